# Optimizing an MI355X kernel written in HIP

```python
import jax, jax.numpy as jnp
from jax import lax
import numpy as np

D_MODEL = 2048
BATCH = 4
SEQ = 2048
DEPTH = 4

N_META = 16
BLOCK = 128
EPS = 1e-6
NEG_INF = -1e30
ROPE_THETA = 10000.0
MLA_HEADS = 8
MLA_Q_RANK = 512
MLA_KV_RANK = 512
MLA_NOPE = 128
MLA_ROPE = 64
MLA_V = 128
CONV_WIDTH = 1024
CONV_K = 3
FOX_HEADS = 8
FOX_HEAD_DIM = 128
FORGET_BIAS_MEAN = 2.0
N_BRANCH = 3
BRANCH_WIDTH = 1024
D_FF = -(-8 * D_MODEL // (3 * 256)) * 256
FOX_WIDTH = FOX_HEADS * FOX_HEAD_DIM
IN_SPLITS = (MLA_Q_RANK, MLA_KV_RANK, MLA_ROPE,
             CONV_WIDTH, CONV_WIDTH, CONV_WIDTH,
             FOX_WIDTH, FOX_WIDTH, FOX_WIDTH, FOX_HEADS,
             N_BRANCH * D_MODEL)
D_IN = sum(IN_SPLITS)

kernel_name = "hybrid_mla_conv_fox_gated_block"


def _split_points():
    return [int(v) for v in np.cumsum(IN_SPLITS)[:-1]]


def rms_norm(x, g):
    xf = x.astype(jnp.float32)
    y = xf * lax.rsqrt(jnp.mean(xf * xf, axis=-1, keepdims=True) + EPS) * g.astype(jnp.float32)
    return y.astype(x.dtype)


def rope_tables(length):
    inv_freq = 1.0 / (ROPE_THETA ** (jnp.arange(0, MLA_ROPE, 2, dtype=jnp.float32) / MLA_ROPE))
    ang = jnp.arange(length, dtype=jnp.float32)[:, None] * inv_freq[None, :]
    return jnp.cos(ang)[:, None, :], jnp.sin(ang)[:, None, :]


def apply_rope(x, cos, sin):
    xf = x.astype(jnp.float32)
    x1, x2 = xf[..., : MLA_ROPE // 2], xf[..., MLA_ROPE // 2:]
    return jnp.concatenate([x1 * cos - x2 * sin, x1 * sin + x2 * cos], axis=-1).astype(x.dtype)


def to_heads(t, n_heads):
    b, l, _ = t.shape
    return t.reshape(b, l, n_heads, -1).transpose(0, 2, 1, 3)


def blocked_causal_attention(q, k, v, scale, decay=None):
    b, h, l, _ = q.shape
    pad = (-l) % BLOCK
    padw = ((0, 0), (0, 0), (pad, 0), (0, 0))
    qp, kp, vp = jnp.pad(q, padw), jnp.pad(k, padw), jnp.pad(v, padw)
    lp = l + pad
    nb = lp // BLOCK
    kpos = jnp.arange(lp)
    key_ok = kpos >= pad
    q_blocks = qp.reshape(b, h, nb, BLOCK, -1).transpose(2, 0, 1, 3, 4)
    dp = None if decay is None else jnp.pad(decay, ((0, 0), (0, 0), (pad, 0)))

    def attend(qi, i, di):
        s = jnp.einsum('bhqd,bhkd->bhqk', qi, kp, preferred_element_type=jnp.float32) * scale
        if di is not None:
            s = s + (di[..., :, None] - dp[:, :, None, :])
        qpos = i * BLOCK + jnp.arange(BLOCK)
        mask = (kpos[None, :] <= qpos[:, None]) & key_ok[None, :]
        p = jax.nn.softmax(jnp.where(mask, s, NEG_INF), axis=-1).astype(vp.dtype)
        return jnp.einsum('bhqk,bhkd->bhqd', p, vp)

    idx = jnp.arange(nb)
    if decay is None:
        out = lax.map(lambda a: attend(a[0], a[1], None), (q_blocks, idx))
    else:
        d_blocks = dp.reshape(b, h, nb, BLOCK).transpose(2, 0, 1, 3)
        out = lax.map(lambda a: attend(a[0], a[1], a[2]), (q_blocks, idx, d_blocks))
    out = out.transpose(1, 2, 0, 3, 4).reshape(b, h, lp, -1)
    return out[:, :, pad:]


def hybrid_mixer(h, w_in, b_forget, g_q_lat, g_kv_lat, w_uq, w_ukv, conv_w, w_branch, w_out, cos, sin):
    b, l, _ = h.shape
    proj = h @ w_in
    (c_q, c_kv, k_pe, conv_b, conv_c, conv_x,
     f_q, f_k, f_v, f_logit, gate_logit) = jnp.split(proj, _split_points(), axis=-1)

    q = (rms_norm(c_q, g_q_lat) @ w_uq).reshape(b, l, MLA_HEADS, MLA_NOPE + MLA_ROPE)
    q_nope, q_pe = q[..., :MLA_NOPE], apply_rope(q[..., MLA_NOPE:], cos, sin)
    kv = (rms_norm(c_kv, g_kv_lat) @ w_ukv).reshape(b, l, MLA_HEADS, MLA_NOPE + MLA_V)
    k_nope, v_a = kv[..., :MLA_NOPE], kv[..., MLA_NOPE:]
    k_pe = apply_rope(k_pe[:, :, None, :], cos, sin)
    q_a = jnp.concatenate([q_nope, q_pe], axis=-1)
    k_a = jnp.concatenate([k_nope, jnp.broadcast_to(k_pe, (b, l, MLA_HEADS, MLA_ROPE))], axis=-1)
    o_a = blocked_causal_attention(q_a.transpose(0, 2, 1, 3), k_a.transpose(0, 2, 1, 3),
                                   v_a.transpose(0, 2, 1, 3), (MLA_NOPE + MLA_ROPE) ** -0.5)
    o_a = o_a.transpose(0, 2, 1, 3).reshape(b, l, MLA_HEADS * MLA_V)

    u = conv_c * conv_x
    u = lax.conv_general_dilated(u, conv_w[:, None, :].astype(u.dtype), window_strides=(1,),
                                 padding=[(CONV_K - 1, 0)], dimension_numbers=('NWC', 'WIO', 'NWC'),
                                 feature_group_count=CONV_WIDTH)
    o_b = conv_b * u

    log_f = jax.nn.log_sigmoid(f_logit.astype(jnp.float32) + b_forget.astype(jnp.float32))
    c = jnp.cumsum(log_f, axis=1).transpose(0, 2, 1)
    o_c = blocked_causal_attention(to_heads(f_q, FOX_HEADS), to_heads(f_k, FOX_HEADS),
                                   to_heads(f_v, FOX_HEADS), FOX_HEAD_DIM ** -0.5, decay=c)
    o_c = o_c.transpose(0, 2, 1, 3).reshape(b, l, FOX_WIDTH)

    o = jnp.stack([o_a, o_b, o_c], axis=2)
    y = jnp.einsum('blnw,nwd->blnd', o, w_branch)
    gates = jax.nn.sigmoid(gate_logit.astype(jnp.float32)).astype(h.dtype).reshape(b, l, N_BRANCH, D_MODEL)
    merged = jnp.sum(gates * y, axis=2)
    return merged @ w_out


def swiglu(h, w_ffn_in, w_ffn_out):
    g, u = jnp.split(h @ w_ffn_in, 2, axis=-1)
    return (jax.nn.silu(g) * u) @ w_ffn_out


def setup_inputs(seed: int = 0) -> dict:
    key = jax.random.key(seed)
    ks = jax.random.split(key, 18)
    f32 = jnp.float32

    def dense(k, shape, fan_in):
        return jax.random.normal(k, shape, f32) * fan_in ** -0.5

    def gain(k, shape):
        return 1.0 + 0.05 * jax.random.normal(k, shape, f32)

    return {
        "x": jax.random.normal(ks[0], (BATCH, SEQ, D_MODEL), f32),
        "meta": jax.random.normal(ks[1], (N_META, D_MODEL), f32),
        "w_in": dense(ks[2], (DEPTH, D_MODEL, D_IN), D_MODEL),
        "b_forget": FORGET_BIAS_MEAN + 0.1 * jax.random.normal(ks[3], (DEPTH, FOX_HEADS), f32),
        "g_q_lat": gain(ks[4], (DEPTH, MLA_Q_RANK)),
        "g_kv_lat": gain(ks[5], (DEPTH, MLA_KV_RANK)),
        "w_uq": dense(ks[6], (DEPTH, MLA_Q_RANK, MLA_HEADS * (MLA_NOPE + MLA_ROPE)), MLA_Q_RANK),
        "w_ukv": dense(ks[7], (DEPTH, MLA_KV_RANK, MLA_HEADS * (MLA_NOPE + MLA_V)), MLA_KV_RANK),
        "conv_w": dense(ks[8], (DEPTH, CONV_K, CONV_WIDTH), CONV_K),
        "w_branch": dense(ks[9], (DEPTH, N_BRANCH, BRANCH_WIDTH, D_MODEL), BRANCH_WIDTH),
        "w_out": dense(ks[10], (DEPTH, D_MODEL, D_MODEL), D_MODEL),
        "w_ffn_in": dense(ks[11], (DEPTH, D_MODEL, 2 * D_FF), D_MODEL),
        "w_ffn_out": dense(ks[12], (DEPTH, D_FF, D_MODEL), D_FF),
        "g_mix_pre": gain(ks[13], (DEPTH, D_MODEL)),
        "g_mix_post": gain(ks[14], (DEPTH, D_MODEL)),
        "g_ffn_pre": gain(ks[15], (DEPTH, D_MODEL)),
        "g_ffn_post": gain(ks[16], (DEPTH, D_MODEL)),
    }


def reference(x, meta, w_in, b_forget, g_q_lat, g_kv_lat, w_uq, w_ukv, conv_w, w_branch, w_out,
              w_ffn_in, w_ffn_out, g_mix_pre, g_mix_post, g_ffn_pre, g_ffn_post):
    b, s, _ = x.shape
    length = N_META + s
    h = jnp.concatenate([jnp.broadcast_to(meta[None].astype(x.dtype), (b, N_META, D_MODEL)), x], axis=1)
    cos, sin = rope_tables(length)
    for layer in range(DEPTH):
        hn = rms_norm(h, g_mix_pre[layer])
        mix = hybrid_mixer(hn, w_in[layer], b_forget[layer], g_q_lat[layer], g_kv_lat[layer],
                           w_uq[layer], w_ukv[layer], conv_w[layer], w_branch[layer], w_out[layer], cos, sin)
        h = h + rms_norm(mix, g_mix_post[layer])
        hn = rms_norm(h, g_ffn_pre[layer])
        h = h + rms_norm(swiglu(hn, w_ffn_in[layer], w_ffn_out[layer]), g_ffn_post[layer])
    return h[:, N_META:]
```

```cpp
#include <hip/hip_runtime.h>
#include <cstdio>
#include <cstdint>

#ifndef MK_ONE_LAUNCH
#define MK_ONE_LAUNCH 1
#endif
#ifndef FAST_GEMM
#define FAST_GEMM 1
#endif
#ifndef FAST_ATTN
#define FAST_ATTN 0
#endif

#define GAS __attribute__((address_space(1)))
#define LAS __attribute__((address_space(3)))
typedef unsigned short bf16_t;
typedef short bf16x8 __attribute__((ext_vector_type(8)));
typedef float f32x4 __attribute__((ext_vector_type(4)));
typedef float f32x2 __attribute__((ext_vector_type(2)));
typedef unsigned u32x4 __attribute__((ext_vector_type(4)));
typedef unsigned u32x2 __attribute__((ext_vector_type(2)));
typedef __bf16 bf16x2_t __attribute__((ext_vector_type(2)));

constexpr int DM = 2048, NBATCH = 4, SEQ = 2048, DEPTH = 4, NMETA = 16, LSEQ = SEQ + NMETA;
constexpr int MREAL = NBATCH * SEQ;
constexpr int MTOK = MREAL + NBATCH * NMETA;
constexpr int MP = 8448, NPM = MP / 256;
constexpr int DIN = 13384, N1 = 13568, N1T = N1 / 256;
constexpr int DFF = 5632, NH = 8, HQK = 192;
constexpr float EPS = 1e-6f;
constexpr int PC_CQ = 0, PC_CKV = 512, PC_MISC = 1024, PC_CONVB = 1280, PC_CONVC = 2304, PC_CONVX = 3328, PC_FQ = 4352, PC_FK = 5376, PC_FV = 6400, PC_GATE = 7424;
constexpr int CBLD = 2112;

constexpr size_t al256(size_t x) { return (x + 255) & ~(size_t)255; }
constexpr size_t WS_CTL = 0, CTL_ZERO_BYTES = 1u << 20;
constexpr size_t SZ_W1 = (size_t)N1 * DM * 2, SZ_WUQ = (size_t)1536 * 512 * 2, SZ_WUKV = (size_t)2048 * 512 * 2, SZ_WBR = (size_t)DM * 3072 * 2,
                 SZ_WOUT = (size_t)DM * DM * 2, SZ_WF1 = (size_t)2 * DFF * DM * 2, SZ_WF2 = (size_t)DM * DFF * 2;
constexpr size_t WO_W1 = 0, WO_WUQ = WO_W1 + SZ_W1, WO_WUKV = WO_WUQ + SZ_WUQ, WO_WBR = WO_WUKV + SZ_WUKV, WO_WOUT = WO_WBR + SZ_WBR,
                 WO_WF1 = WO_WOUT + SZ_WOUT, WO_WF2 = WO_WF1 + SZ_WF1, W_LAYER = WO_WF2 + SZ_WF2;
constexpr size_t WS_W = CTL_ZERO_BYTES;
constexpr size_t WS_H = al256(WS_W + DEPTH * W_LAYER);
constexpr size_t WS_HN = al256(WS_H + (size_t)MP * DM * 4);
constexpr size_t WS_PROJ = al256(WS_HN + (size_t)MP * DM * 2);
constexpr size_t WS_MISC = al256(WS_PROJ + (size_t)MP * N1 * 2);
constexpr size_t WS_CQN = al256(WS_MISC + (size_t)MP * 128 * 4);
constexpr size_t WS_CKVN = al256(WS_CQN + (size_t)MP * 512 * 2);
constexpr size_t WS_QA = al256(WS_CKVN + (size_t)MP * 512 * 2);
constexpr size_t WS_KA = al256(WS_QA + (size_t)MP * 1536 * 2);
constexpr size_t WS_VA = al256(WS_KA + (size_t)MP * 1536 * 2);
constexpr size_t WS_CB = al256(WS_VA + (size_t)MP * 1024 * 2);
constexpr size_t WS_OCAT = al256(WS_CB + (size_t)32 * CBLD * 4);
constexpr size_t WS_MIXF = al256(WS_OCAT + (size_t)MP * 3072 * 2);
constexpr size_t WS_MERGED = al256(WS_MIXF + (size_t)MP * DM * 4);
constexpr size_t WS_ACT = al256(WS_MERGED + (size_t)MP * DM * 2);
constexpr size_t WS_ROPE = al256(WS_ACT + (size_t)MP * DFF * 2);
constexpr size_t WS_END = al256(WS_ROPE + (size_t)LSEQ * 32 * 2 * 4);

constexpr int NWAVES = 8, NTHREADS = NWAVES * 64;
constexpr int LDS_BYTES = 147456;
constexpr int RING_BYTES = 131072, MISC_OFF = RING_BYTES + 320;
constexpr int NPHASES = 1 + 10 * DEPTH;

__device__ __forceinline__ unsigned cvtpk(float lo, float hi) { f32x2 v = {lo, hi}; bf16x2_t b = __builtin_convertvector(v, bf16x2_t); return __builtin_bit_cast(unsigned, b); }
__device__ __forceinline__ float bf2f(unsigned short u) { return __uint_as_float((unsigned)u << 16); }
__device__ __forceinline__ float bflo(unsigned w) { return __uint_as_float(w << 16); }
__device__ __forceinline__ float bfhi(unsigned w) { return __uint_as_float(w & 0xffff0000u); }
__device__ __forceinline__ float wave_sum(float v) {
#pragma unroll
    for (int o = 1; o < 64; o <<= 1) v += __shfl_xor(v, o);
    return v;
}
__device__ __forceinline__ float wave_max(float v) {
#pragma unroll
    for (int o = 1; o < 64; o <<= 1) v = fmaxf(v, __shfl_xor(v, o));
    return v;
}
__device__ __forceinline__ float sigmoidf_(float x) { return __builtin_amdgcn_rcpf(1.0f + __builtin_amdgcn_exp2f(-1.4426950408889634f * x)); }
__device__ __forceinline__ int row_of(int b, int t) { return t < NMETA ? MREAL + b * NMETA + t : b * SEQ + t - NMETA; }
__device__ __forceinline__ int t_of(int r) { return r < MREAL ? NMETA + (r & (SEQ - 1)) : (r < MTOK ? ((r - MREAL) & (NMETA - 1)) : 0); }
#define LDS_WAIT() asm volatile("s_waitcnt lgkmcnt(0)" ::: "memory")
#define VM_WAIT() asm volatile("s_waitcnt vmcnt(0)" ::: "memory")

#define XB_TMO      128
#define XB_XCNT(j)  (256  + 64 * (j))
#define XB_XSUB(j)  (1280 + 64 * (j))
#define XB_XGEN(j)  (2304 + 64 * (j))
#define XB_TOP      3328
#define XB_TOPGEN   3392
#define XCD_BAR_WORDS 3456
#define XB_SPIN_CAP (1u << 18)
__device__ __forceinline__ unsigned xb_ld(unsigned* p)              { return __hip_atomic_load(p, __ATOMIC_RELAXED, __HIP_MEMORY_SCOPE_AGENT); }
__device__ __forceinline__ unsigned xb_add(unsigned* p, unsigned v) { return __hip_atomic_fetch_add(p, v, __ATOMIC_RELAXED, __HIP_MEMORY_SCOPE_AGENT); }
__device__ __forceinline__ unsigned xb_xcc_id() { return (unsigned)__builtin_amdgcn_s_getreg((3 << 11) | 20) & 0xFu; }
#define XB_SPIN(cond, bar) do { unsigned _sp = 0; while (cond) { __builtin_amdgcn_s_sleep(1); \
    if ((++_sp & 255u) == 0u) { if (xb_ld(&(bar)[XB_TMO])) break; if (_sp > XB_SPIN_CAP) { atomicAdd(&(bar)[XB_TMO], 1u); break; } } } } while (0)
struct XcdBarrier { unsigned* bar; unsigned x; volatile LAS unsigned* st; };
__device__ __forceinline__ XcdBarrier xcd_barrier_post(unsigned* bar, volatile LAS unsigned* st) {
    XcdBarrier b; b.bar = bar; b.x = xb_xcc_id(); b.st = st;
    if (threadIdx.x == 0) (void)xb_add(&bar[XB_XCNT(b.x)], 1u);
    return b;
}
__device__ __forceinline__ void xcd_barrier_complete(unsigned* bar, unsigned x, unsigned& nloc, unsigned& nx) {
    const unsigned G = gridDim.x * gridDim.y * gridDim.z;
    unsigned sum, cnt, mine, sp = 0u;
    for (;;) {
        sum = 0u; cnt = 0u; mine = 0u;
#pragma unroll
        for (unsigned j = 0; j < 16; ++j) { const unsigned c = xb_ld(&bar[XB_XCNT(j)]); sum += c; cnt += (c > 0u) ? 1u : 0u; mine = (j == x) ? c : mine; }
        if (sum == G) break;
        __builtin_amdgcn_s_sleep(1);
        if ((++sp & 255u) == 0u) { if (xb_ld(&bar[XB_TMO])) break; if (sp > XB_SPIN_CAP) { atomicAdd(&bar[XB_TMO], 1u); break; } }
    }
    nloc = mine > 0u ? mine : 1u; nx = cnt > 0u ? cnt : 1u;
}
__device__ __forceinline__ void xcd_barrier(const XcdBarrier& b) {
    asm volatile("s_waitcnt vmcnt(0)" ::: "memory");
    __syncthreads();
    if (threadIdx.x == 0) {
        unsigned* bar = b.bar; asm volatile("" : "+s"(bar));
        __builtin_amdgcn_s_waitcnt(0);
        unsigned nloc = b.st[0], nx = b.st[1];
        if (nloc == 0u) { xcd_barrier_complete(bar, b.x, nloc, nx); b.st[0] = nloc; b.st[1] = nx; }
        const unsigned old = xb_add(&bar[XB_XSUB(b.x)], 1u);
        const unsigned gen = old / nloc;
        if (old + 1u == (gen + 1u) * nloc) {
            __builtin_amdgcn_fence(__ATOMIC_RELEASE, "agent");
            asm volatile("s_waitcnt vmcnt(0)" ::: "memory");
            const unsigned og = xb_add(&bar[XB_TOP], 1u);
            const unsigned tg = og / nx;
            if (og + 1u == (tg + 1u) * nx) xb_add(&bar[XB_TOPGEN], 1u);
            else XB_SPIN(xb_ld(&bar[XB_TOPGEN]) == tg, bar);
            __builtin_amdgcn_fence(__ATOMIC_ACQUIRE, "agent");
            xb_add(&bar[XB_XGEN(b.x)], 1u);
            asm volatile("s_waitcnt vmcnt(0)" ::: "memory");
        } else {
            XB_SPIN(xb_ld(&bar[XB_XGEN(b.x)]) == gen, bar);
            __builtin_amdgcn_fence(__ATOMIC_ACQUIRE, "agent");
            asm volatile("s_waitcnt vmcnt(0)" ::: "memory");
        }
    }
    __syncthreads();
}

struct Unit { int pm, pn, tag; const char* A; const char* B; };

__device__ __forceinline__ void tile_decode(int L, int nM, int nN, int& pm, int& pn) {
    const int nwg = nM * nN; int wgid = L;
    { const int q = nwg / 8, r = nwg % 8, xcd = wgid % 8, off = wgid / 8; wgid = (xcd < r ? xcd * (q + 1) : r * (q + 1) + (xcd - r) * q) + off; }
    const int nig = 8 * nN, gid = wgid / nig, fm = gid * 8, gsz = (nM - fm) < 8 ? (nM - fm) : 8;
    pm = fm + ((wgid % nig) % gsz); pn = (wgid % nig) / gsz;
}
struct SchedPlain {
    const char* A; const char* B; int lda, ldb, nN, G, c;
    __device__ __forceinline__ bool next(int i, Unit& u) const {
        const int L = i * G + c; if (L >= NPM * nN) return false;
        tile_decode(L, NPM, nN, u.pm, u.pn); u.tag = 0;
        u.A = A + (size_t)u.pm * 256 * lda * 2; u.B = B + (size_t)u.pn * 256 * ldb * 2; return true;
    }
};
struct SchedG2 {
    const char* Akv; const char* Bkv; const char* Aq; const char* Bq; int G, c;
    __device__ __forceinline__ bool next(int i, Unit& u) const {
        int L = i * G + c; if (L >= NPM * 14) return false;
        if (L < NPM * 8) { tile_decode(L, NPM, 8, u.pm, u.pn); u.tag = 0; u.A = Akv + (size_t)u.pm * 256 * 1024; u.B = Bkv + (size_t)u.pn * 256 * 1024; }
        else { L -= NPM * 8; tile_decode(L, NPM, 6, u.pm, u.pn); u.tag = 1; u.A = Aq + (size_t)u.pm * 256 * 1024; u.B = Bq + (size_t)u.pn * 256 * 1024; }
        return true;
    }
};
struct SchedG3 {
    const char* A; const char* B; int G, c;
    __device__ __forceinline__ bool next(int i, Unit& u) const {
        const int br = i % 3, L = (i / 3) * G + c; if (L >= NPM * 8) return false;
        tile_decode(L, NPM, 8, u.pm, u.pn); u.tag = br;
        u.A = A + ((size_t)u.pm * 256 * 3072 + br * 1024) * 2; u.B = B + ((size_t)u.pn * 256 * 3072 + br * 1024) * 2; return true;
    }
};

__device__ __forceinline__ void st_bf4(bf16_t* p, f32x4 v) { u32x2 w; w.x = cvtpk(v[0], v[1]); w.y = cvtpk(v[2], v[3]); *(u32x2*)p = w; }
struct EpiG1 {
    bf16_t* proj; float* misc;
    __device__ __forceinline__ void operator()(int, int row, int pn, int cj, f32x4 lo, f32x4 hi) const {
        if (pn >= PC_GATE / 256) {
#pragma unroll
            for (int e = 0; e < 4; ++e) { lo[e] = sigmoidf_(lo[e]); hi[e] = sigmoidf_(hi[e]); }
        }
        bf16_t* p = proj + (size_t)row * N1 + pn * 256 + cj;
        st_bf4(p, lo); st_bf4(p + 128, hi);
        if (pn == PC_MISC / 256) *(f32x4*)(misc + (size_t)row * 128 + cj) = lo;
    }
};
struct EpiG2 {
    bf16_t* qa; bf16_t* ka; bf16_t* va; const float* rope;
    __device__ __forceinline__ void qcols(int row, int col, f32x4 v) const {
        const int h = col / HQK, j = col - h * HQK;
        if (j >= 128) {
            const int i0 = (j - 128) >> 1; const float* rp = rope + ((size_t)t_of(row) * 32 + i0) * 2;
            const f32x4 cs = *(const f32x4*)rp;
            v = (f32x4){v[0] * cs[0] - v[1] * cs[1], v[0] * cs[1] + v[1] * cs[0], v[2] * cs[2] - v[3] * cs[3], v[2] * cs[3] + v[3] * cs[2]};
        }
        st_bf4(qa + (size_t)row * 1536 + col, v);
    }
    __device__ __forceinline__ void operator()(int tag, int row, int pn, int cj, f32x4 lo, f32x4 hi) const {
        if (tag == 0) { st_bf4(ka + (size_t)row * 1536 + pn * HQK + cj, lo); st_bf4(va + (size_t)row * 1024 + pn * 128 + cj, hi); }
        else { qcols(row, pn * 256 + cj, lo); qcols(row, pn * 256 + 128 + cj, hi); }
    }
};
struct EpiG3 {
    const bf16_t* proj; float* part; bf16_t* merged;
    __device__ __forceinline__ void one(int tag, int row, int col, f32x4 v) const {
        const u32x2 g = *(const u32x2*)(proj + (size_t)row * N1 + PC_GATE + tag * DM + col);
        v = (f32x4){v[0] * bflo(g.x), v[1] * bfhi(g.x), v[2] * bflo(g.y), v[3] * bfhi(g.y)};
        float* pp = part + (size_t)row * DM + col;
        if (tag > 0) v += *(const f32x4*)pp;
        if (tag < 2) *(f32x4*)pp = v; else st_bf4(merged + (size_t)row * DM + col, v);
    }
    __device__ __forceinline__ void operator()(int tag, int row, int pn, int cj, f32x4 lo, f32x4 hi) const { one(tag, row, pn * 256 + cj, lo); one(tag, row, pn * 256 + 128 + cj, hi); }
};
struct EpiF32 {
    float* out;
    __device__ __forceinline__ void operator()(int, int row, int pn, int cj, f32x4 lo, f32x4 hi) const {
        float* p = out + (size_t)row * DM + pn * 256 + cj; *(f32x4*)p = lo; *(f32x4*)(p + 128) = hi;
    }
};
struct EpiG5 {
    bf16_t* act;
    __device__ __forceinline__ void operator()(int, int row, int pn, int cj, f32x4 lo, f32x4 hi) const {
        f32x4 v;
#pragma unroll
        for (int e = 0; e < 4; ++e) v[e] = lo[e] * sigmoidf_(lo[e]) * hi[e];
        st_bf4(act + (size_t)row * DFF + pn * 128 + cj, v);
    }
};

template <class EF, class Sched>
__device__ __forceinline__ void gemm_simple(int K, int lda, int ldb, const Sched& S, const EF& E) {
    const int tid = threadIdx.x, wid = tid >> 6, lane = tid & 63, wr = wid >> 2, q = wid & 3, fr = lane & 15, fq = lane >> 4;
    Unit u;
#pragma unroll 1
    for (int i = 0; S.next(i, u); ++i) {
        const bf16_t* Ab = (const bf16_t*)u.A; const bf16_t* Bb = (const bf16_t*)u.B;
#pragma unroll 1
        for (int rb = 0; rb < 8; ++rb) {
            const int rloc = wr * 128 + rb * 16 + fr;
            f32x4 acc[4] = {};
            const bf16_t* ap = Ab + (size_t)rloc * lda + fq * 8;
            const bf16_t* bp[4];
#pragma unroll
            for (int n = 0; n < 4; ++n) bp[n] = Bb + (size_t)((n >> 1) * 128 + q * 32 + (n & 1) * 16 + fr) * ldb + fq * 8;
#pragma unroll 2
            for (int k = 0; k < K; k += 32) {
                const bf16x8 a = *(const bf16x8*)(ap + k);
#pragma unroll
                for (int n = 0; n < 4; ++n) { const bf16x8 b = *(const bf16x8*)(bp[n] + k); acc[n] = __builtin_amdgcn_mfma_f32_16x16x32_bf16(b, a, acc[n], 0, 0, 0); }
            }
            const int row = u.pm * 256 + rloc;
#pragma unroll
            for (int n = 0; n < 2; ++n) E(u.tag, row, u.pn, q * 32 + n * 16 + 4 * fq, acc[n], acc[2 + n]);
        }
    }
}

namespace pg8 {
constexpr int BK = 64, HALF = 128, HTB = HALF * BK * 2, STAGE_BYTES = 8 * HTB;
__device__ __forceinline__ int lds_byte(int r, int c) { const int st = (r >> 4) * 2 + (c >> 5), rr = r & 15, cc = c & 31, ob = rr * 64 + cc * 2; return st * 1024 + (ob ^ (((ob >> 9) & 1) << 5)); }
__device__ __forceinline__ void stage_rc(int b, int& R, int& C) { const int st = b / 1024, sb = b % 1024, swz = sb ^ (((sb >> 9) & 1) << 5); R = (st >> 1) * 16 + swz / 64; C = (st & 1) * 32 + (swz % 64) / 2; }

template <class EF, class Sched, bool ALIGN_EPI>
__device__ __forceinline__ void gemm_phase(LAS unsigned char* lds, const int K, const int lda, const int ldb, const Sched& S, const EF& E) {
    int tid = threadIdx.x; asm volatile("" : "+v"(tid));
    const int wid = __builtin_amdgcn_readfirstlane(tid >> 6), lane = tid & 63, wr = wid >> 2, wc = wid & 3, fr = lane & 15, fq = lane >> 4;
    const int nt = K / BK;
    unsigned voffA[2], voffB[2];
#pragma unroll
    for (int i = 0; i < 2; ++i) { int R, C; stage_rc(tid * 16 + i * 8192, R, C); voffA[i] = (unsigned)(R * lda + C) * 2u; voffB[i] = (unsigned)(R * ldb + C) * 2u; }
    const size_t kstep = (size_t)(BK * 2);
    const size_t hstepA = (size_t)HALF * lda * 2, hstepB = (size_t)HALF * ldb * 2;
    const unsigned ldsw = (unsigned)wid * 1024u;
    const int aoff = lds_byte(wr * 64 + fr, fq * 8), boff = lds_byte(wc * 32 + fr, fq * 8);
#define PG8_SA(b, h) (((b) * 2 + (h)) * HTB)
#define PG8_SB(b, h) ((4 + (b) * 2 + (h)) * HTB)
#define PG8_STAGE(bufoff, gbase, voff) do { _Pragma("unroll") for (int _i = 0; _i < 2; ++_i) \
        __builtin_amdgcn_global_load_lds((const unsigned*)((const char*)(gbase) + (voff)[_i]), (LAS unsigned*)(lds + (bufoff) + ldsw + _i * 8192), 16, 0, 0); } while (0)
#define PG8_LDA(dst, b, h) do { _Pragma("unroll") for (int m = 0; m < 4; ++m) _Pragma("unroll") for (int k = 0; k < 2; ++k) dst[m][k] = *(const LAS bf16x8*)(lds + PG8_SA(b, h) + aoff + m * 2048 + k * 1024); } while (0)
#define PG8_LDB(dst, b, h) do { _Pragma("unroll") for (int n = 0; n < 2; ++n) _Pragma("unroll") for (int k = 0; k < 2; ++k) dst[n][k] = *(const LAS bf16x8*)(lds + PG8_SB(b, h) + boff + n * 2048 + k * 1024); } while (0)
#define PG8_MMA(ai, bj, At, Bt) do { __builtin_amdgcn_s_setprio(1); _Pragma("unroll") for (int m = 0; m < 4; ++m) _Pragma("unroll") for (int n = 0; n < 2; ++n) _Pragma("unroll") for (int k = 0; k < 2; ++k) \
        acc[ai][bj][m][n] = __builtin_amdgcn_mfma_f32_16x16x32_bf16(Bt[n][k], At[m][k], acc[ai][bj][m][n], 0, 0, 0); __builtin_amdgcn_s_setprio(0); } while (0)
#define PG8_WAIT_V(n) asm volatile("s_waitcnt vmcnt(" #n ")" ::: "memory")
#define PG8_WAIT_L(n) asm volatile("s_waitcnt lgkmcnt(" #n ")" ::: "memory")
#define PG8_BAR __builtin_amdgcn_s_barrier()
#define PG8_SCHED __builtin_amdgcn_sched_barrier(0)
    Unit cur, nxt; int ui = 0;
    if (!S.next(0, cur)) return;
    f32x4 acc[2][2][4][2];
#pragma unroll
    for (int a = 0; a < 2; ++a)
#pragma unroll
        for (int b = 0; b < 2; ++b)
#pragma unroll
            for (int m = 0; m < 4; ++m)
#pragma unroll
                for (int n = 0; n < 2; ++n) acc[a][b][m][n] = (f32x4){0.f, 0.f, 0.f, 0.f};
    bf16x8 At[4][2], B0[2][2], B1[2][2];
    const char* cA = cur.A; const char* cB = cur.B;
    PG8_STAGE(PG8_SB(0, 0), cB, voffB); PG8_STAGE(PG8_SB(0, 1), cB + hstepB, voffB); PG8_STAGE(PG8_SA(0, 0), cA, voffA); PG8_STAGE(PG8_SA(0, 1), cA + hstepA, voffA);
    if (wr == 1) PG8_BAR;
    PG8_WAIT_V(2); PG8_BAR;
    PG8_STAGE(PG8_SB(1, 0), cB + kstep, voffB); PG8_STAGE(PG8_SA(1, 0), cA + kstep, voffA); PG8_STAGE(PG8_SB(1, 1), cB + hstepB + kstep, voffB);
    PG8_WAIT_V(6); PG8_BAR;
    for (;;) {
        const bool has_next = S.next(ui + 1, nxt);
        const char* nA = has_next ? nxt.A : cA; const char* nB = has_next ? nxt.B : cB;
        for (int t = 0; t < nt; t += 2) {
            const bool last = (t == nt - 2);
            const char* a1 = cA + (size_t)(t + 1) * kstep;
            const char* a2 = last ? nA : cA + (size_t)(t + 2) * kstep; const char* b2 = last ? nB : cB + (size_t)(t + 2) * kstep;
            const char* a3 = a2 + kstep; const char* b3 = b2 + kstep;
            PG8_LDB(B0, 0, 0); PG8_LDB(B1, 0, 1); PG8_SCHED; PG8_LDA(At, 0, 0); PG8_STAGE(PG8_SA(1, 1), a1 + hstepA, voffA);
            PG8_WAIT_V(8); PG8_WAIT_L(0); PG8_BAR; PG8_MMA(0, 0, At, B0); PG8_MMA(0, 1, At, B1); PG8_BAR; PG8_SCHED;
            PG8_LDA(At, 0, 1); PG8_STAGE(PG8_SB(0, 0), b2, voffB); PG8_STAGE(PG8_SB(0, 1), b2 + hstepB, voffB); PG8_STAGE(PG8_SA(0, 0), a2, voffA);
            PG8_WAIT_V(8); PG8_WAIT_L(0); PG8_BAR; PG8_MMA(1, 0, At, B0); PG8_MMA(1, 1, At, B1); PG8_BAR; PG8_SCHED;
            PG8_LDB(B0, 1, 0); PG8_LDB(B1, 1, 1); PG8_SCHED; PG8_LDA(At, 1, 0); PG8_STAGE(PG8_SA(0, 1), a2 + hstepA, voffA);
            PG8_WAIT_V(8); PG8_WAIT_L(0); PG8_BAR; PG8_MMA(0, 0, At, B0); PG8_MMA(0, 1, At, B1); PG8_BAR; PG8_SCHED;
            PG8_LDA(At, 1, 1); PG8_STAGE(PG8_SB(1, 0), b3, voffB); PG8_STAGE(PG8_SB(1, 1), b3 + hstepB, voffB); PG8_STAGE(PG8_SA(1, 0), a3, voffA);
            PG8_WAIT_V(8); PG8_WAIT_L(0); PG8_BAR; PG8_MMA(1, 0, At, B0); PG8_MMA(1, 1, At, B1); PG8_BAR; PG8_SCHED;
        }
        if constexpr (ALIGN_EPI) { if (wr == 0) PG8_BAR; }
        {
#pragma unroll
            for (int ai = 0; ai < 2; ++ai)
#pragma unroll
                for (int m = 0; m < 4; ++m) { const int row = cur.pm * 256 + ai * HALF + wr * 64 + m * 16 + fr;
#pragma unroll
                    for (int n = 0; n < 2; ++n) E(cur.tag, row, cur.pn, wc * 32 + n * 16 + 4 * fq, acc[ai][0][m][n], acc[ai][1][m][n]); }
        }
        if (!has_next) break;
#pragma unroll
        for (int a = 0; a < 2; ++a)
#pragma unroll
            for (int b = 0; b < 2; ++b)
#pragma unroll
                for (int m = 0; m < 4; ++m)
#pragma unroll
                    for (int n = 0; n < 2; ++n) acc[a][b][m][n] = (f32x4){0.f, 0.f, 0.f, 0.f};
        cur = nxt; cA = nA; cB = nB; ++ui;
        if constexpr (ALIGN_EPI) { if (wr == 1) PG8_BAR; }
    }
    PG8_WAIT_V(0);
    if constexpr (!ALIGN_EPI) { if (wr == 0) PG8_BAR; }
    PG8_BAR;
#undef PG8_SA
#undef PG8_SB
#undef PG8_STAGE
#undef PG8_LDA
#undef PG8_LDB
#undef PG8_MMA
#undef PG8_WAIT_V
#undef PG8_WAIT_L
#undef PG8_BAR
#undef PG8_SCHED
}
}

template <class EF, class Sched>
__device__ __forceinline__ void run_gemm(LAS unsigned char* lds, int K, int lda, int ldb, const Sched& S, const EF& E) {
#if FAST_GEMM
    pg8::gemm_phase<EF, Sched, true>(lds, K, lda, ldb, S, E);
#else
    gemm_simple<EF, Sched>(K, lda, ldb, S, E);
#endif
}

__device__ __forceinline__ int perm_col(int kind, int n) {
    if (kind == 0) {
        if (n < 1024) return n;
        if (n < 1280) { const int j = n - 1024; return j < 64 ? 1024 + j : (j < 72 ? 7232 + (j - 64) : -1); }
        if (n < PC_FQ) return 1088 + (n - 1280);
        if (n < PC_GATE) return 4160 + (n - PC_FQ);
        return 7240 + (n - PC_GATE);
    }
    if (kind == 1) {
        const int h = n / HQK, j = n - h * HQK; if (j < 128) return n; const int p = j - 128; return h * HQK + 128 + (p >> 1) + 32 * (p & 1);
    }
    if (kind == 2) {
        const int tl = n >> 8, j = n & 255; return j < 128 ? tl * 128 + j : DFF + tl * 128 + (j - 128);
    }
    return n;
}
__device__ __forceinline__ void transpose_item(const float* W, int Nsrc, bf16_t* WT, int ldd, int koff, int kind, LAS float* scr, int kb, int nb, int lane) {
    const int k0 = 64 * kb, n0 = 32 * nb; const int sc = perm_col(kind, n0 + (lane & 31));
#pragma unroll 8
    for (int i = 0; i < 32; ++i) { const int kk = 2 * i + (lane >> 5); scr[kk * 33 + (lane & 31)] = sc >= 0 ? W[(size_t)(k0 + kk) * Nsrc + sc] : 0.f; }
    LDS_WAIT(); asm volatile("" ::: "memory");
    const int c = lane & 7;
#pragma unroll
    for (int j = 0; j < 4; ++j) { const int n = (lane >> 3) + 8 * j; const LAS float* s = scr + (8 * c) * 33 + n;
        u32x4 o; o.x = cvtpk(s[0 * 33], s[1 * 33]); o.y = cvtpk(s[2 * 33], s[3 * 33]); o.z = cvtpk(s[4 * 33], s[5 * 33]); o.w = cvtpk(s[6 * 33], s[7 * 33]);
        *(u32x4*)(WT + (size_t)(n0 + n) * ldd + koff + k0 + 8 * c) = o; }
    LDS_WAIT(); asm volatile("" ::: "memory");
}
struct Ins { const float *x, *meta, *w_in, *b_forget, *g_q, *g_kv, *w_uq, *w_ukv, *conv_w, *w_branch, *w_out, *w_f1, *w_f2, *g_mix_pre, *g_mix_post, *g_ffn_pre, *g_ffn_post; };

__device__ __forceinline__ void sincos_d(double x, float& c, float& s) {
    const double k = __builtin_rint(x * 0.63661977236758134308);
    const double r = (x - k * 1.57079632679489655800e+00) - k * 6.12323399573676603587e-17;
    const double r2 = r * r;
    double sp = -1.0 / 1307674368000.0; sp = sp * r2 + 1.0 / 6227020800.0; sp = sp * r2 - 1.0 / 39916800.0; sp = sp * r2 + 1.0 / 362880.0; sp = sp * r2 - 1.0 / 5040.0; sp = sp * r2 + 1.0 / 120.0; sp = sp * r2 - 1.0 / 6.0; sp = sp * r2 + 1.0; sp *= r;
    double cp = 1.0 / 20922789888000.0; cp = cp * r2 - 1.0 / 87178291200.0; cp = cp * r2 + 1.0 / 479001600.0; cp = cp * r2 - 1.0 / 3628800.0; cp = cp * r2 + 1.0 / 40320.0; cp = cp * r2 - 1.0 / 720.0; cp = cp * r2 + 1.0 / 24.0; cp = cp * r2 - 0.5; cp = cp * r2 + 1.0;
    const int qd = (int)((long long)k & 3);
    const double cc = (qd == 0) ? cp : (qd == 1) ? -sp : (qd == 2) ? -cp : sp;
    const double ss = (qd == 0) ? sp : (qd == 1) ? cp : (qd == 2) ? -sp : -cp;
    c = (float)cc; s = (float)ss;
}

constexpr int IT_W1 = 32 * (N1 / 32), IT_WUQ = 8 * 48, IT_WUKV = 8 * 64, IT_WBR = 16 * 64, IT_WOUT = 32 * 64, IT_WF1 = 32 * (2 * DFF / 32), IT_WF2 = (DFF / 64) * 64;
constexpr int IT_LAYER = IT_W1 + IT_WUQ + IT_WUKV + 3 * IT_WBR + IT_WOUT + IT_WF1 + IT_WF2;

__device__ __forceinline__ void p0_weights(const Ins& in, unsigned char* ws, LAS unsigned char* lds, int gw, int NGW, int wave, int lane) {
    LAS float* scr = (LAS float*)(lds + wave * 16384);
#pragma unroll 1
    for (int it = gw; it < DEPTH * IT_LAYER; it += NGW) {
        const int l = it / IT_LAYER; int r = it - l * IT_LAYER;
        unsigned char* wl = ws + WS_W + (size_t)l * W_LAYER;
        if (r < IT_W1) { const int nbk = N1 / 32; transpose_item(in.w_in + (size_t)l * DM * DIN, DIN, (bf16_t*)(wl + WO_W1), DM, 0, 0, scr, r / nbk, r % nbk, lane); continue; } r -= IT_W1;
        if (r < IT_WUQ) { transpose_item(in.w_uq + (size_t)l * 512 * 1536, 1536, (bf16_t*)(wl + WO_WUQ), 512, 0, 1, scr, r / 48, r % 48, lane); continue; } r -= IT_WUQ;
        if (r < IT_WUKV) { transpose_item(in.w_ukv + (size_t)l * 512 * 2048, 2048, (bf16_t*)(wl + WO_WUKV), 512, 0, 3, scr, r / 64, r % 64, lane); continue; } r -= IT_WUKV;
        if (r < 3 * IT_WBR) { const int br = r / IT_WBR; r -= br * IT_WBR;
            transpose_item(in.w_branch + ((size_t)l * 3 + br) * 1024 * DM, DM, (bf16_t*)(wl + WO_WBR), 3072, br * 1024, 3, scr, r / 64, r % 64, lane); continue; } r -= 3 * IT_WBR;
        if (r < IT_WOUT) { transpose_item(in.w_out + (size_t)l * DM * DM, DM, (bf16_t*)(wl + WO_WOUT), DM, 0, 3, scr, r / 64, r % 64, lane); continue; } r -= IT_WOUT;
        if (r < IT_WF1) { const int nbk = 2 * DFF / 32; transpose_item(in.w_f1 + (size_t)l * DM * 2 * DFF, 2 * DFF, (bf16_t*)(wl + WO_WF1), DM, 0, 2, scr, r / nbk, r % nbk, lane); continue; } r -= IT_WF1;
        transpose_item(in.w_f2 + (size_t)l * DFF * DM, DM, (bf16_t*)(wl + WO_WF2), DFF, 0, 3, scr, r / 64, r % 64, lane);
    }
}
__device__ __forceinline__ void p0_rope(float* rope, int gtid, int ngt) {
    for (int idx = gtid; idx < LSEQ * 32; idx += ngt) {
        const int t = idx >> 5, i = idx & 31;
        double pwd = 1.0; for (int e = 0; e < i; ++e) pwd *= 1.3335214321633240;
        const float pw = (float)pwd;
        const float inv = 1.0f / pw;
        const float ang = (float)t * inv;
        float c, s; sincos_d((double)ang, c, s);
        rope[idx * 2] = c; rope[idx * 2 + 1] = s;
    }
}

__device__ __forceinline__ void t_norm(int mode, bool last, const Ins& in, float* H, const float* MIX, bf16_t* HN, float* out, const float* gpost, const float* gpre, int gw, int NGW, int lane) {
    asm volatile("" : "+v"(lane));
#pragma unroll 1
    for (int r = gw; r < MP; r += NGW) {
        f32x4 v[8];
        if (mode == 0) {
            const float* src = r < MREAL ? in.x + (size_t)r * DM : (r < MTOK ? in.meta + (size_t)((r - MREAL) & 15) * DM : nullptr);
#pragma unroll
            for (int j = 0; j < 8; ++j) v[j] = src ? *(const f32x4*)(src + 256 * j + 4 * lane) : (f32x4){0.f, 0.f, 0.f, 0.f};
        } else {
            f32x4 m[8]; float ss = 0.f;
#pragma unroll
            for (int j = 0; j < 8; ++j) { m[j] = *(const f32x4*)(MIX + (size_t)r * DM + 256 * j + 4 * lane); ss += (m[j][0] * m[j][0] + m[j][1] * m[j][1]) + (m[j][2] * m[j][2] + m[j][3] * m[j][3]); }
            const float rstd = 1.0f / sqrtf(wave_sum(ss) * (1.0f / DM) + EPS);
#pragma unroll
            for (int j = 0; j < 8; ++j) { const f32x4 g = *(const f32x4*)(gpost + 256 * j + 4 * lane); const f32x4 hb = *(const f32x4*)(H + (size_t)r * DM + 256 * j + 4 * lane); v[j] = hb + (m[j] * rstd) * g; }
        }
        if (last) {
            if (r < MREAL) {
#pragma unroll
                for (int j = 0; j < 8; ++j) *(f32x4*)(out + (size_t)r * DM + 256 * j + 4 * lane) = v[j];
            }
            continue;
        }
        float ss = 0.f;
#pragma unroll
        for (int j = 0; j < 8; ++j) { *(f32x4*)(H + (size_t)r * DM + 256 * j + 4 * lane) = v[j]; ss += (v[j][0] * v[j][0] + v[j][1] * v[j][1]) + (v[j][2] * v[j][2] + v[j][3] * v[j][3]); }
        const float rstd = 1.0f / sqrtf(wave_sum(ss) * (1.0f / DM) + EPS);
#pragma unroll
        for (int j = 0; j < 8; ++j) { const f32x4 g = *(const f32x4*)(gpre + 256 * j + 4 * lane); const f32x4 y = (v[j] * rstd) * g; st_bf4(HN + (size_t)r * DM + 256 * j + 4 * lane, y); }
    }
}

__device__ __forceinline__ void t1_phase(int l, const Ins& in, const bf16_t* PROJ, const float* MISC, bf16_t* CQN, bf16_t* CKVN, bf16_t* KA, bf16_t* OCAT, float* CB, const float* rope, LAS float* scr, int gw, int NGW, int lane) {
    asm volatile("" : "+v"(lane));
    if (gw < 32) {
        const int b = gw >> 3, h = gw & 7; const float bias = in.b_forget[l * NH + h];
        {
            float x[33];
#pragma unroll
            for (int c = 0; c < 33; ++c) { const int t = c * 64 + lane; x[c] = t < LSEQ ? MISC[(size_t)row_of(b, t) * 128 + 64 + h] + bias : 0.f; }
#pragma unroll
            for (int c = 0; c < 33; ++c) scr[c * 64 + lane] = x[c];
        }
        LDS_WAIT(); asm volatile("" ::: "memory");
        float carry = 0.f;
#pragma unroll 1
        for (int c = 0; c < 33; ++c) { const int t = c * 64 + lane; const float xv = scr[c * 64 + lane];
            float lf = fminf(xv, 0.f) - log1pf(expf(-fabsf(xv))); if (t >= LSEQ) lf = 0.f;
#pragma unroll
            for (int o = 1; o < 64; o <<= 1) { const float y = __shfl_up(lf, o); if (lane >= o) lf += y; }
            lf += carry; carry = __shfl(lf, 63);
            if (t < LSEQ) CB[gw * CBLD + t] = lf; }
    }
    const float* gq = in.g_q + l * 512; const float* gkv = in.g_kv + l * 512; const float* cw = in.conv_w + (size_t)l * 3 * 1024;
#pragma unroll 1
    for (int r = gw; r < MP; r += NGW) {
        {
            const int half = lane >> 5, c0 = (lane & 31) * 16;
            const bf16_t* src = PROJ + (size_t)r * N1 + half * 512 + c0;
            const u32x4 a = *(const u32x4*)src, b = *(const u32x4*)(src + 8);
            float v[16] = {bflo(a.x), bfhi(a.x), bflo(a.y), bfhi(a.y), bflo(a.z), bfhi(a.z), bflo(a.w), bfhi(a.w), bflo(b.x), bfhi(b.x), bflo(b.y), bfhi(b.y), bflo(b.z), bfhi(b.z), bflo(b.w), bfhi(b.w)};
            float ss = 0.f;
#pragma unroll
            for (int e = 0; e < 16; ++e) ss += v[e] * v[e];
#pragma unroll
            for (int o = 1; o < 32; o <<= 1) ss += __shfl_xor(ss, o);
            const float rstd = 1.0f / sqrtf(ss * (1.0f / 512.0f) + EPS);
            const float* g = (half ? gkv : gq) + c0;
            u32x4 o0, o1;
            o0.x = cvtpk(v[0] * rstd * g[0], v[1] * rstd * g[1]); o0.y = cvtpk(v[2] * rstd * g[2], v[3] * rstd * g[3]); o0.z = cvtpk(v[4] * rstd * g[4], v[5] * rstd * g[5]); o0.w = cvtpk(v[6] * rstd * g[6], v[7] * rstd * g[7]);
            o1.x = cvtpk(v[8] * rstd * g[8], v[9] * rstd * g[9]); o1.y = cvtpk(v[10] * rstd * g[10], v[11] * rstd * g[11]); o1.z = cvtpk(v[12] * rstd * g[12], v[13] * rstd * g[13]); o1.w = cvtpk(v[14] * rstd * g[14], v[15] * rstd * g[15]);
            bf16_t* dst = (half ? CKVN : CQN) + (size_t)r * 512 + c0;
            *(u32x4*)dst = o0; *(u32x4*)(dst + 8) = o1;
        }
        if (r >= MTOK) continue;
        const int t = t_of(r), b = r < MREAL ? (r >> 11) : ((r - MREAL) >> 4);
        if (lane < 32) {
            const float x1 = MISC[(size_t)r * 128 + lane], x2 = MISC[(size_t)r * 128 + 32 + lane];
            const f32x2 cs = *(const f32x2*)(rope + ((size_t)t * 32 + lane) * 2);
            const unsigned w = cvtpk(x1 * cs[0] - x2 * cs[1], x1 * cs[1] + x2 * cs[0]);
#pragma unroll
            for (int h = 0; h < NH; ++h) *(unsigned*)(KA + (size_t)r * 1536 + h * HQK + 128 + 2 * lane) = w;
        }
        {
            const int c0 = lane * 16; float acc[16];
#pragma unroll
            for (int e = 0; e < 16; ++e) acc[e] = 0.f;
#pragma unroll
            for (int kk = 0; kk < 3; ++kk) {
                const int tt = t - 2 + kk; if (tt < 0) continue;
                const size_t rr = (size_t)row_of(b, tt);
                const u32x4 c0v = *(const u32x4*)(PROJ + rr * N1 + PC_CONVC + c0), c1v = *(const u32x4*)(PROJ + rr * N1 + PC_CONVC + c0 + 8);
                const u32x4 x0v = *(const u32x4*)(PROJ + rr * N1 + PC_CONVX + c0), x1v = *(const u32x4*)(PROJ + rr * N1 + PC_CONVX + c0 + 8);
                const float* w = cw + kk * 1024 + c0;
                const unsigned cc[8] = {c0v.x, c0v.y, c0v.z, c0v.w, c1v.x, c1v.y, c1v.z, c1v.w}; const unsigned xx[8] = {x0v.x, x0v.y, x0v.z, x0v.w, x1v.x, x1v.y, x1v.z, x1v.w};
#pragma unroll
                for (int e = 0; e < 8; ++e) { acc[2 * e] += w[2 * e] * (bflo(cc[e]) * bflo(xx[e])); acc[2 * e + 1] += w[2 * e + 1] * (bfhi(cc[e]) * bfhi(xx[e])); }
            }
            const u32x4 b0v = *(const u32x4*)(PROJ + (size_t)r * N1 + PC_CONVB + c0), b1v = *(const u32x4*)(PROJ + (size_t)r * N1 + PC_CONVB + c0 + 8);
            const unsigned bb[8] = {b0v.x, b0v.y, b0v.z, b0v.w, b1v.x, b1v.y, b1v.z, b1v.w};
            unsigned o[8];
#pragma unroll
            for (int e = 0; e < 8; ++e) o[e] = cvtpk(bflo(bb[e]) * acc[2 * e], bfhi(bb[e]) * acc[2 * e + 1]);
            bf16_t* dst = OCAT + (size_t)r * 3072 + 1024 + c0;
            *(u32x4*)dst = (u32x4){o[0], o[1], o[2], o[3]}; *(u32x4*)(dst + 8) = (u32x4){o[4], o[5], o[6], o[7]};
        }
    }
}

__device__ __forceinline__ void attn_naive(LAS unsigned char* lds, const bf16_t* PROJ, const bf16_t* QA, const bf16_t* KA, const bf16_t* VA, const float* CB, bf16_t* OCAT, int gw, int NGW, int wave, int lane) {
    asm volatile("" : "+v"(lane));
    LAS float* sc = (LAS float*)lds + wave * 2304; LAS float* qs = sc + 2112;
#pragma unroll 1
    for (int it = gw; it < 2 * NBATCH * NH * LSEQ; it += NGW) {
        const int t = it % LSEQ; const int r_ = it / LSEQ; const int h = r_ & 7, b = (r_ >> 3) & 3, ty = r_ >> 5;
        const int row = row_of(b, t); const int dk = ty ? 128 : HQK;
        const bf16_t* qp = ty ? PROJ + (size_t)row * N1 + PC_FQ + h * 128 : QA + (size_t)row * 1536 + h * HQK;
        const bf16_t* kbase = ty ? PROJ + PC_FK + h * 128 : KA + h * HQK; const int ldk = ty ? N1 : 1536;
        const bf16_t* vbase = ty ? PROJ + PC_FV + h * 128 : VA + h * 128; const int ldv = ty ? N1 : 1024;
        const float scale = ty ? 0.08838834764831845f : 0.07216878364870323f;
        const float* cb = CB + (b * NH + h) * CBLD;
        for (int d = lane; d < dk; d += 64) qs[d] = bf2f(qp[d]);
        LDS_WAIT(); asm volatile("" ::: "memory");
        const float ct = ty ? cb[t] : 0.f;
        float mx = -1e30f;
#pragma unroll 1
        for (int s = lane; s <= t; s += 64) {
            const bf16_t* kp = kbase + (size_t)row_of(b, s) * ldk; float dot = 0.f;
#pragma unroll 4
            for (int d8 = 0; d8 < dk; d8 += 8) { const u32x4 kv = *(const u32x4*)(kp + d8);
                dot += qs[d8] * bflo(kv.x) + qs[d8 + 1] * bfhi(kv.x) + qs[d8 + 2] * bflo(kv.y) + qs[d8 + 3] * bfhi(kv.y) + qs[d8 + 4] * bflo(kv.z) + qs[d8 + 5] * bfhi(kv.z) + qs[d8 + 6] * bflo(kv.w) + qs[d8 + 7] * bfhi(kv.w); }
            float v = dot * scale; if (ty) v += ct - cb[s];
            sc[s] = v; mx = fmaxf(mx, v);
        }
        mx = wave_max(mx);
        float sum = 0.f;
        for (int s = lane; s <= t; s += 64) { const float p = __expf(sc[s] - mx); sc[s] = p; sum += p; }
        sum = wave_sum(sum);
        LDS_WAIT(); asm volatile("" ::: "memory");
        float a0 = 0.f, a1 = 0.f;
#pragma unroll 4
        for (int s = 0; s <= t; ++s) { const float p = sc[s]; const unsigned w = *(const unsigned*)(vbase + (size_t)row_of(b, s) * ldv + 2 * lane); a0 += p * bflo(w); a1 += p * bfhi(w); }
        const float inv = 1.0f / sum;
        *(unsigned*)(OCAT + (size_t)row * 3072 + (ty ? 2048 : 0) + h * 128 + 2 * lane) = cvtpk(a0 * inv, a1 * inv);
        LDS_WAIT(); asm volatile("" ::: "memory");
    }
}

struct Args { const float* in[17]; float* out; unsigned char* ws; int ph_lo, ph_hi; };
__global__ void __launch_bounds__(NTHREADS, 2) fwd(Args args) {
    extern __shared__ __attribute__((aligned(16))) unsigned char lds_raw[];
    LAS unsigned char* lds = (LAS unsigned char*)lds_raw;
    volatile LAS unsigned* MISCW = (volatile LAS unsigned*)(lds + MISC_OFF);
    const int tid = threadIdx.x, lane = tid & 63, wave = __builtin_amdgcn_readfirstlane(tid >> 6);
    const int G = gridDim.x, bid = blockIdx.x;
    const int gw = bid * NWAVES + wave, NGW = G * NWAVES;
    unsigned char* ws = args.ws;
    Ins in; in.x = args.in[0]; in.meta = args.in[1]; in.w_in = args.in[2]; in.b_forget = args.in[3]; in.g_q = args.in[4]; in.g_kv = args.in[5]; in.w_uq = args.in[6]; in.w_ukv = args.in[7];
    in.conv_w = args.in[8]; in.w_branch = args.in[9]; in.w_out = args.in[10]; in.w_f1 = args.in[11]; in.w_f2 = args.in[12]; in.g_mix_pre = args.in[13]; in.g_mix_post = args.in[14]; in.g_ffn_pre = args.in[15]; in.g_ffn_post = args.in[16];
    float* H = (float*)(ws + WS_H); bf16_t* HN = (bf16_t*)(ws + WS_HN); bf16_t* PROJ = (bf16_t*)(ws + WS_PROJ); float* MISC = (float*)(ws + WS_MISC);
    bf16_t* CQN = (bf16_t*)(ws + WS_CQN); bf16_t* CKVN = (bf16_t*)(ws + WS_CKVN); bf16_t* QA = (bf16_t*)(ws + WS_QA); bf16_t* KA = (bf16_t*)(ws + WS_KA); bf16_t* VA = (bf16_t*)(ws + WS_VA);
    float* CB = (float*)(ws + WS_CB); bf16_t* OCAT = (bf16_t*)(ws + WS_OCAT); float* MIXF = (float*)(ws + WS_MIXF); bf16_t* MERGED = (bf16_t*)(ws + WS_MERGED); bf16_t* ACT = (bf16_t*)(ws + WS_ACT);
    float* ROPE = (float*)(ws + WS_ROPE);

    for (int u = tid; u < (LDS_BYTES - RING_BYTES) / 4; u += NTHREADS) ((LAS unsigned*)(lds + RING_BYTES))[u] = 0u;
    __syncthreads();
    const int lo = args.ph_lo, hi = args.ph_hi;
    XcdBarrier bar; bar.bar = (unsigned*)(ws + WS_CTL) + 4096; bar.x = 0; bar.st = nullptr;
    if (hi - lo > 1) bar = xcd_barrier_post((unsigned*)(ws + WS_CTL) + 4096, MISCW + 8);
#ifndef SKIPMASK
#define SKIPMASK 0
#endif
#define IN(k) (lo <= (k) && (k) < hi && !((SKIPMASK >> ((k) == 0 ? 0 : 1 + ((k) - 1) % 10)) & 1))
#define SEAM(k) do { if (IN(k) && IN((k) + 1)) xcd_barrier(bar); } while (0)

    if (IN(0)) {
        p0_weights(in, ws, lds, gw, NGW, wave, lane);
        p0_rope(ROPE, bid * NTHREADS + tid, G * NTHREADS);
        t_norm(0, false, in, H, nullptr, HN, nullptr, nullptr, in.g_mix_pre, gw, NGW, lane);
    }
    SEAM(0);
#pragma unroll 1
    for (int l = 0; l < DEPTH; ++l) {
        const int pb = 1 + 10 * l;
        const unsigned char* wl = ws + WS_W + (size_t)l * W_LAYER;
        if (IN(pb + 0)) {
            SchedPlain S{(const char*)HN, (const char*)(wl + WO_W1), DM, DM, N1T, G, bid}; EpiG1 E{PROJ, MISC};
            run_gemm(lds, DM, DM, DM, S, E);
        }
        SEAM(pb + 0);
        if (IN(pb + 1)) t1_phase(l, in, PROJ, MISC, CQN, CKVN, KA, OCAT, CB, ROPE, (LAS float*)(lds + wave * 16384), gw, NGW, lane);
        SEAM(pb + 1);
        if (IN(pb + 2)) {
            SchedG2 S{(const char*)CKVN, (const char*)(wl + WO_WUKV), (const char*)CQN, (const char*)(wl + WO_WUQ), G, bid}; EpiG2 E{QA, KA, VA, ROPE};
            run_gemm(lds, 512, 512, 512, S, E);
        }
        SEAM(pb + 2);
        if (IN(pb + 3)) attn_naive(lds, PROJ, QA, KA, VA, CB, OCAT, gw, NGW, wave, lane);
        SEAM(pb + 3);
        if (IN(pb + 4)) {
            SchedG3 S{(const char*)OCAT, (const char*)(wl + WO_WBR), G, bid}; EpiG3 E{PROJ, MIXF, MERGED};
            run_gemm(lds, 1024, 3072, 3072, S, E);
        }
        SEAM(pb + 4);
        if (IN(pb + 5)) {
            SchedPlain S{(const char*)MERGED, (const char*)(wl + WO_WOUT), DM, DM, 8, G, bid}; EpiF32 E{MIXF};
            run_gemm(lds, DM, DM, DM, S, E);
        }
        SEAM(pb + 5);
        if (IN(pb + 6)) t_norm(1, false, in, H, MIXF, HN, nullptr, in.g_mix_post + l * DM, in.g_ffn_pre + l * DM, gw, NGW, lane);
        SEAM(pb + 6);
        if (IN(pb + 7)) {
            SchedPlain S{(const char*)HN, (const char*)(wl + WO_WF1), DM, DM, 2 * DFF / 256, G, bid}; EpiG5 E{ACT};
            run_gemm(lds, DM, DM, DM, S, E);
        }
        SEAM(pb + 7);
        if (IN(pb + 8)) {
            SchedPlain S{(const char*)ACT, (const char*)(wl + WO_WF2), DFF, DFF, 8, G, bid}; EpiF32 E{MIXF};
            run_gemm(lds, DFF, DFF, DFF, S, E);
        }
        SEAM(pb + 8);
        if (IN(pb + 9)) t_norm(1, l == DEPTH - 1, in, H, MIXF, HN, args.out, in.g_ffn_post + l * DM, in.g_mix_pre + (l + 1 < DEPTH ? l + 1 : 0) * DM, gw, NGW, lane);
        SEAM(pb + 9);
    }
#undef IN
#undef SEAM
}

extern "C" void kernel_launch(void* const* d_in, const int* in_sizes, int n_in, void* d_out, int out_size, void* d_ws, size_t ws_size, hipStream_t stream) {
    static int grid = 0;
    if (grid == 0) {
        if (n_in != 17 || out_size != MREAL * DM || ws_size < WS_END) { fprintf(stderr, "kernel_launch: unexpected shapes: n_in %d out %d ws %zu (need %zu)\n", n_in, out_size, ws_size, (size_t)WS_END); grid = -1; return; }
        int dev = 0, cus = 0, per_cu = 0;
        if (hipGetDevice(&dev) != hipSuccess || hipDeviceGetAttribute(&cus, hipDeviceAttributeMultiprocessorCount, dev) != hipSuccess) { grid = -1; return; }
        if (hipFuncSetAttribute((const void*)fwd, hipFuncAttributeMaxDynamicSharedMemorySize, LDS_BYTES) != hipSuccess) { fprintf(stderr, "kernel_launch: hipFuncSetAttribute failed\n"); grid = -1; return; }
        if (hipOccupancyMaxActiveBlocksPerMultiprocessor(&per_cu, (const void*)fwd, NTHREADS, LDS_BYTES) != hipSuccess || per_cu < 1) fprintf(stderr, "kernel_launch: occupancy query says %d\n", per_cu);
        (void)hipGetLastError();
        grid = cus;
    }
    if (grid < 0) return;
    (void)hipMemsetAsync((char*)d_ws + WS_CTL, 0, CTL_ZERO_BYTES, stream);
    Args a{};
    for (int i = 0; i < 17; ++i) a.in[i] = (const float*)d_in[i];
    a.out = (float*)d_out; a.ws = (unsigned char*)d_ws;
#if MK_ONE_LAUNCH
    a.ph_lo = 0; a.ph_hi = NPHASES;
    hipLaunchKernelGGL(fwd, dim3(grid), dim3(NTHREADS), LDS_BYTES, stream, a);
#else
    for (int p = 0; p < NPHASES; ++p) { a.ph_lo = p; a.ph_hi = p + 1; hipLaunchKernelGGL(fwd, dim3(grid), dim3(NTHREADS), LDS_BYTES, stream, a); }
#endif
}
```

```cpp
#include <hip/hip_runtime.h>
#include <cstdio>
#include <cstdint>

#ifndef MK_ONE_LAUNCH
#define MK_ONE_LAUNCH 1
#endif
#ifndef FAST_GEMM
#define FAST_GEMM 1
#endif
#ifndef FAST_ATTN
#define FAST_ATTN 1
#endif

#define GAS __attribute__((address_space(1)))
#define LAS __attribute__((address_space(3)))
typedef unsigned short bf16_t;
typedef short bf16x8 __attribute__((ext_vector_type(8)));
typedef float f32x4 __attribute__((ext_vector_type(4)));
typedef float f32x2 __attribute__((ext_vector_type(2)));
typedef unsigned u32x4 __attribute__((ext_vector_type(4)));
typedef unsigned u32x2 __attribute__((ext_vector_type(2)));
typedef __bf16 bf16x2_t __attribute__((ext_vector_type(2)));

constexpr int DM = 2048, NBATCH = 4, SEQ = 2048, DEPTH = 4, NMETA = 16, LSEQ = SEQ + NMETA;
constexpr int MREAL = NBATCH * SEQ;
constexpr int MTOK = MREAL + NBATCH * NMETA;
constexpr int MP = 8448, NPM = MP / 256;
constexpr int DIN = 13384, N1 = 13568, N1T = N1 / 256;
constexpr int DFF = 5632, NH = 8, HQK = 192;
constexpr float EPS = 1e-6f;
constexpr int PC_CQ = 0, PC_CKV = 512, PC_MISC = 1024, PC_CONVB = 1280, PC_CONVC = 2304, PC_CONVX = 3328, PC_FQ = 4352, PC_FK = 5376, PC_FV = 6400, PC_GATE = 7424;
constexpr int CBLD = 2112;

constexpr size_t al256(size_t x) { return (x + 255) & ~(size_t)255; }
constexpr size_t WS_CTL = 0, CTL_ZERO_BYTES = 1u << 20;
constexpr size_t SZ_W1 = (size_t)N1 * DM * 2, SZ_WUQ = (size_t)1536 * 512 * 2, SZ_WUKV = (size_t)2048 * 512 * 2, SZ_WBR = (size_t)DM * 3072 * 2,
                 SZ_WOUT = (size_t)DM * DM * 2, SZ_WF1 = (size_t)2 * DFF * DM * 2, SZ_WF2 = (size_t)DM * DFF * 2;
constexpr size_t WO_W1 = 0, WO_WUQ = WO_W1 + SZ_W1, WO_WUKV = WO_WUQ + SZ_WUQ, WO_WBR = WO_WUKV + SZ_WUKV, WO_WOUT = WO_WBR + SZ_WBR,
                 WO_WF1 = WO_WOUT + SZ_WOUT, WO_WF2 = WO_WF1 + SZ_WF1, W_LAYER = WO_WF2 + SZ_WF2;
constexpr size_t WS_W = CTL_ZERO_BYTES;
constexpr size_t WS_H = al256(WS_W + DEPTH * W_LAYER);
constexpr size_t WS_HN = al256(WS_H + (size_t)MP * DM * 4);
constexpr size_t WS_PROJ = al256(WS_HN + (size_t)MP * DM * 2);
constexpr size_t WS_MISC = al256(WS_PROJ + (size_t)MP * N1 * 2);
constexpr size_t WS_CQN = al256(WS_MISC + (size_t)MP * 128 * 4);
constexpr size_t WS_CKVN = al256(WS_CQN + (size_t)MP * 512 * 2);
constexpr size_t WS_QA = al256(WS_CKVN + (size_t)MP * 512 * 2);
constexpr size_t WS_KA = al256(WS_QA + (size_t)MP * 1536 * 2);
constexpr size_t WS_VA = al256(WS_KA + (size_t)MP * 1536 * 2);
constexpr size_t WS_CB = al256(WS_VA + (size_t)MP * 1024 * 2);
constexpr size_t WS_OCAT = al256(WS_CB + (size_t)32 * CBLD * 4);
constexpr size_t WS_MIXF = al256(WS_OCAT + (size_t)MP * 3072 * 2);
constexpr size_t WS_MERGED = al256(WS_MIXF + (size_t)MP * DM * 4);
constexpr size_t WS_ACT = al256(WS_MERGED + (size_t)MP * DM * 2);
constexpr size_t WS_ROPE = al256(WS_ACT + (size_t)MP * DFF * 2);
constexpr size_t WS_END = al256(WS_ROPE + (size_t)LSEQ * 32 * 2 * 4);

constexpr int NWAVES = 8, NTHREADS = NWAVES * 64;
constexpr int LDS_BYTES = 147456;
constexpr int RING_BYTES = 131072, MISC_OFF = RING_BYTES + 320;
constexpr int NPHASES = 1 + 10 * DEPTH;

__device__ __forceinline__ unsigned cvtpk(float lo, float hi) { f32x2 v = {lo, hi}; bf16x2_t b = __builtin_convertvector(v, bf16x2_t); return __builtin_bit_cast(unsigned, b); }
__device__ __forceinline__ float bf2f(unsigned short u) { return __uint_as_float((unsigned)u << 16); }
__device__ __forceinline__ float bflo(unsigned w) { return __uint_as_float(w << 16); }
__device__ __forceinline__ float bfhi(unsigned w) { return __uint_as_float(w & 0xffff0000u); }
__device__ __forceinline__ float wave_sum(float v) {
#pragma unroll
    for (int o = 1; o < 64; o <<= 1) v += __shfl_xor(v, o);
    return v;
}
__device__ __forceinline__ float wave_max(float v) {
#pragma unroll
    for (int o = 1; o < 64; o <<= 1) v = fmaxf(v, __shfl_xor(v, o));
    return v;
}
__device__ __forceinline__ float sigmoidf_(float x) { return __builtin_amdgcn_rcpf(1.0f + __builtin_amdgcn_exp2f(-1.4426950408889634f * x)); }
__device__ __forceinline__ int row_of(int b, int t) { return t < NMETA ? MREAL + b * NMETA + t : b * SEQ + t - NMETA; }
__device__ __forceinline__ int t_of(int r) { return r < MREAL ? NMETA + (r & (SEQ - 1)) : (r < MTOK ? ((r - MREAL) & (NMETA - 1)) : 0); }
#define LDS_WAIT() asm volatile("s_waitcnt lgkmcnt(0)" ::: "memory")
#define VM_WAIT() asm volatile("s_waitcnt vmcnt(0)" ::: "memory")

#define XB_TMO      128
#define XB_XCNT(j)  (256  + 64 * (j))
#define XB_XSUB(j)  (1280 + 64 * (j))
#define XB_XGEN(j)  (2304 + 64 * (j))
#define XB_TOP      3328
#define XB_TOPGEN   3392
#define XCD_BAR_WORDS 3456
#define XB_SPIN_CAP (1u << 18)
__device__ __forceinline__ unsigned xb_ld(unsigned* p)              { return __hip_atomic_load(p, __ATOMIC_RELAXED, __HIP_MEMORY_SCOPE_AGENT); }
__device__ __forceinline__ unsigned xb_add(unsigned* p, unsigned v) { return __hip_atomic_fetch_add(p, v, __ATOMIC_RELAXED, __HIP_MEMORY_SCOPE_AGENT); }
__device__ __forceinline__ unsigned xb_xcc_id() { return (unsigned)__builtin_amdgcn_s_getreg((3 << 11) | 20) & 0xFu; }
#define XB_SPIN(cond, bar) do { unsigned _sp = 0; while (cond) { __builtin_amdgcn_s_sleep(1); \
    if ((++_sp & 255u) == 0u) { if (xb_ld(&(bar)[XB_TMO])) break; if (_sp > XB_SPIN_CAP) { atomicAdd(&(bar)[XB_TMO], 1u); break; } } } } while (0)
struct XcdBarrier { unsigned* bar; unsigned x; volatile LAS unsigned* st; };
__device__ __forceinline__ XcdBarrier xcd_barrier_post(unsigned* bar, volatile LAS unsigned* st) {
    XcdBarrier b; b.bar = bar; b.x = xb_xcc_id(); b.st = st;
    if (threadIdx.x == 0) (void)xb_add(&bar[XB_XCNT(b.x)], 1u);
    return b;
}
__device__ __forceinline__ void xcd_barrier_complete(unsigned* bar, unsigned x, unsigned& nloc, unsigned& nx) {
    const unsigned G = gridDim.x * gridDim.y * gridDim.z;
    unsigned sum, cnt, mine, sp = 0u;
    for (;;) {
        sum = 0u; cnt = 0u; mine = 0u;
#pragma unroll
        for (unsigned j = 0; j < 16; ++j) { const unsigned c = xb_ld(&bar[XB_XCNT(j)]); sum += c; cnt += (c > 0u) ? 1u : 0u; mine = (j == x) ? c : mine; }
        if (sum == G) break;
        __builtin_amdgcn_s_sleep(1);
        if ((++sp & 255u) == 0u) { if (xb_ld(&bar[XB_TMO])) break; if (sp > XB_SPIN_CAP) { atomicAdd(&bar[XB_TMO], 1u); break; } }
    }
    nloc = mine > 0u ? mine : 1u; nx = cnt > 0u ? cnt : 1u;
}
__device__ __forceinline__ void xcd_barrier(const XcdBarrier& b) {
    asm volatile("s_waitcnt vmcnt(0)" ::: "memory");
    __syncthreads();
    if (threadIdx.x == 0) {
        unsigned* bar = b.bar; asm volatile("" : "+s"(bar));
        __builtin_amdgcn_s_waitcnt(0);
        unsigned nloc = b.st[0], nx = b.st[1];
        if (nloc == 0u) { xcd_barrier_complete(bar, b.x, nloc, nx); b.st[0] = nloc; b.st[1] = nx; }
        const unsigned old = xb_add(&bar[XB_XSUB(b.x)], 1u);
        const unsigned gen = old / nloc;
        if (old + 1u == (gen + 1u) * nloc) {
            __builtin_amdgcn_fence(__ATOMIC_RELEASE, "agent");
            asm volatile("s_waitcnt vmcnt(0)" ::: "memory");
            const unsigned og = xb_add(&bar[XB_TOP], 1u);
            const unsigned tg = og / nx;
            if (og + 1u == (tg + 1u) * nx) xb_add(&bar[XB_TOPGEN], 1u);
            else XB_SPIN(xb_ld(&bar[XB_TOPGEN]) == tg, bar);
            __builtin_amdgcn_fence(__ATOMIC_ACQUIRE, "agent");
            xb_add(&bar[XB_XGEN(b.x)], 1u);
            asm volatile("s_waitcnt vmcnt(0)" ::: "memory");
        } else {
            XB_SPIN(xb_ld(&bar[XB_XGEN(b.x)]) == gen, bar);
            __builtin_amdgcn_fence(__ATOMIC_ACQUIRE, "agent");
            asm volatile("s_waitcnt vmcnt(0)" ::: "memory");
        }
    }
    __syncthreads();
}

struct Unit { int pm, pn, tag; const char* A; const char* B; };

__device__ __forceinline__ void tile_decode(int L, int nM, int nN, int& pm, int& pn) {
    const int nwg = nM * nN; int wgid = L;
    { const int q = nwg / 8, r = nwg % 8, xcd = wgid % 8, off = wgid / 8; wgid = (xcd < r ? xcd * (q + 1) : r * (q + 1) + (xcd - r) * q) + off; }
    const int nig = 8 * nN, gid = wgid / nig, fm = gid * 8, gsz = (nM - fm) < 8 ? (nM - fm) : 8;
    pm = fm + ((wgid % nig) % gsz); pn = (wgid % nig) / gsz;
}
struct SchedPlain {
    const char* A; const char* B; int lda, ldb, nN, G, c;
    __device__ __forceinline__ bool next(int i, Unit& u) const {
        const int L = i * G + c; if (L >= NPM * nN) return false;
        tile_decode(L, NPM, nN, u.pm, u.pn); u.tag = 0;
        u.A = A + (size_t)u.pm * 256 * lda * 2; u.B = B + (size_t)u.pn * 256 * ldb * 2; return true;
    }
};
struct SchedG2 {
    const char* Akv; const char* Bkv; const char* Aq; const char* Bq; int G, c;
    __device__ __forceinline__ bool next(int i, Unit& u) const {
        int L = i * G + c; if (L >= NPM * 14) return false;
        if (L < NPM * 8) { tile_decode(L, NPM, 8, u.pm, u.pn); u.tag = 0; u.A = Akv + (size_t)u.pm * 256 * 1024; u.B = Bkv + (size_t)u.pn * 256 * 1024; }
        else { L -= NPM * 8; tile_decode(L, NPM, 6, u.pm, u.pn); u.tag = 1; u.A = Aq + (size_t)u.pm * 256 * 1024; u.B = Bq + (size_t)u.pn * 256 * 1024; }
        return true;
    }
};
struct SchedG3 {
    const char* A; const char* B; int G, c;
    __device__ __forceinline__ bool next(int i, Unit& u) const {
        const int br = i % 3, L = (i / 3) * G + c; if (L >= NPM * 8) return false;
        tile_decode(L, NPM, 8, u.pm, u.pn); u.tag = br;
        u.A = A + ((size_t)u.pm * 256 * 3072 + br * 1024) * 2; u.B = B + ((size_t)u.pn * 256 * 3072 + br * 1024) * 2; return true;
    }
};

__device__ __forceinline__ void st_bf4(bf16_t* p, f32x4 v) { u32x2 w; w.x = cvtpk(v[0], v[1]); w.y = cvtpk(v[2], v[3]); *(u32x2*)p = w; }
struct EpiG1 {
    bf16_t* proj; float* misc;
    __device__ __forceinline__ void operator()(int, int row, int pn, int cj, f32x4 lo, f32x4 hi) const {
        if (pn >= PC_GATE / 256) {
#pragma unroll
            for (int e = 0; e < 4; ++e) { lo[e] = sigmoidf_(lo[e]); hi[e] = sigmoidf_(hi[e]); }
        }
        bf16_t* p = proj + (size_t)row * N1 + pn * 256 + cj;
        st_bf4(p, lo); st_bf4(p + 128, hi);
        if (pn == PC_MISC / 256) *(f32x4*)(misc + (size_t)row * 128 + cj) = lo;
    }
};
struct EpiG2 {
    bf16_t* qa; bf16_t* ka; bf16_t* va; const float* rope;
    __device__ __forceinline__ void qcols(int row, int col, f32x4 v) const {
        const int h = col / HQK, j = col - h * HQK;
        if (j >= 128) {
            const int i0 = (j - 128) >> 1; const float* rp = rope + ((size_t)t_of(row) * 32 + i0) * 2;
            const f32x4 cs = *(const f32x4*)rp;
            v = (f32x4){v[0] * cs[0] - v[1] * cs[1], v[0] * cs[1] + v[1] * cs[0], v[2] * cs[2] - v[3] * cs[3], v[2] * cs[3] + v[3] * cs[2]};
        }
        st_bf4(qa + (size_t)row * 1536 + col, v);
    }
    __device__ __forceinline__ void operator()(int tag, int row, int pn, int cj, f32x4 lo, f32x4 hi) const {
        if (tag == 0) { st_bf4(ka + (size_t)row * 1536 + pn * HQK + cj, lo); st_bf4(va + (size_t)row * 1024 + pn * 128 + cj, hi); }
        else { qcols(row, pn * 256 + cj, lo); qcols(row, pn * 256 + 128 + cj, hi); }
    }
};
struct EpiG3 {
    const bf16_t* proj; float* part; bf16_t* merged;
    __device__ __forceinline__ void one(int tag, int row, int col, f32x4 v) const {
        const u32x2 g = *(const u32x2*)(proj + (size_t)row * N1 + PC_GATE + tag * DM + col);
        v = (f32x4){v[0] * bflo(g.x), v[1] * bfhi(g.x), v[2] * bflo(g.y), v[3] * bfhi(g.y)};
        float* pp = part + (size_t)row * DM + col;
        if (tag > 0) v += *(const f32x4*)pp;
        if (tag < 2) *(f32x4*)pp = v; else st_bf4(merged + (size_t)row * DM + col, v);
    }
    __device__ __forceinline__ void operator()(int tag, int row, int pn, int cj, f32x4 lo, f32x4 hi) const { one(tag, row, pn * 256 + cj, lo); one(tag, row, pn * 256 + 128 + cj, hi); }
};
struct EpiF32 {
    float* out;
    __device__ __forceinline__ void operator()(int, int row, int pn, int cj, f32x4 lo, f32x4 hi) const {
        float* p = out + (size_t)row * DM + pn * 256 + cj; *(f32x4*)p = lo; *(f32x4*)(p + 128) = hi;
    }
};
struct EpiG5 {
    bf16_t* act;
    __device__ __forceinline__ void operator()(int, int row, int pn, int cj, f32x4 lo, f32x4 hi) const {
        f32x4 v;
#pragma unroll
        for (int e = 0; e < 4; ++e) v[e] = lo[e] * sigmoidf_(lo[e]) * hi[e];
        st_bf4(act + (size_t)row * DFF + pn * 128 + cj, v);
    }
};

template <class EF, class Sched>
__device__ __forceinline__ void gemm_simple(int K, int lda, int ldb, const Sched& S, const EF& E) {
    const int tid = threadIdx.x, wid = tid >> 6, lane = tid & 63, wr = wid >> 2, q = wid & 3, fr = lane & 15, fq = lane >> 4;
    Unit u;
#pragma unroll 1
    for (int i = 0; S.next(i, u); ++i) {
        const bf16_t* Ab = (const bf16_t*)u.A; const bf16_t* Bb = (const bf16_t*)u.B;
#pragma unroll 1
        for (int rb = 0; rb < 8; ++rb) {
            const int rloc = wr * 128 + rb * 16 + fr;
            f32x4 acc[4] = {};
            const bf16_t* ap = Ab + (size_t)rloc * lda + fq * 8;
            const bf16_t* bp[4];
#pragma unroll
            for (int n = 0; n < 4; ++n) bp[n] = Bb + (size_t)((n >> 1) * 128 + q * 32 + (n & 1) * 16 + fr) * ldb + fq * 8;
#pragma unroll 2
            for (int k = 0; k < K; k += 32) {
                const bf16x8 a = *(const bf16x8*)(ap + k);
#pragma unroll
                for (int n = 0; n < 4; ++n) { const bf16x8 b = *(const bf16x8*)(bp[n] + k); acc[n] = __builtin_amdgcn_mfma_f32_16x16x32_bf16(b, a, acc[n], 0, 0, 0); }
            }
            const int row = u.pm * 256 + rloc;
#pragma unroll
            for (int n = 0; n < 2; ++n) E(u.tag, row, u.pn, q * 32 + n * 16 + 4 * fq, acc[n], acc[2 + n]);
        }
    }
}

namespace pg8 {
constexpr int BK = 64, HALF = 128, HTB = HALF * BK * 2, STAGE_BYTES = 8 * HTB;
__device__ __forceinline__ int lds_byte(int r, int c) { const int st = (r >> 4) * 2 + (c >> 5), rr = r & 15, cc = c & 31, ob = rr * 64 + cc * 2; return st * 1024 + (ob ^ (((ob >> 9) & 1) << 5)); }
__device__ __forceinline__ void stage_rc(int b, int& R, int& C) { const int st = b / 1024, sb = b % 1024, swz = sb ^ (((sb >> 9) & 1) << 5); R = (st >> 1) * 16 + swz / 64; C = (st & 1) * 32 + (swz % 64) / 2; }

template <class EF, class Sched, bool ALIGN_EPI>
__device__ __forceinline__ void gemm_phase(LAS unsigned char* lds, const int K, const int lda, const int ldb, const Sched& S, const EF& E) {
    int tid = threadIdx.x; asm volatile("" : "+v"(tid));
    const int wid = __builtin_amdgcn_readfirstlane(tid >> 6), lane = tid & 63, wr = wid >> 2, wc = wid & 3, fr = lane & 15, fq = lane >> 4;
    const int nt = K / BK;
    unsigned voffA[2], voffB[2];
#pragma unroll
    for (int i = 0; i < 2; ++i) { int R, C; stage_rc(tid * 16 + i * 8192, R, C); voffA[i] = (unsigned)(R * lda + C) * 2u; voffB[i] = (unsigned)(R * ldb + C) * 2u; }
    const size_t kstep = (size_t)(BK * 2);
    const size_t hstepA = (size_t)HALF * lda * 2, hstepB = (size_t)HALF * ldb * 2;
    const unsigned ldsw = (unsigned)wid * 1024u;
    const int aoff = lds_byte(wr * 64 + fr, fq * 8), boff = lds_byte(wc * 32 + fr, fq * 8);
#define PG8_SA(b, h) (((b) * 2 + (h)) * HTB)
#define PG8_SB(b, h) ((4 + (b) * 2 + (h)) * HTB)
#define PG8_STAGE(bufoff, gbase, voff) do { _Pragma("unroll") for (int _i = 0; _i < 2; ++_i) \
        __builtin_amdgcn_global_load_lds((const unsigned*)((const char*)(gbase) + (voff)[_i]), (LAS unsigned*)(lds + (bufoff) + ldsw + _i * 8192), 16, 0, 0); } while (0)
#define PG8_LDA(dst, b, h) do { _Pragma("unroll") for (int m = 0; m < 4; ++m) _Pragma("unroll") for (int k = 0; k < 2; ++k) dst[m][k] = *(const LAS bf16x8*)(lds + PG8_SA(b, h) + aoff + m * 2048 + k * 1024); } while (0)
#define PG8_LDB(dst, b, h) do { _Pragma("unroll") for (int n = 0; n < 2; ++n) _Pragma("unroll") for (int k = 0; k < 2; ++k) dst[n][k] = *(const LAS bf16x8*)(lds + PG8_SB(b, h) + boff + n * 2048 + k * 1024); } while (0)
#define PG8_MMA(ai, bj, At, Bt) do { __builtin_amdgcn_s_setprio(1); _Pragma("unroll") for (int m = 0; m < 4; ++m) _Pragma("unroll") for (int n = 0; n < 2; ++n) _Pragma("unroll") for (int k = 0; k < 2; ++k) \
        acc[ai][bj][m][n] = __builtin_amdgcn_mfma_f32_16x16x32_bf16(Bt[n][k], At[m][k], acc[ai][bj][m][n], 0, 0, 0); __builtin_amdgcn_s_setprio(0); } while (0)
#define PG8_WAIT_V(n) asm volatile("s_waitcnt vmcnt(" #n ")" ::: "memory")
#define PG8_WAIT_L(n) asm volatile("s_waitcnt lgkmcnt(" #n ")" ::: "memory")
#define PG8_BAR __builtin_amdgcn_s_barrier()
#define PG8_SCHED __builtin_amdgcn_sched_barrier(0)
    Unit cur, nxt; int ui = 0;
    if (!S.next(0, cur)) return;
    f32x4 acc[2][2][4][2];
#pragma unroll
    for (int a = 0; a < 2; ++a)
#pragma unroll
        for (int b = 0; b < 2; ++b)
#pragma unroll
            for (int m = 0; m < 4; ++m)
#pragma unroll
                for (int n = 0; n < 2; ++n) acc[a][b][m][n] = (f32x4){0.f, 0.f, 0.f, 0.f};
    bf16x8 At[4][2], B0[2][2], B1[2][2];
    const char* cA = cur.A; const char* cB = cur.B;
    PG8_STAGE(PG8_SB(0, 0), cB, voffB); PG8_STAGE(PG8_SB(0, 1), cB + hstepB, voffB); PG8_STAGE(PG8_SA(0, 0), cA, voffA); PG8_STAGE(PG8_SA(0, 1), cA + hstepA, voffA);
    if (wr == 1) PG8_BAR;
    PG8_WAIT_V(2); PG8_BAR;
    PG8_STAGE(PG8_SB(1, 0), cB + kstep, voffB); PG8_STAGE(PG8_SA(1, 0), cA + kstep, voffA); PG8_STAGE(PG8_SB(1, 1), cB + hstepB + kstep, voffB);
    PG8_WAIT_V(6); PG8_BAR;
    for (;;) {
        const bool has_next = S.next(ui + 1, nxt);
        const char* nA = has_next ? nxt.A : cA; const char* nB = has_next ? nxt.B : cB;
        for (int t = 0; t < nt; t += 2) {
            const bool last = (t == nt - 2);
            const char* a1 = cA + (size_t)(t + 1) * kstep;
            const char* a2 = last ? nA : cA + (size_t)(t + 2) * kstep; const char* b2 = last ? nB : cB + (size_t)(t + 2) * kstep;
            const char* a3 = a2 + kstep; const char* b3 = b2 + kstep;
            PG8_LDB(B0, 0, 0); PG8_LDB(B1, 0, 1); PG8_SCHED; PG8_LDA(At, 0, 0); PG8_STAGE(PG8_SA(1, 1), a1 + hstepA, voffA);
            PG8_WAIT_V(8); PG8_WAIT_L(0); PG8_BAR; PG8_MMA(0, 0, At, B0); PG8_MMA(0, 1, At, B1); PG8_BAR; PG8_SCHED;
            PG8_LDA(At, 0, 1); PG8_STAGE(PG8_SB(0, 0), b2, voffB); PG8_STAGE(PG8_SB(0, 1), b2 + hstepB, voffB); PG8_STAGE(PG8_SA(0, 0), a2, voffA);
            PG8_WAIT_V(8); PG8_WAIT_L(0); PG8_BAR; PG8_MMA(1, 0, At, B0); PG8_MMA(1, 1, At, B1); PG8_BAR; PG8_SCHED;
            PG8_LDB(B0, 1, 0); PG8_LDB(B1, 1, 1); PG8_SCHED; PG8_LDA(At, 1, 0); PG8_STAGE(PG8_SA(0, 1), a2 + hstepA, voffA);
            PG8_WAIT_V(8); PG8_WAIT_L(0); PG8_BAR; PG8_MMA(0, 0, At, B0); PG8_MMA(0, 1, At, B1); PG8_BAR; PG8_SCHED;
            PG8_LDA(At, 1, 1); PG8_STAGE(PG8_SB(1, 0), b3, voffB); PG8_STAGE(PG8_SB(1, 1), b3 + hstepB, voffB); PG8_STAGE(PG8_SA(1, 0), a3, voffA);
            PG8_WAIT_V(8); PG8_WAIT_L(0); PG8_BAR; PG8_MMA(1, 0, At, B0); PG8_MMA(1, 1, At, B1); PG8_BAR; PG8_SCHED;
        }
        if constexpr (ALIGN_EPI) { if (wr == 0) PG8_BAR; }
        {
#pragma unroll
            for (int ai = 0; ai < 2; ++ai)
#pragma unroll
                for (int m = 0; m < 4; ++m) { const int row = cur.pm * 256 + ai * HALF + wr * 64 + m * 16 + fr;
#pragma unroll
                    for (int n = 0; n < 2; ++n) E(cur.tag, row, cur.pn, wc * 32 + n * 16 + 4 * fq, acc[ai][0][m][n], acc[ai][1][m][n]); }
        }
        if (!has_next) break;
#pragma unroll
        for (int a = 0; a < 2; ++a)
#pragma unroll
            for (int b = 0; b < 2; ++b)
#pragma unroll
                for (int m = 0; m < 4; ++m)
#pragma unroll
                    for (int n = 0; n < 2; ++n) acc[a][b][m][n] = (f32x4){0.f, 0.f, 0.f, 0.f};
        cur = nxt; cA = nA; cB = nB; ++ui;
        if constexpr (ALIGN_EPI) { if (wr == 1) PG8_BAR; }
    }
    PG8_WAIT_V(0);
    if constexpr (!ALIGN_EPI) { if (wr == 0) PG8_BAR; }
    PG8_BAR;
#undef PG8_SA
#undef PG8_SB
#undef PG8_STAGE
#undef PG8_LDA
#undef PG8_LDB
#undef PG8_MMA
#undef PG8_WAIT_V
#undef PG8_WAIT_L
#undef PG8_BAR
#undef PG8_SCHED
}
}

template <class EF, class Sched>
__device__ __forceinline__ void run_gemm(LAS unsigned char* lds, int K, int lda, int ldb, const Sched& S, const EF& E) {
#if FAST_GEMM
    pg8::gemm_phase<EF, Sched, true>(lds, K, lda, ldb, S, E);
#else
    gemm_simple<EF, Sched>(K, lda, ldb, S, E);
#endif
}

__device__ __forceinline__ int perm_col(int kind, int n) {
    if (kind == 0) {
        if (n < 1024) return n;
        if (n < 1280) { const int j = n - 1024; return j < 64 ? 1024 + j : (j < 72 ? 7232 + (j - 64) : -1); }
        if (n < PC_FQ) return 1088 + (n - 1280);
        if (n < PC_GATE) return 4160 + (n - PC_FQ);
        return 7240 + (n - PC_GATE);
    }
    if (kind == 1) {
        const int h = n / HQK, j = n - h * HQK; if (j < 128) return n; const int p = j - 128; return h * HQK + 128 + (p >> 1) + 32 * (p & 1);
    }
    if (kind == 2) {
        const int tl = n >> 8, j = n & 255; return j < 128 ? tl * 128 + j : DFF + tl * 128 + (j - 128);
    }
    return n;
}
__device__ __forceinline__ void transpose_item(const float* W, int Nsrc, bf16_t* WT, int ldd, int koff, int kind, LAS float* scr, int kb, int nb, int lane) {
    const int k0 = 64 * kb, n0 = 32 * nb; const int sc = perm_col(kind, n0 + (lane & 31));
#pragma unroll 8
    for (int i = 0; i < 32; ++i) { const int kk = 2 * i + (lane >> 5); scr[kk * 33 + (lane & 31)] = sc >= 0 ? W[(size_t)(k0 + kk) * Nsrc + sc] : 0.f; }
    LDS_WAIT(); asm volatile("" ::: "memory");
    const int c = lane & 7;
#pragma unroll
    for (int j = 0; j < 4; ++j) { const int n = (lane >> 3) + 8 * j; const LAS float* s = scr + (8 * c) * 33 + n;
        u32x4 o; o.x = cvtpk(s[0 * 33], s[1 * 33]); o.y = cvtpk(s[2 * 33], s[3 * 33]); o.z = cvtpk(s[4 * 33], s[5 * 33]); o.w = cvtpk(s[6 * 33], s[7 * 33]);
        *(u32x4*)(WT + (size_t)(n0 + n) * ldd + koff + k0 + 8 * c) = o; }
    LDS_WAIT(); asm volatile("" ::: "memory");
}
struct Ins { const float *x, *meta, *w_in, *b_forget, *g_q, *g_kv, *w_uq, *w_ukv, *conv_w, *w_branch, *w_out, *w_f1, *w_f2, *g_mix_pre, *g_mix_post, *g_ffn_pre, *g_ffn_post; };

__device__ __forceinline__ void sincos_d(double x, float& c, float& s) {
    const double k = __builtin_rint(x * 0.63661977236758134308);
    const double r = (x - k * 1.57079632679489655800e+00) - k * 6.12323399573676603587e-17;
    const double r2 = r * r;
    double sp = -1.0 / 1307674368000.0; sp = sp * r2 + 1.0 / 6227020800.0; sp = sp * r2 - 1.0 / 39916800.0; sp = sp * r2 + 1.0 / 362880.0; sp = sp * r2 - 1.0 / 5040.0; sp = sp * r2 + 1.0 / 120.0; sp = sp * r2 - 1.0 / 6.0; sp = sp * r2 + 1.0; sp *= r;
    double cp = 1.0 / 20922789888000.0; cp = cp * r2 - 1.0 / 87178291200.0; cp = cp * r2 + 1.0 / 479001600.0; cp = cp * r2 - 1.0 / 3628800.0; cp = cp * r2 + 1.0 / 40320.0; cp = cp * r2 - 1.0 / 720.0; cp = cp * r2 + 1.0 / 24.0; cp = cp * r2 - 0.5; cp = cp * r2 + 1.0;
    const int qd = (int)((long long)k & 3);
    const double cc = (qd == 0) ? cp : (qd == 1) ? -sp : (qd == 2) ? -cp : sp;
    const double ss = (qd == 0) ? sp : (qd == 1) ? cp : (qd == 2) ? -sp : -cp;
    c = (float)cc; s = (float)ss;
}

constexpr int IT_W1 = 32 * (N1 / 32), IT_WUQ = 8 * 48, IT_WUKV = 8 * 64, IT_WBR = 16 * 64, IT_WOUT = 32 * 64, IT_WF1 = 32 * (2 * DFF / 32), IT_WF2 = (DFF / 64) * 64;
constexpr int IT_LAYER = IT_W1 + IT_WUQ + IT_WUKV + 3 * IT_WBR + IT_WOUT + IT_WF1 + IT_WF2;

__device__ __forceinline__ void p0_weights(const Ins& in, unsigned char* ws, LAS unsigned char* lds, int gw, int NGW, int wave, int lane) {
    LAS float* scr = (LAS float*)(lds + wave * 16384);
#pragma unroll 1
    for (int it = gw; it < DEPTH * IT_LAYER; it += NGW) {
        const int l = it / IT_LAYER; int r = it - l * IT_LAYER;
        unsigned char* wl = ws + WS_W + (size_t)l * W_LAYER;
        if (r < IT_W1) { const int nbk = N1 / 32; transpose_item(in.w_in + (size_t)l * DM * DIN, DIN, (bf16_t*)(wl + WO_W1), DM, 0, 0, scr, r / nbk, r % nbk, lane); continue; } r -= IT_W1;
        if (r < IT_WUQ) { transpose_item(in.w_uq + (size_t)l * 512 * 1536, 1536, (bf16_t*)(wl + WO_WUQ), 512, 0, 1, scr, r / 48, r % 48, lane); continue; } r -= IT_WUQ;
        if (r < IT_WUKV) { transpose_item(in.w_ukv + (size_t)l * 512 * 2048, 2048, (bf16_t*)(wl + WO_WUKV), 512, 0, 3, scr, r / 64, r % 64, lane); continue; } r -= IT_WUKV;
        if (r < 3 * IT_WBR) { const int br = r / IT_WBR; r -= br * IT_WBR;
            transpose_item(in.w_branch + ((size_t)l * 3 + br) * 1024 * DM, DM, (bf16_t*)(wl + WO_WBR), 3072, br * 1024, 3, scr, r / 64, r % 64, lane); continue; } r -= 3 * IT_WBR;
        if (r < IT_WOUT) { transpose_item(in.w_out + (size_t)l * DM * DM, DM, (bf16_t*)(wl + WO_WOUT), DM, 0, 3, scr, r / 64, r % 64, lane); continue; } r -= IT_WOUT;
        if (r < IT_WF1) { const int nbk = 2 * DFF / 32; transpose_item(in.w_f1 + (size_t)l * DM * 2 * DFF, 2 * DFF, (bf16_t*)(wl + WO_WF1), DM, 0, 2, scr, r / nbk, r % nbk, lane); continue; } r -= IT_WF1;
        transpose_item(in.w_f2 + (size_t)l * DFF * DM, DM, (bf16_t*)(wl + WO_WF2), DFF, 0, 3, scr, r / 64, r % 64, lane);
    }
}
__device__ __forceinline__ void p0_rope(float* rope, int gtid, int ngt) {
    for (int idx = gtid; idx < LSEQ * 32; idx += ngt) {
        const int t = idx >> 5, i = idx & 31;
        double pwd = 1.0; for (int e = 0; e < i; ++e) pwd *= 1.3335214321633240;
        const float pw = (float)pwd;
        const float inv = 1.0f / pw;
        const float ang = (float)t * inv;
        float c, s; sincos_d((double)ang, c, s);
        rope[idx * 2] = c; rope[idx * 2 + 1] = s;
    }
}

__device__ __forceinline__ void t_norm(int mode, bool last, const Ins& in, float* H, const float* MIX, bf16_t* HN, float* out, const float* gpost, const float* gpre, int gw, int NGW, int lane) {
    asm volatile("" : "+v"(lane));
#pragma unroll 1
    for (int r = gw; r < MP; r += NGW) {
        f32x4 v[8];
        if (mode == 0) {
            const float* src = r < MREAL ? in.x + (size_t)r * DM : (r < MTOK ? in.meta + (size_t)((r - MREAL) & 15) * DM : nullptr);
#pragma unroll
            for (int j = 0; j < 8; ++j) v[j] = src ? *(const f32x4*)(src + 256 * j + 4 * lane) : (f32x4){0.f, 0.f, 0.f, 0.f};
        } else {
            f32x4 m[8]; float ss = 0.f;
#pragma unroll
            for (int j = 0; j < 8; ++j) { m[j] = *(const f32x4*)(MIX + (size_t)r * DM + 256 * j + 4 * lane); ss += (m[j][0] * m[j][0] + m[j][1] * m[j][1]) + (m[j][2] * m[j][2] + m[j][3] * m[j][3]); }
            const float rstd = 1.0f / sqrtf(wave_sum(ss) * (1.0f / DM) + EPS);
#pragma unroll
            for (int j = 0; j < 8; ++j) { const f32x4 g = *(const f32x4*)(gpost + 256 * j + 4 * lane); const f32x4 hb = *(const f32x4*)(H + (size_t)r * DM + 256 * j + 4 * lane); v[j] = hb + (m[j] * rstd) * g; }
        }
        if (last) {
            if (r < MREAL) {
#pragma unroll
                for (int j = 0; j < 8; ++j) *(f32x4*)(out + (size_t)r * DM + 256 * j + 4 * lane) = v[j];
            }
            continue;
        }
        float ss = 0.f;
#pragma unroll
        for (int j = 0; j < 8; ++j) { *(f32x4*)(H + (size_t)r * DM + 256 * j + 4 * lane) = v[j]; ss += (v[j][0] * v[j][0] + v[j][1] * v[j][1]) + (v[j][2] * v[j][2] + v[j][3] * v[j][3]); }
        const float rstd = 1.0f / sqrtf(wave_sum(ss) * (1.0f / DM) + EPS);
#pragma unroll
        for (int j = 0; j < 8; ++j) { const f32x4 g = *(const f32x4*)(gpre + 256 * j + 4 * lane); const f32x4 y = (v[j] * rstd) * g; st_bf4(HN + (size_t)r * DM + 256 * j + 4 * lane, y); }
    }
}

__device__ __forceinline__ void t1_phase(int l, const Ins& in, const bf16_t* PROJ, const float* MISC, bf16_t* CQN, bf16_t* CKVN, bf16_t* KA, bf16_t* OCAT, float* CB, const float* rope, LAS float* scr, int gw, int NGW, int lane) {
    asm volatile("" : "+v"(lane));
    if (gw < 32) {
        const int b = gw >> 3, h = gw & 7; const float bias = in.b_forget[l * NH + h];
        {
            float x[33];
#pragma unroll
            for (int c = 0; c < 33; ++c) { const int t = c * 64 + lane; x[c] = t < LSEQ ? MISC[(size_t)row_of(b, t) * 128 + 64 + h] + bias : 0.f; }
#pragma unroll
            for (int c = 0; c < 33; ++c) scr[c * 64 + lane] = x[c];
        }
        LDS_WAIT(); asm volatile("" ::: "memory");
        float carry = 0.f;
#pragma unroll 1
        for (int c = 0; c < 33; ++c) { const int t = c * 64 + lane; const float xv = scr[c * 64 + lane];
            float lf = fminf(xv, 0.f) - log1pf(expf(-fabsf(xv))); if (t >= LSEQ) lf = 0.f;
#pragma unroll
            for (int o = 1; o < 64; o <<= 1) { const float y = __shfl_up(lf, o); if (lane >= o) lf += y; }
            lf += carry; carry = __shfl(lf, 63);
            if (t < LSEQ) CB[gw * CBLD + t] = lf; }
    }
    const float* gq = in.g_q + l * 512; const float* gkv = in.g_kv + l * 512; const float* cw = in.conv_w + (size_t)l * 3 * 1024;
#pragma unroll 1
    for (int r = gw; r < MP; r += NGW) {
        {
            const int half = lane >> 5, c0 = (lane & 31) * 16;
            const bf16_t* src = PROJ + (size_t)r * N1 + half * 512 + c0;
            const u32x4 a = *(const u32x4*)src, b = *(const u32x4*)(src + 8);
            float v[16] = {bflo(a.x), bfhi(a.x), bflo(a.y), bfhi(a.y), bflo(a.z), bfhi(a.z), bflo(a.w), bfhi(a.w), bflo(b.x), bfhi(b.x), bflo(b.y), bfhi(b.y), bflo(b.z), bfhi(b.z), bflo(b.w), bfhi(b.w)};
            float ss = 0.f;
#pragma unroll
            for (int e = 0; e < 16; ++e) ss += v[e] * v[e];
#pragma unroll
            for (int o = 1; o < 32; o <<= 1) ss += __shfl_xor(ss, o);
            const float rstd = 1.0f / sqrtf(ss * (1.0f / 512.0f) + EPS);
            const float* g = (half ? gkv : gq) + c0;
            u32x4 o0, o1;
            o0.x = cvtpk(v[0] * rstd * g[0], v[1] * rstd * g[1]); o0.y = cvtpk(v[2] * rstd * g[2], v[3] * rstd * g[3]); o0.z = cvtpk(v[4] * rstd * g[4], v[5] * rstd * g[5]); o0.w = cvtpk(v[6] * rstd * g[6], v[7] * rstd * g[7]);
            o1.x = cvtpk(v[8] * rstd * g[8], v[9] * rstd * g[9]); o1.y = cvtpk(v[10] * rstd * g[10], v[11] * rstd * g[11]); o1.z = cvtpk(v[12] * rstd * g[12], v[13] * rstd * g[13]); o1.w = cvtpk(v[14] * rstd * g[14], v[15] * rstd * g[15]);
            bf16_t* dst = (half ? CKVN : CQN) + (size_t)r * 512 + c0;
            *(u32x4*)dst = o0; *(u32x4*)(dst + 8) = o1;
        }
        if (r >= MTOK) continue;
        const int t = t_of(r), b = r < MREAL ? (r >> 11) : ((r - MREAL) >> 4);
        if (lane < 32) {
            const float x1 = MISC[(size_t)r * 128 + lane], x2 = MISC[(size_t)r * 128 + 32 + lane];
            const f32x2 cs = *(const f32x2*)(rope + ((size_t)t * 32 + lane) * 2);
            const unsigned w = cvtpk(x1 * cs[0] - x2 * cs[1], x1 * cs[1] + x2 * cs[0]);
#pragma unroll
            for (int h = 0; h < NH; ++h) *(unsigned*)(KA + (size_t)r * 1536 + h * HQK + 128 + 2 * lane) = w;
        }
        {
            const int c0 = lane * 16; float acc[16];
#pragma unroll
            for (int e = 0; e < 16; ++e) acc[e] = 0.f;
#pragma unroll
            for (int kk = 0; kk < 3; ++kk) {
                const int tt = t - 2 + kk; if (tt < 0) continue;
                const size_t rr = (size_t)row_of(b, tt);
                const u32x4 c0v = *(const u32x4*)(PROJ + rr * N1 + PC_CONVC + c0), c1v = *(const u32x4*)(PROJ + rr * N1 + PC_CONVC + c0 + 8);
                const u32x4 x0v = *(const u32x4*)(PROJ + rr * N1 + PC_CONVX + c0), x1v = *(const u32x4*)(PROJ + rr * N1 + PC_CONVX + c0 + 8);
                const float* w = cw + kk * 1024 + c0;
                const unsigned cc[8] = {c0v.x, c0v.y, c0v.z, c0v.w, c1v.x, c1v.y, c1v.z, c1v.w}; const unsigned xx[8] = {x0v.x, x0v.y, x0v.z, x0v.w, x1v.x, x1v.y, x1v.z, x1v.w};
#pragma unroll
                for (int e = 0; e < 8; ++e) { acc[2 * e] += w[2 * e] * (bflo(cc[e]) * bflo(xx[e])); acc[2 * e + 1] += w[2 * e + 1] * (bfhi(cc[e]) * bfhi(xx[e])); }
            }
            const u32x4 b0v = *(const u32x4*)(PROJ + (size_t)r * N1 + PC_CONVB + c0), b1v = *(const u32x4*)(PROJ + (size_t)r * N1 + PC_CONVB + c0 + 8);
            const unsigned bb[8] = {b0v.x, b0v.y, b0v.z, b0v.w, b1v.x, b1v.y, b1v.z, b1v.w};
            unsigned o[8];
#pragma unroll
            for (int e = 0; e < 8; ++e) o[e] = cvtpk(bflo(bb[e]) * acc[2 * e], bfhi(bb[e]) * acc[2 * e + 1]);
            bf16_t* dst = OCAT + (size_t)r * 3072 + 1024 + c0;
            *(u32x4*)dst = (u32x4){o[0], o[1], o[2], o[3]}; *(u32x4*)(dst + 8) = (u32x4){o[4], o[5], o[6], o[7]};
        }
    }
}

__device__ __forceinline__ void attn_naive(LAS unsigned char* lds, const bf16_t* PROJ, const bf16_t* QA, const bf16_t* KA, const bf16_t* VA, const float* CB, bf16_t* OCAT, int tmax, int gw, int NGW, int wave, int lane) {
    asm volatile("" : "+v"(lane));
    LAS float* sc = (LAS float*)lds + wave * 2304; LAS float* qs = sc + 2112;
#pragma unroll 1
    for (int it = gw; it < 2 * NBATCH * NH * tmax; it += NGW) {
        const int t = it % tmax; const int r_ = it / tmax; const int h = r_ & 7, b = (r_ >> 3) & 3, ty = r_ >> 5;
        const int row = row_of(b, t); const int dk = ty ? 128 : HQK;
        const bf16_t* qp = ty ? PROJ + (size_t)row * N1 + PC_FQ + h * 128 : QA + (size_t)row * 1536 + h * HQK;
        const bf16_t* kbase = ty ? PROJ + PC_FK + h * 128 : KA + h * HQK; const int ldk = ty ? N1 : 1536;
        const bf16_t* vbase = ty ? PROJ + PC_FV + h * 128 : VA + h * 128; const int ldv = ty ? N1 : 1024;
        const float scale = ty ? 0.08838834764831845f : 0.07216878364870323f;
        const float* cb = CB + (b * NH + h) * CBLD;
        for (int d = lane; d < dk; d += 64) qs[d] = bf2f(qp[d]);
        LDS_WAIT(); asm volatile("" ::: "memory");
        const float ct = ty ? cb[t] : 0.f;
        float mx = -1e30f;
#pragma unroll 1
        for (int s = lane; s <= t; s += 64) {
            const bf16_t* kp = kbase + (size_t)row_of(b, s) * ldk; float dot = 0.f;
#pragma unroll 4
            for (int d8 = 0; d8 < dk; d8 += 8) { const u32x4 kv = *(const u32x4*)(kp + d8);
                dot += qs[d8] * bflo(kv.x) + qs[d8 + 1] * bfhi(kv.x) + qs[d8 + 2] * bflo(kv.y) + qs[d8 + 3] * bfhi(kv.y) + qs[d8 + 4] * bflo(kv.z) + qs[d8 + 5] * bfhi(kv.z) + qs[d8 + 6] * bflo(kv.w) + qs[d8 + 7] * bfhi(kv.w); }
            float v = dot * scale; if (ty) v += ct - cb[s];
            sc[s] = v; mx = fmaxf(mx, v);
        }
        mx = wave_max(mx);
        float sum = 0.f;
        for (int s = lane; s <= t; s += 64) { const float p = __expf(sc[s] - mx); sc[s] = p; sum += p; }
        sum = wave_sum(sum);
        LDS_WAIT(); asm volatile("" ::: "memory");
        float a0 = 0.f, a1 = 0.f;
#pragma unroll 4
        for (int s = 0; s <= t; ++s) { const float p = sc[s]; const unsigned w = *(const unsigned*)(vbase + (size_t)row_of(b, s) * ldv + 2 * lane); a0 += p * bflo(w); a1 += p * bfhi(w); }
        const float inv = 1.0f / sum;
        *(unsigned*)(OCAT + (size_t)row * 3072 + (ty ? 2048 : 0) + h * 128 + 2 * lane) = cvtpk(a0 * inv, a1 * inv);
        LDS_WAIT(); asm volatile("" ::: "memory");
    }
}

namespace fa {
constexpr int NW = 8, QBLK = 32, KVBLK = 64, QB = NW * QBLK, DV = 128;
constexpr int SHM_V = KVBLK * DV * 2;
typedef short s16x4 __attribute__((ext_vector_type(4)));
typedef float f32x16 __attribute__((ext_vector_type(16)));
#define FA_SBAR() __builtin_amdgcn_sched_barrier(0)
__device__ __forceinline__ int v_st(int k, int c) { const int kk = (k & ~0xC) | ((k & 4) << 1) | ((k & 8) >> 1); return ((kk >> 3) * 4 + (c >> 5)) * 512 + ((kk & 7) * 32 + (c & 31)) * 2; }
__device__ __forceinline__ int v_rd_base(int lane) { return ((lane & 3) << 3) | (((lane >> 2) & 3) << 6) | (((lane >> 4) & 1) << 5) | (((lane >> 5) & 1) << 8); }
constexpr int v_rd_off(int d0, int ks, int half) { return d0 * 512 + ks * 4096 + half * 2048; }
__device__ __forceinline__ int crow(int r, int hi) { return (r & 3) + 8 * (r >> 2) + 4 * hi; }
__device__ __forceinline__ unsigned cvtpk_a(float lo, float hi) { unsigned r; asm volatile("v_cvt_pk_bf16_f32 %0, %1, %2" : "=v"(r) : "v"(lo), "v"(hi)); return r; }
__device__ __forceinline__ void mask_tile(f32x16& p0, f32x16& p1, int dq) {
    const float NEG = -__builtin_inff();
#pragma unroll
    for (int r = 0; r < 16; ++r) { const int c = (r & 3) + 8 * (r >> 2); if (dq - c < 0) p0[r] = NEG; if (dq - c - 32 < 0) p1[r] = NEG; }
}
__device__ __forceinline__ void mask_meta(f32x16& p0, f32x16& p1) {
    const float NEG = -__builtin_inff();
#pragma unroll
    for (int r = 8; r < 16; ++r) p0[r] = NEG;
#pragma unroll
    for (int r = 0; r < 16; ++r) p1[r] = NEG;
}
__device__ __forceinline__ void partialSM(f32x16& p0, f32x16& p1, float& m_reg, float& mn, float& alpha, const float SCALE) {
    float pmax = p0[0];
#pragma unroll
    for (int r = 1; r < 16; ++r) pmax = fmaxf(pmax, p0[r]);
#pragma unroll
    for (int r = 0; r < 16; ++r) pmax = fmaxf(pmax, p1[r]);
    { auto rr = __builtin_amdgcn_permlane32_swap(__float_as_uint(pmax), __float_as_uint(pmax), false, false); pmax = fmaxf(__uint_as_float(rr[0]), __uint_as_float(rr[1])); }
    const float C2 = 1.4426950408889634f * SCALE;
    if (__builtin_expect(__all((pmax - m_reg) * SCALE <= 8.f), 1)) { mn = m_reg; alpha = 1.f; }
    else { mn = fmaxf(m_reg, pmax); alpha = __builtin_amdgcn_exp2f((m_reg - mn) * C2); m_reg = mn; }
    const float mnL = -mn * C2;
#pragma unroll
    for (int r = 0; r < 16; ++r) p0[r] = fmaf(p0[r], C2, mnL);
#pragma unroll
    for (int r = 0; r < 16; ++r) p1[r] = fmaf(p1[r], C2, mnL);
#pragma unroll
    for (int r = 0; r < 16; ++r) p0[r] = __builtin_amdgcn_exp2f(p0[r]);
}
__device__ __forceinline__ void finishSM(f32x16& p0, f32x16& p1, float alpha, float& l_reg, bf16x8& pa0, bf16x8& pa1, bf16x8& pa2, bf16x8& pa3) {
#pragma unroll
    for (int r = 0; r < 16; ++r) p1[r] = __builtin_amdgcn_exp2f(p1[r]);
    float ps = 0;
#pragma unroll
    for (int r = 0; r < 16; ++r) ps += p0[r];
#pragma unroll
    for (int r = 0; r < 16; ++r) ps += p1[r];
    { auto rr = __builtin_amdgcn_permlane32_swap(__float_as_uint(ps), __float_as_uint(ps), false, false); ps = __uint_as_float(rr[0]) + __uint_as_float(rr[1]); }
    l_reg = l_reg * alpha + ps;
#define FA_PK4(P, B_, OUT) do { unsigned a0 = cvtpk_a(P[B_+0], P[B_+1]), a1 = cvtpk_a(P[B_+2], P[B_+3]); unsigned b0 = cvtpk_a(P[B_+4], P[B_+5]), b1 = cvtpk_a(P[B_+6], P[B_+7]); \
        auto r0 = __builtin_amdgcn_permlane32_swap(a0, b0, false, false); auto r1 = __builtin_amdgcn_permlane32_swap(a1, b1, false, false); \
        u32x4 w = {r0[0], r1[0], r0[1], r1[1]}; OUT = *reinterpret_cast<bf16x8*>(&w); } while (0)
    FA_PK4(p0, 0, pa0); FA_PK4(p0, 8, pa1); FA_PK4(p1, 0, pa2); FA_PK4(p1, 8, pa3);
#undef FA_PK4
}
template <int DK> __device__ __forceinline__ int kswz(int row, int colB) { return row * (2 * DK) + (colB ^ ((row & 7) << 4)); }
template <int DK, int KB, bool BIAS>
__device__ __forceinline__ void qkt(f32x16& p0, f32x16& p1, const char* K_lds, const float* bias_lds, int r32, int hi, const bf16x8* qr) {
    constexpr int SHM_K = KVBLK * DK * 2;
    if constexpr (BIAS) {
        const float* bp = bias_lds + KB * 64 + 4 * hi;
#pragma unroll
        for (int g = 0; g < 4; ++g) { const f32x4 a = *(const f32x4*)(bp + 8 * g), b = *(const f32x4*)(bp + 32 + 8 * g);
            p0[4 * g] = a[0]; p0[4 * g + 1] = a[1]; p0[4 * g + 2] = a[2]; p0[4 * g + 3] = a[3]; p1[4 * g] = b[0]; p1[4 * g + 1] = b[1]; p1[4 * g + 2] = b[2]; p1[4 * g + 3] = b[3]; }
    } else { p0 = f32x16{}; p1 = f32x16{}; }
    const char* kb[4];
#pragma unroll
    for (int dd = 0; dd < 4; ++dd) kb[dd] = K_lds + KB * SHM_K + kswz<DK>(r32, (dd * 16 + hi * 8) * 2);
#pragma unroll
    for (int d0 = 0; d0 < DK / 16; ++d0) { const char* a = kb[d0 & 3] + (d0 >> 2) * 128;
        bf16x8 b0 = *reinterpret_cast<const bf16x8*>(a);
        bf16x8 b1 = *reinterpret_cast<const bf16x8*>(a + 32 * 2 * DK);
        p0 = __builtin_amdgcn_mfma_f32_32x32x16_bf16(b0, qr[d0], p0, 0, 0, 0);
        p1 = __builtin_amdgcn_mfma_f32_32x32x16_bf16(b1, qr[d0], p1, 0, 0, 0); }
}
template <int VB>
__device__ __forceinline__ void pv_tile(f32x16* o, int vb0, bf16x8 pa0, bf16x8 pa1, bf16x8 pa2, bf16x8 pa3) {
#define FA_TRRD(dst, off) asm volatile("ds_read_b64_tr_b16 %0, %1 offset:%2" : "=&v"(dst) : "v"(vb0), "i"(off) : "memory")
#define FA_PV_D0(d0) do { s16x4 l0, l1, l2, l3, h0, h1, h2, h3; constexpr int b_ = VB * SHM_V + v_rd_off(d0, 0, 0); \
        FA_TRRD(l0, b_); FA_TRRD(h0, b_ + 2048); FA_TRRD(l1, b_ + 4096); FA_TRRD(h1, b_ + 6144); FA_TRRD(l2, b_ + 8192); FA_TRRD(h2, b_ + 10240); FA_TRRD(l3, b_ + 12288); FA_TRRD(h3, b_ + 14336); \
        asm volatile("s_waitcnt lgkmcnt(0)" ::: "memory"); FA_SBAR(); \
        o[d0] = __builtin_amdgcn_mfma_f32_32x32x16_bf16(pa0, (bf16x8){l0[0], l0[1], l0[2], l0[3], h0[0], h0[1], h0[2], h0[3]}, o[d0], 0, 0, 0); \
        o[d0] = __builtin_amdgcn_mfma_f32_32x32x16_bf16(pa1, (bf16x8){l1[0], l1[1], l1[2], l1[3], h1[0], h1[1], h1[2], h1[3]}, o[d0], 0, 0, 0); \
        o[d0] = __builtin_amdgcn_mfma_f32_32x32x16_bf16(pa2, (bf16x8){l2[0], l2[1], l2[2], l2[3], h2[0], h2[1], h2[2], h2[3]}, o[d0], 0, 0, 0); \
        o[d0] = __builtin_amdgcn_mfma_f32_32x32x16_bf16(pa3, (bf16x8){l3[0], l3[1], l3[2], l3[3], h3[0], h3[1], h3[2], h3[3]}, o[d0], 0, 0, 0); } while (0)
    FA_PV_D0(0); FA_PV_D0(1); FA_PV_D0(2); FA_PV_D0(3);
#undef FA_PV_D0
#undef FA_TRRD
}
struct Blk { const bf16_t* Q; const bf16_t* Kr; const bf16_t* Km; const bf16_t* Vr; const bf16_t* Vm; const float* cbr; const float* cbm; bf16_t* O; int P0; };
template <int DK> struct Seam { bf16x8 qr[DK / 16]; bf16x8 st_v0, st_v1; bf16x8 st_k[DK / 64]; float st_b; };
template <int DK> constexpr int lds_bytes() { return 2 * SHM_V + 2 * KVBLK * DK * 2 + NW * 64 * 4 + 2 * 64 * 4; }

#define FA_VMW() asm volatile("s_waitcnt vmcnt(0)" ::: "memory")
template <int DK, bool BIAS>
__device__ __forceinline__ void fa_load_tile(const Blk& B, int kb, int ldk, int ldv, int tid, Seam<DK>& S, const float BSC) {
    const bf16_t* Kp = kb == 0 ? B.Km : B.Kr; const bf16_t* Vp = kb == 0 ? B.Vm : B.Vr;
    const int sr = tid >> 4, sc = (tid & 15) * 8;
    S.st_v0 = *(const bf16x8*)(Vp + (size_t)(kb + sr) * ldv + sc); S.st_v1 = *(const bf16x8*)(Vp + (size_t)(kb + 32 + sr) * ldv + sc);
#pragma unroll
    for (int j = 0; j < DK / 64; ++j) { const int ci = tid + 512 * j, row = ci / (DK / 8), cc = ci % (DK / 8); S.st_k[j] = *(const bf16x8*)(Kp + (size_t)(kb + row) * ldk + cc * 8); }
    if constexpr (BIAS) { const float* cp = kb == 0 ? B.cbm : B.cbr; S.st_b = cp[kb + (tid & 63)] * BSC; }
}
template <int DK, bool BIAS>
__device__ __forceinline__ void fa_write_k(char* K_lds, float* bias_lds, int bf, int tid, const Seam<DK>& S) {
    constexpr int SHM_K = KVBLK * DK * 2;
#pragma unroll
    for (int j = 0; j < DK / 64; ++j) { const int ci = tid + 512 * j, row = ci / (DK / 8), cc = ci % (DK / 8); *(bf16x8*)(K_lds + bf * SHM_K + kswz<DK>(row, cc * 16)) = S.st_k[j]; }
    if constexpr (BIAS) { if (tid < 64) bias_lds[bf * 64 + tid] = S.st_b; }
}
template <int DK>
__device__ __forceinline__ void fa_write_v(char* V_lds, int bf, int tid, const Seam<DK>& S) {
    const int sr = tid >> 4, sc = (tid & 15) * 8;
    *(bf16x8*)(V_lds + bf * SHM_V + v_st(sr, sc)) = S.st_v0; *(bf16x8*)(V_lds + bf * SHM_V + v_st(32 + sr, sc)) = S.st_v1;
}
template <int DK, bool BIAS>
__device__ __forceinline__ void fa_prime(const int tid, const Blk& cur, int ldq, int ldk, int ldv, char* lds, Seam<DK>& S, const float BSC) {
    const int wid = __builtin_amdgcn_readfirstlane(tid >> 6), lane = tid & 63, r32 = lane & 31, hi = lane >> 5;
    constexpr int SHM_K = KVBLK * DK * 2;
    char* K_lds = lds + 2 * SHM_V; float* bias_lds = (float*)(lds + 2 * SHM_V + 2 * SHM_K + NW * 64 * 4);
#pragma unroll
    for (int d0 = 0; d0 < DK / 16; ++d0) S.qr[d0] = *(const bf16x8*)(cur.Q + (size_t)(wid * QBLK + r32) * ldq + d0 * 16 + hi * 8);
    fa_load_tile<DK, BIAS>(cur, 0, ldk, ldv, tid, S, BSC); FA_VMW(); fa_write_k<DK, BIAS>(K_lds, bias_lds, 0, tid, S);
    __syncthreads();
}
template <int DK, bool BIAS>
__device__ __forceinline__ void fa_block(const int tid, const Blk& cur, const Blk& nxt, int ldq, int ldk, int ldv, int ldo, char* lds, Seam<DK>& S, const float SCALE, const float BSC) {
    const int wid = __builtin_amdgcn_readfirstlane(tid >> 6), lane = tid & 63, r32 = lane & 31, hi = lane >> 5;
    constexpr int SHM_K = KVBLK * DK * 2;
    const int NT = (cur.P0 + QB - 1) / KVBLK + 1;
    const int qlo = cur.P0 + wid * QBLK, qm = qlo + r32 - 4 * hi;
    char* V_lds = lds; char* K_lds = lds + 2 * SHM_V;
    float* ws = (float*)(lds + 2 * SHM_V + 2 * SHM_K) + wid * 64; float* li_l = ws; float* al_l = ws + 32;
    float* bias_lds = (float*)(lds + 2 * SHM_V + 2 * SHM_K + NW * 64 * 4);
    float m_reg = -1e30f, l_reg = 0; f32x16 o[4] = {};
    const int vb0 = (int)(uintptr_t)V_lds + v_rd_base(lane);
#define FA_RESC(a) do { if (__any((a) < 1.f)) { if (hi == 0) al_l[r32] = (a); asm volatile("s_waitcnt lgkmcnt(0)" ::: "memory"); \
                     _Pragma("unroll") for (int d_ = 0; d_ < 4; ++d_) _Pragma("unroll") for (int r = 0; r < 16; ++r) o[d_][r] *= al_l[crow(r, hi)]; } } while (0)
#define FA_KBASE(t) ((t) * KVBLK)
#define FA_MASKT(P0_, P1_, t) do { const int kb_ = FA_KBASE(t); if (kb_ == 0) mask_meta(P0_, P1_); else if (kb_ + KVBLK - 1 > qlo) mask_tile(P0_, P1_, qm - kb_); } while (0)
    f32x16 pA0, pA1, pB0, pB1; float mnA, mnB, alA, alB; bf16x8 pa0, pa1, pa2, pa3;
    fa_write_v<DK>(V_lds, 0, tid, S); FA_SBAR();
    if (NT > 1) fa_load_tile<DK, BIAS>(cur, FA_KBASE(1), ldk, ldv, tid, S, BSC);
    FA_SBAR(); qkt<DK, 0, BIAS>(pA0, pA1, K_lds, bias_lds, r32, hi, S.qr);
    FA_MASKT(pA0, pA1, 0); partialSM(pA0, pA1, m_reg, mnA, alA, SCALE);
    if (NT > 1) { FA_VMW(); fa_write_v<DK>(V_lds, 1, tid, S); fa_write_k<DK, BIAS>(K_lds, bias_lds, 1, tid, S); }
    __syncthreads();
#define FA_HALF_STEP(PX0, PX1, mnX, alX, PY0, PY1, alY, t, KB, VB, SB) do { \
        FA_SBAR(); qkt<DK, KB, BIAS>(PX0, PX1, K_lds, bias_lds, r32, hi, S.qr); \
        finishSM(PY0, PY1, alY, l_reg, pa0, pa1, pa2, pa3); FA_SBAR(); \
        if ((t) + 1 < NT) { fa_load_tile<DK, BIAS>(cur, FA_KBASE((t) + 1), ldk, ldv, tid, S, BSC); FA_SBAR(); } \
        pv_tile<VB>(o, vb0, pa0, pa1, pa2, pa3); FA_MASKT(PX0, PX1, (t)); partialSM(PX0, PX1, m_reg, mnX, alX, SCALE); \
        __syncthreads(); \
        if ((t) + 1 < NT) { FA_VMW(); fa_write_v<DK>(V_lds, SB, tid, S); fa_write_k<DK, BIAS>(K_lds, bias_lds, SB, tid, S); } \
        FA_RESC(alX); __syncthreads(); } while (0)
    for (int t = 1; t + 1 < NT; t += 2) {
        FA_HALF_STEP(pB0, pB1, mnB, alB, pA0, pA1, alA, t, 1, 0, 0);
        FA_HALF_STEP(pA0, pA1, mnA, alA, pB0, pB1, alB, t + 1, 0, 1, 1);
    }
    const bool even = (NT & 1) == 0;
    if (even) { FA_SBAR(); qkt<DK, 1, BIAS>(pB0, pB1, K_lds, bias_lds, r32, hi, S.qr); FA_SBAR(); }
    fa_load_tile<DK, BIAS>(nxt, 0, ldk, ldv, tid, S, BSC); FA_SBAR();
#pragma unroll
    for (int d0 = 0; d0 < DK / 16; ++d0) S.qr[d0] = *(const bf16x8*)(nxt.Q + (size_t)(wid * QBLK + r32) * ldq + d0 * 16 + hi * 8);
    FA_SBAR();
    finishSM(pA0, pA1, alA, l_reg, pa0, pa1, pa2, pa3); FA_SBAR();
    pv_tile<0>(o, vb0, pa0, pa1, pa2, pa3);
    if (even) { FA_MASKT(pB0, pB1, NT - 1); partialSM(pB0, pB1, m_reg, mnB, alB, SCALE); __syncthreads(); FA_RESC(alB);
        finishSM(pB0, pB1, alB, l_reg, pa0, pa1, pa2, pa3); FA_SBAR(); pv_tile<1>(o, vb0, pa0, pa1, pa2, pa3); }
    FA_SBAR();
    asm volatile("s_waitcnt vmcnt(%0)" :: "i"(DK / 16) : "memory");
    fa_write_k<DK, BIAS>(K_lds, bias_lds, 0, tid, S); FA_SBAR();
    if (hi == 0) li_l[r32] = l_reg; asm volatile("s_waitcnt lgkmcnt(0)" ::: "memory");
    float rli[16];
#pragma unroll
    for (int r = 0; r < 16; ++r) rli[r] = __builtin_amdgcn_rcpf(li_l[crow(r, hi)]);
    bf16_t* Ow = cur.O + (size_t)(wid * QBLK) * ldo;
#pragma unroll
    for (int r = 0; r < 16; ++r) { const int orow = crow(r, hi);
#pragma unroll
        for (int d0 = 0; d0 < 4; ++d0) { const float v = o[d0][r] * rli[r]; const float vn = __shfl_xor(v, 1);
            if ((r32 & 1) == 0) *(unsigned*)(Ow + (size_t)orow * ldo + d0 * 32 + r32) = cvtpk_a(v, vn); } }
    __syncthreads();
#undef FA_RESC
#undef FA_KBASE
#undef FA_MASKT
#undef FA_HALF_STEP
}
template <int DK, bool BIAS>
__device__ __forceinline__ void fa_block_sb(const int tid, const Blk& cur, int ldk, int ldv, int ldo, char* lds, Seam<DK>& S, const float SCALE, const float BSC) {
    const int wid = __builtin_amdgcn_readfirstlane(tid >> 6), lane = tid & 63, r32 = lane & 31, hi = lane >> 5;
    constexpr int SHM_K = KVBLK * DK * 2;
    const int NT = (cur.P0 + QB - 1) / KVBLK + 1;
    const int qlo = cur.P0 + wid * QBLK, qm = qlo + r32 - 4 * hi;
    char* V_lds = lds; char* K_lds = lds + 2 * SHM_V;
    float* ws = (float*)(lds + 2 * SHM_V + 2 * SHM_K) + wid * 64; float* li_l = ws; float* al_l = ws + 32;
    float* bias_lds = (float*)(lds + 2 * SHM_V + 2 * SHM_K + NW * 64 * 4);
    float m_reg = -1e30f, l_reg = 0; f32x16 o[4] = {};
    const int vb0 = (int)(uintptr_t)V_lds + v_rd_base(lane);
    fa_write_v<DK>(V_lds, 0, tid, S);
    __syncthreads();
#define FA_STEP(t, KB) do { f32x16 p0, p1; float mn, al; bf16x8 pa0, pa1, pa2, pa3; \
        if ((t) + 1 < NT) { fa_load_tile<DK, BIAS>(cur, ((t) + 1) * KVBLK, ldk, ldv, tid, S, BSC); FA_SBAR(); } \
        qkt<DK, KB, BIAS>(p0, p1, K_lds, bias_lds, r32, hi, S.qr); \
        { const int kb_ = (t) * KVBLK; if (kb_ == 0) mask_meta(p0, p1); else if (kb_ + KVBLK - 1 > qlo) mask_tile(p0, p1, qm - kb_); } \
        partialSM(p0, p1, m_reg, mn, al, SCALE); \
        if (__any(al < 1.f)) { if (hi == 0) al_l[r32] = al; asm volatile("s_waitcnt lgkmcnt(0)" ::: "memory"); \
            _Pragma("unroll") for (int d_ = 0; d_ < 4; ++d_) _Pragma("unroll") for (int r = 0; r < 16; ++r) o[d_][r] *= al_l[crow(r, hi)]; } \
        finishSM(p0, p1, al, l_reg, pa0, pa1, pa2, pa3); FA_SBAR(); \
        pv_tile<KB>(o, vb0, pa0, pa1, pa2, pa3); \
        if ((t) + 1 < NT) { FA_VMW(); fa_write_v<DK>(V_lds, 1 - KB, tid, S); fa_write_k<DK, BIAS>(K_lds, bias_lds, 1 - KB, tid, S); } \
        __syncthreads(); } while (0)
    int t = 0;
    for (; t + 1 < NT; t += 2) { FA_STEP(t, 0); FA_STEP(t + 1, 1); }
    if (t < NT) FA_STEP(t, 0);
#undef FA_STEP
    if (hi == 0) li_l[r32] = l_reg; asm volatile("s_waitcnt lgkmcnt(0)" ::: "memory");
    float rli[16];
#pragma unroll
    for (int r = 0; r < 16; ++r) rli[r] = __builtin_amdgcn_rcpf(li_l[crow(r, hi)]);
    bf16_t* Ow = cur.O + (size_t)(wid * QBLK) * ldo;
#pragma unroll
    for (int r = 0; r < 16; ++r) { const int orow = crow(r, hi);
#pragma unroll
        for (int d0 = 0; d0 < 4; ++d0) { const float v = o[d0][r] * rli[r]; const float vn = __shfl_xor(v, 1);
            if ((r32 & 1) == 0) *(unsigned*)(Ow + (size_t)orow * ldo + d0 * 32 + r32) = cvtpk_a(v, vn); } }
    __syncthreads();
}
}

__device__ __forceinline__ void attn_fast(char* lds, const bf16_t* PROJ, const bf16_t* QA, const bf16_t* KA, const bf16_t* VA, const float* CB, bf16_t* OCAT, int vcu, int G) {
    for (int v = vcu; v < NBATCH * NH * 8; v += G) {
        const int bh = v >> 3, qb = v & 7, b = bh >> 3, h = bh & 7;
#ifndef FA_ONLY
#define FA_ONLY 3
#endif
        if (FA_ONLY & 1) {
            fa::Blk B; const size_t r0 = (size_t)b * SEQ + qb * 256, rm = (size_t)MREAL + b * NMETA;
            B.Q = QA + r0 * 1536 + h * HQK; B.Kr = KA + ((size_t)b * SEQ) * 1536 + h * HQK - (size_t)64 * 1536; B.Km = KA + rm * 1536 + h * HQK;
            B.Vr = VA + ((size_t)b * SEQ) * 1024 + h * 128 - (size_t)64 * 1024; B.Vm = VA + rm * 1024 + h * 128; B.cbr = nullptr; B.cbm = nullptr;
            B.O = OCAT + r0 * 3072 + h * 128; B.P0 = 64 + qb * 256;
            int tl = threadIdx.x; asm volatile("" : "+v"(tl));
            fa::Seam<192> S; fa::fa_prime<192, false>(tl, B, 1536, 1536, 1024, lds, S, 0.f);
            fa::fa_block_sb<192, false>(tl, B, 1536, 1024, 3072, lds, S, 0.07216878364870323f, 0.f);
        }
        if (FA_ONLY & 2) {
            const int qf = 7 - qb; fa::Blk B; const size_t r0 = (size_t)b * SEQ + qf * 256, rm = (size_t)MREAL + b * NMETA;
            B.Q = PROJ + r0 * N1 + PC_FQ + h * 128; B.Kr = PROJ + ((size_t)b * SEQ) * N1 + PC_FK + h * 128 - (size_t)64 * N1; B.Km = PROJ + rm * N1 + PC_FK + h * 128;
            B.Vr = PROJ + ((size_t)b * SEQ) * N1 + PC_FV + h * 128 - (size_t)64 * N1; B.Vm = PROJ + rm * N1 + PC_FV + h * 128;
            B.cbm = CB + bh * CBLD; B.cbr = CB + bh * CBLD - 48;
            B.O = OCAT + r0 * 3072 + 2048 + h * 128; B.P0 = 64 + qf * 256;
            int tl = threadIdx.x; asm volatile("" : "+v"(tl));
            fa::Seam<128> S; fa::fa_prime<128, true>(tl, B, N1, N1, N1, lds, S, -11.313708498984761f);
            fa::fa_block<128, true>(tl, B, B, N1, N1, N1, 3072, lds, S, 0.08838834764831845f, -11.313708498984761f);
        }
    }
}

struct Args { const float* in[17]; float* out; unsigned char* ws; int ph_lo, ph_hi; };
__global__ void __launch_bounds__(NTHREADS, 2) fwd(Args args) {
    extern __shared__ __attribute__((aligned(16))) unsigned char lds_raw[];
    LAS unsigned char* lds = (LAS unsigned char*)lds_raw;
    volatile LAS unsigned* MISCW = (volatile LAS unsigned*)(lds + MISC_OFF);
    const int tid = threadIdx.x, lane = tid & 63, wave = __builtin_amdgcn_readfirstlane(tid >> 6);
    const int G = gridDim.x, bid = blockIdx.x;
    const int gw = bid * NWAVES + wave, NGW = G * NWAVES;
    const int vcu = (G % 8 == 0) ? (bid % 8) * (G / 8) + bid / 8 : bid;
    unsigned char* ws = args.ws;
    Ins in; in.x = args.in[0]; in.meta = args.in[1]; in.w_in = args.in[2]; in.b_forget = args.in[3]; in.g_q = args.in[4]; in.g_kv = args.in[5]; in.w_uq = args.in[6]; in.w_ukv = args.in[7];
    in.conv_w = args.in[8]; in.w_branch = args.in[9]; in.w_out = args.in[10]; in.w_f1 = args.in[11]; in.w_f2 = args.in[12]; in.g_mix_pre = args.in[13]; in.g_mix_post = args.in[14]; in.g_ffn_pre = args.in[15]; in.g_ffn_post = args.in[16];
    float* H = (float*)(ws + WS_H); bf16_t* HN = (bf16_t*)(ws + WS_HN); bf16_t* PROJ = (bf16_t*)(ws + WS_PROJ); float* MISC = (float*)(ws + WS_MISC);
    bf16_t* CQN = (bf16_t*)(ws + WS_CQN); bf16_t* CKVN = (bf16_t*)(ws + WS_CKVN); bf16_t* QA = (bf16_t*)(ws + WS_QA); bf16_t* KA = (bf16_t*)(ws + WS_KA); bf16_t* VA = (bf16_t*)(ws + WS_VA);
    float* CB = (float*)(ws + WS_CB); bf16_t* OCAT = (bf16_t*)(ws + WS_OCAT); float* MIXF = (float*)(ws + WS_MIXF); bf16_t* MERGED = (bf16_t*)(ws + WS_MERGED); bf16_t* ACT = (bf16_t*)(ws + WS_ACT);
    float* ROPE = (float*)(ws + WS_ROPE);

    for (int u = tid; u < (LDS_BYTES - RING_BYTES) / 4; u += NTHREADS) ((LAS unsigned*)(lds + RING_BYTES))[u] = 0u;
    __syncthreads();
    const int lo = args.ph_lo, hi = args.ph_hi;
    XcdBarrier bar; bar.bar = (unsigned*)(ws + WS_CTL) + 4096; bar.x = 0; bar.st = nullptr;
    if (hi - lo > 1) bar = xcd_barrier_post((unsigned*)(ws + WS_CTL) + 4096, MISCW + 8);
#ifndef SKIPMASK
#define SKIPMASK 0
#endif
#define IN(k) (lo <= (k) && (k) < hi && !((SKIPMASK >> ((k) == 0 ? 0 : 1 + ((k) - 1) % 10)) & 1))
#define SEAM(k) do { if (IN(k) && IN((k) + 1)) xcd_barrier(bar); } while (0)

    if (IN(0)) {
        p0_weights(in, ws, lds, gw, NGW, wave, lane);
        p0_rope(ROPE, bid * NTHREADS + tid, G * NTHREADS);
        t_norm(0, false, in, H, nullptr, HN, nullptr, nullptr, in.g_mix_pre, gw, NGW, lane);
    }
    SEAM(0);
#pragma unroll 1
    for (int l = 0; l < DEPTH; ++l) {
        const int pb = 1 + 10 * l;
        const unsigned char* wl = ws + WS_W + (size_t)l * W_LAYER;
        if (IN(pb + 0)) {
            SchedPlain S{(const char*)HN, (const char*)(wl + WO_W1), DM, DM, N1T, G, bid}; EpiG1 E{PROJ, MISC};
            run_gemm(lds, DM, DM, DM, S, E);
        }
        SEAM(pb + 0);
        if (IN(pb + 1)) t1_phase(l, in, PROJ, MISC, CQN, CKVN, KA, OCAT, CB, ROPE, (LAS float*)(lds + wave * 16384), gw, NGW, lane);
        SEAM(pb + 1);
        if (IN(pb + 2)) {
            SchedG2 S{(const char*)CKVN, (const char*)(wl + WO_WUKV), (const char*)CQN, (const char*)(wl + WO_WUQ), G, bid}; EpiG2 E{QA, KA, VA, ROPE};
            run_gemm(lds, 512, 512, 512, S, E);
        }
        SEAM(pb + 2);
        if (IN(pb + 3)) {
#if FAST_ATTN
            attn_fast((char*)lds_raw, PROJ, QA, KA, VA, CB, OCAT, vcu, G);
            attn_naive(lds, PROJ, QA, KA, VA, CB, OCAT, NMETA, gw, NGW, wave, lane);
#else
            attn_naive(lds, PROJ, QA, KA, VA, CB, OCAT, LSEQ, gw, NGW, wave, lane);
#endif
        }
        SEAM(pb + 3);
        if (IN(pb + 4)) {
            SchedG3 S{(const char*)OCAT, (const char*)(wl + WO_WBR), G, bid}; EpiG3 E{PROJ, MIXF, MERGED};
            run_gemm(lds, 1024, 3072, 3072, S, E);
        }
        SEAM(pb + 4);
        if (IN(pb + 5)) {
            SchedPlain S{(const char*)MERGED, (const char*)(wl + WO_WOUT), DM, DM, 8, G, bid}; EpiF32 E{MIXF};
            run_gemm(lds, DM, DM, DM, S, E);
        }
        SEAM(pb + 5);
        if (IN(pb + 6)) t_norm(1, false, in, H, MIXF, HN, nullptr, in.g_mix_post + l * DM, in.g_ffn_pre + l * DM, gw, NGW, lane);
        SEAM(pb + 6);
        if (IN(pb + 7)) {
            SchedPlain S{(const char*)HN, (const char*)(wl + WO_WF1), DM, DM, 2 * DFF / 256, G, bid}; EpiG5 E{ACT};
            run_gemm(lds, DM, DM, DM, S, E);
        }
        SEAM(pb + 7);
        if (IN(pb + 8)) {
            SchedPlain S{(const char*)ACT, (const char*)(wl + WO_WF2), DFF, DFF, 8, G, bid}; EpiF32 E{MIXF};
            run_gemm(lds, DFF, DFF, DFF, S, E);
        }
        SEAM(pb + 8);
        if (IN(pb + 9)) t_norm(1, l == DEPTH - 1, in, H, MIXF, HN, args.out, in.g_ffn_post + l * DM, in.g_mix_pre + (l + 1 < DEPTH ? l + 1 : 0) * DM, gw, NGW, lane);
        SEAM(pb + 9);
    }
#undef IN
#undef SEAM
}

extern "C" void kernel_launch(void* const* d_in, const int* in_sizes, int n_in, void* d_out, int out_size, void* d_ws, size_t ws_size, hipStream_t stream) {
    static int grid = 0;
    if (grid == 0) {
        if (n_in != 17 || out_size != MREAL * DM || ws_size < WS_END) { fprintf(stderr, "kernel_launch: unexpected shapes: n_in %d out %d ws %zu (need %zu)\n", n_in, out_size, ws_size, (size_t)WS_END); grid = -1; return; }
        int dev = 0, cus = 0, per_cu = 0;
        if (hipGetDevice(&dev) != hipSuccess || hipDeviceGetAttribute(&cus, hipDeviceAttributeMultiprocessorCount, dev) != hipSuccess) { grid = -1; return; }
        if (hipFuncSetAttribute((const void*)fwd, hipFuncAttributeMaxDynamicSharedMemorySize, LDS_BYTES) != hipSuccess) { fprintf(stderr, "kernel_launch: hipFuncSetAttribute failed\n"); grid = -1; return; }
        if (hipOccupancyMaxActiveBlocksPerMultiprocessor(&per_cu, (const void*)fwd, NTHREADS, LDS_BYTES) != hipSuccess || per_cu < 1) fprintf(stderr, "kernel_launch: occupancy query says %d\n", per_cu);
        (void)hipGetLastError();
        grid = cus;
    }
    if (grid < 0) return;
    (void)hipMemsetAsync((char*)d_ws + WS_CTL, 0, CTL_ZERO_BYTES, stream);
    Args a{};
    for (int i = 0; i < 17; ++i) a.in[i] = (const float*)d_in[i];
    a.out = (float*)d_out; a.ws = (unsigned char*)d_ws;
#if MK_ONE_LAUNCH
    a.ph_lo = 0; a.ph_hi = NPHASES;
    hipLaunchKernelGGL(fwd, dim3(grid), dim3(NTHREADS), LDS_BYTES, stream, a);
#else
    for (int p = 0; p < NPHASES; ++p) { a.ph_lo = p; a.ph_hi = p + 1; hipLaunchKernelGGL(fwd, dim3(grid), dim3(NTHREADS), LDS_BYTES, stream, a); }
#endif
}
```

```cpp
#include <hip/hip_runtime.h>
#include <cstdio>
#include <cstdint>

#ifndef MK_ONE_LAUNCH
#define MK_ONE_LAUNCH 1
#endif
#ifndef FAST_GEMM
#define FAST_GEMM 1
#endif
#ifndef FAST_ATTN
#define FAST_ATTN 1
#endif

#define GAS __attribute__((address_space(1)))
#define LAS __attribute__((address_space(3)))
typedef unsigned short bf16_t;
typedef short bf16x8 __attribute__((ext_vector_type(8)));
typedef float f32x4 __attribute__((ext_vector_type(4)));
typedef float f32x2 __attribute__((ext_vector_type(2)));
typedef unsigned u32x4 __attribute__((ext_vector_type(4)));
typedef unsigned u32x2 __attribute__((ext_vector_type(2)));
typedef __bf16 bf16x2_t __attribute__((ext_vector_type(2)));

constexpr int DM = 2048, NBATCH = 4, SEQ = 2048, DEPTH = 4, NMETA = 16, LSEQ = SEQ + NMETA;
constexpr int MREAL = NBATCH * SEQ;
constexpr int MTOK = MREAL + NMETA;
constexpr int MP = MREAL + 64, NPM = MREAL / 256;
constexpr int DIN = 13384, N1 = 13568, N1T = N1 / 256;
constexpr int DFF = 5632, NH = 8, HQK = 192;
constexpr float EPS = 1e-6f;
constexpr int PC_CQ = 0, PC_CKV = 512, PC_MISC = 1024, PC_CONVB = 1280, PC_CONVC = 2304, PC_CONVX = 3328, PC_FQ = 4352, PC_FK = 5376, PC_FV = 6400, PC_GATE = 7424;
constexpr int CBLD = 2112;

constexpr size_t al256(size_t x) { return (x + 255) & ~(size_t)255; }
constexpr size_t WS_CTL = 0, CTL_ZERO_BYTES = 1u << 20;
constexpr size_t SZ_W1 = (size_t)N1 * DM * 2, SZ_WUQ = (size_t)1536 * 512 * 2, SZ_WUKV = (size_t)2048 * 512 * 2, SZ_WBR = (size_t)DM * 3072 * 2,
                 SZ_WOUT = (size_t)DM * DM * 2, SZ_WF1 = (size_t)2 * DFF * DM * 2, SZ_WF2 = (size_t)DM * DFF * 2;
constexpr size_t WO_W1 = 0, WO_WUQ = WO_W1 + SZ_W1, WO_WUKV = WO_WUQ + SZ_WUQ, WO_WBR = WO_WUKV + SZ_WUKV, WO_WOUT = WO_WBR + SZ_WBR,
                 WO_WF1 = WO_WOUT + SZ_WOUT, WO_WF2 = WO_WF1 + SZ_WF1, W_LAYER = WO_WF2 + SZ_WF2;
constexpr size_t WS_W = CTL_ZERO_BYTES;
constexpr size_t WS_H = al256(WS_W + DEPTH * W_LAYER);
constexpr size_t WS_HN = al256(WS_H + (size_t)MP * DM * 4);
constexpr size_t WS_PROJ = al256(WS_HN + (size_t)MP * DM * 2);
constexpr size_t WS_MISC = al256(WS_PROJ + (size_t)MP * N1 * 2);
constexpr size_t WS_CQN = al256(WS_MISC + (size_t)MP * 128 * 4);
constexpr size_t WS_CKVN = al256(WS_CQN + (size_t)MP * 512 * 2);
constexpr size_t WS_QA = al256(WS_CKVN + (size_t)MP * 512 * 2);
constexpr size_t WS_KA = al256(WS_QA + (size_t)MP * 1536 * 2);
constexpr size_t WS_VA = al256(WS_KA + (size_t)MP * 1536 * 2);
constexpr size_t WS_CB = al256(WS_VA + (size_t)MP * 1024 * 2);
constexpr size_t WS_OCAT = al256(WS_CB + (size_t)32 * CBLD * 4);
constexpr size_t WS_MIXF = al256(WS_OCAT + (size_t)MP * 3072 * 2);
constexpr size_t WS_MERGED = al256(WS_MIXF + (size_t)MP * DM * 4);
constexpr size_t WS_ACT = al256(WS_MERGED + (size_t)MP * DM * 2);
constexpr size_t WS_ROPE = al256(WS_ACT + (size_t)MP * DFF * 2);
constexpr size_t WS_END = al256(WS_ROPE + (size_t)LSEQ * 32 * 2 * 4);

constexpr int NWAVES = 8, NTHREADS = NWAVES * 64;
constexpr int LDS_BYTES = 147456;
constexpr int RING_BYTES = 131072, MISC_OFF = RING_BYTES + 320;
constexpr int NPHASES = 1 + 10 * DEPTH;

__device__ __forceinline__ unsigned cvtpk(float lo, float hi) { f32x2 v = {lo, hi}; bf16x2_t b = __builtin_convertvector(v, bf16x2_t); return __builtin_bit_cast(unsigned, b); }
__device__ __forceinline__ float bf2f(unsigned short u) { return __uint_as_float((unsigned)u << 16); }
__device__ __forceinline__ float bflo(unsigned w) { return __uint_as_float(w << 16); }
__device__ __forceinline__ float bfhi(unsigned w) { return __uint_as_float(w & 0xffff0000u); }
__device__ __forceinline__ float wave_sum(float v) {
#pragma unroll
    for (int o = 1; o < 64; o <<= 1) v += __shfl_xor(v, o);
    return v;
}
__device__ __forceinline__ float wave_max(float v) {
#pragma unroll
    for (int o = 1; o < 64; o <<= 1) v = fmaxf(v, __shfl_xor(v, o));
    return v;
}
__device__ __forceinline__ float sigmoidf_(float x) { return __builtin_amdgcn_rcpf(1.0f + __builtin_amdgcn_exp2f(-1.4426950408889634f * x)); }
__device__ __forceinline__ int row_of(int b, int t) { return t < NMETA ? MREAL + t : b * SEQ + t - NMETA; }
__device__ __forceinline__ int t_of(int r) { return r < MREAL ? NMETA + (r & (SEQ - 1)) : ((r - MREAL) & (NMETA - 1)); }
#define LDS_WAIT() asm volatile("s_waitcnt lgkmcnt(0)" ::: "memory")
#define VM_WAIT() asm volatile("s_waitcnt vmcnt(0)" ::: "memory")

#define XB_TMO      128
#define XB_XCNT(j)  (256  + 64 * (j))
#define XB_XSUB(j)  (1280 + 64 * (j))
#define XB_XGEN(j)  (2304 + 64 * (j))
#define XB_TOP      3328
#define XB_TOPGEN   3392
#define XCD_BAR_WORDS 3456
#define XB_SPIN_CAP (1u << 18)
__device__ __forceinline__ unsigned xb_ld(unsigned* p)              { return __hip_atomic_load(p, __ATOMIC_RELAXED, __HIP_MEMORY_SCOPE_AGENT); }
__device__ __forceinline__ unsigned xb_add(unsigned* p, unsigned v) { return __hip_atomic_fetch_add(p, v, __ATOMIC_RELAXED, __HIP_MEMORY_SCOPE_AGENT); }
__device__ __forceinline__ unsigned xb_xcc_id() { return (unsigned)__builtin_amdgcn_s_getreg((3 << 11) | 20) & 0xFu; }
#define XB_SPIN(cond, bar) do { unsigned _sp = 0; while (cond) { __builtin_amdgcn_s_sleep(1); \
    if ((++_sp & 255u) == 0u) { if (xb_ld(&(bar)[XB_TMO])) break; if (_sp > XB_SPIN_CAP) { atomicAdd(&(bar)[XB_TMO], 1u); break; } } } } while (0)
struct XcdBarrier { unsigned* bar; unsigned x; volatile LAS unsigned* st; };
__device__ __forceinline__ XcdBarrier xcd_barrier_post(unsigned* bar, volatile LAS unsigned* st) {
    XcdBarrier b; b.bar = bar; b.x = xb_xcc_id(); b.st = st;
    if (threadIdx.x == 0) (void)xb_add(&bar[XB_XCNT(b.x)], 1u);
    return b;
}
__device__ __forceinline__ void xcd_barrier_complete(unsigned* bar, unsigned x, unsigned& nloc, unsigned& nx) {
    const unsigned G = gridDim.x * gridDim.y * gridDim.z;
    unsigned sum, cnt, mine, sp = 0u;
    for (;;) {
        sum = 0u; cnt = 0u; mine = 0u;
#pragma unroll
        for (unsigned j = 0; j < 16; ++j) { const unsigned c = xb_ld(&bar[XB_XCNT(j)]); sum += c; cnt += (c > 0u) ? 1u : 0u; mine = (j == x) ? c : mine; }
        if (sum == G) break;
        __builtin_amdgcn_s_sleep(1);
        if ((++sp & 255u) == 0u) { if (xb_ld(&bar[XB_TMO])) break; if (sp > XB_SPIN_CAP) { atomicAdd(&bar[XB_TMO], 1u); break; } }
    }
    nloc = mine > 0u ? mine : 1u; nx = cnt > 0u ? cnt : 1u;
}
__device__ __forceinline__ void xcd_barrier(const XcdBarrier& b) {
    asm volatile("s_waitcnt vmcnt(0)" ::: "memory");
    __syncthreads();
    if (threadIdx.x == 0) {
        unsigned* bar = b.bar; asm volatile("" : "+s"(bar));
        __builtin_amdgcn_s_waitcnt(0);
        unsigned nloc = b.st[0], nx = b.st[1];
        if (nloc == 0u) { xcd_barrier_complete(bar, b.x, nloc, nx); b.st[0] = nloc; b.st[1] = nx; }
        const unsigned old = xb_add(&bar[XB_XSUB(b.x)], 1u);
        const unsigned gen = old / nloc;
        if (old + 1u == (gen + 1u) * nloc) {
            __builtin_amdgcn_fence(__ATOMIC_RELEASE, "agent");
            asm volatile("s_waitcnt vmcnt(0)" ::: "memory");
            const unsigned og = xb_add(&bar[XB_TOP], 1u);
            const unsigned tg = og / nx;
            if (og + 1u == (tg + 1u) * nx) xb_add(&bar[XB_TOPGEN], 1u);
            else XB_SPIN(xb_ld(&bar[XB_TOPGEN]) == tg, bar);
            __builtin_amdgcn_fence(__ATOMIC_ACQUIRE, "agent");
            xb_add(&bar[XB_XGEN(b.x)], 1u);
            asm volatile("s_waitcnt vmcnt(0)" ::: "memory");
        } else {
            XB_SPIN(xb_ld(&bar[XB_XGEN(b.x)]) == gen, bar);
            __builtin_amdgcn_fence(__ATOMIC_ACQUIRE, "agent");
            asm volatile("s_waitcnt vmcnt(0)" ::: "memory");
        }
    }
    __syncthreads();
}

struct Unit { int pm, pn, tag; const char* A; const char* B; };

__device__ __forceinline__ void tile_decode(int L, int nM, int nN, int& pm, int& pn) {
    const int nwg = nM * nN; int wgid = L;
    { const int q = nwg / 8, r = nwg % 8, xcd = wgid % 8, off = wgid / 8; wgid = (xcd < r ? xcd * (q + 1) : r * (q + 1) + (xcd - r) * q) + off; }
    const int nig = 8 * nN, gid = wgid / nig, fm = gid * 8, gsz = (nM - fm) < 8 ? (nM - fm) : 8;
    pm = fm + ((wgid % nig) % gsz); pn = (wgid % nig) / gsz;
}
struct SchedPlain {
    const char* A; const char* B; int lda, ldb, nN, G, c;
    __device__ __forceinline__ bool next(int i, Unit& u) const {
        const int L = i * G + c; if (L >= NPM * nN) return false;
        tile_decode(L, NPM, nN, u.pm, u.pn); u.tag = 0;
        u.A = A + (size_t)u.pm * 256 * lda * 2; u.B = B + (size_t)u.pn * 256 * ldb * 2; return true;
    }
};
struct SchedG2 {
    const char* Akv; const char* Bkv; const char* Aq; const char* Bq; int G, c;
    __device__ __forceinline__ bool next(int i, Unit& u) const {
        int L = i * G + c; if (L >= NPM * 14) return false;
        if (L < NPM * 8) { tile_decode(L, NPM, 8, u.pm, u.pn); u.tag = 0; u.A = Akv + (size_t)u.pm * 256 * 1024; u.B = Bkv + (size_t)u.pn * 256 * 1024; }
        else { L -= NPM * 8; tile_decode(L, NPM, 6, u.pm, u.pn); u.tag = 1; u.A = Aq + (size_t)u.pm * 256 * 1024; u.B = Bq + (size_t)u.pn * 256 * 1024; }
        return true;
    }
};
struct SchedG3 {
    const char* A; const char* B; int G, c;
    __device__ __forceinline__ bool next(int i, Unit& u) const {
        const int br = i % 3, L = (i / 3) * G + c; if (L >= NPM * 8) return false;
        tile_decode(L, NPM, 8, u.pm, u.pn); u.tag = br;
        u.A = A + ((size_t)u.pm * 256 * 3072 + br * 1024) * 2; u.B = B + ((size_t)u.pn * 256 * 3072 + br * 1024) * 2; return true;
    }
};

__device__ __forceinline__ void st_bf4(bf16_t* p, f32x4 v) { u32x2 w; w.x = cvtpk(v[0], v[1]); w.y = cvtpk(v[2], v[3]); *(u32x2*)p = w; }
struct EpiG1 {
    static constexpr bool CHAIN = false;
    bf16_t* proj; float* misc;
    __device__ __forceinline__ void operator()(int, int row, int pn, int cj, f32x4& lo, f32x4& hi) const {
        if (pn >= PC_GATE / 256) {
#pragma unroll
            for (int e = 0; e < 4; ++e) { lo[e] = fmaxf(sigmoidf_(lo[e]), 7.888609052210118e-31f); hi[e] = fmaxf(sigmoidf_(hi[e]), 7.888609052210118e-31f); }
        }
        bf16_t* p = proj + (size_t)row * N1 + pn * 256 + cj;
        st_bf4(p, lo); st_bf4(p + 128, hi);
        if (pn == PC_MISC / 256) *(f32x4*)(misc + (size_t)row * 128 + cj) = lo;
    }
};
struct EpiG2 {
    static constexpr bool CHAIN = false;
    bf16_t* qa; bf16_t* ka; bf16_t* va; const float* rope;
    __device__ __forceinline__ void qcols(int row, int col, f32x4 v) const {
        const int h = col / HQK, j = col - h * HQK;
        if (j >= 128) {
            const int i0 = (j - 128) >> 1; const float* rp = rope + ((size_t)t_of(row) * 32 + i0) * 2;
            const f32x4 cs = *(const f32x4*)rp;
            v = (f32x4){v[0] * cs[0] - v[1] * cs[1], v[0] * cs[1] + v[1] * cs[0], v[2] * cs[2] - v[3] * cs[3], v[2] * cs[3] + v[3] * cs[2]};
        }
        st_bf4(qa + (size_t)row * 1536 + col, v);
    }
    __device__ __forceinline__ void operator()(int tag, int row, int pn, int cj, f32x4& lo, f32x4& hi) const {
        if (tag == 0) { st_bf4(ka + (size_t)row * 1536 + pn * HQK + cj, lo); st_bf4(va + (size_t)row * 1024 + pn * 128 + cj, hi); }
        else { qcols(row, pn * 256 + cj, lo); qcols(row, pn * 256 + 128 + cj, hi); }
    }
};
struct EpiG3 {
    static constexpr bool CHAIN = true;
    const bf16_t* proj; bf16_t* merged;
    __device__ __forceinline__ void one(int tag, int row, int col, f32x4& v) const {
        const bf16_t* gp = proj + (size_t)row * N1 + PC_GATE + tag * DM + col;
        const u32x2 g = *(const u32x2*)gp;
        f32x4 f = {bflo(g.x), bfhi(g.x), bflo(g.y), bfhi(g.y)};
        if (tag < 2) { const u32x2 gn = *(const u32x2*)(gp + DM);
            f = (f32x4){f[0] * __builtin_amdgcn_rcpf(bflo(gn.x)), f[1] * __builtin_amdgcn_rcpf(bfhi(gn.x)), f[2] * __builtin_amdgcn_rcpf(bflo(gn.y)), f[3] * __builtin_amdgcn_rcpf(bfhi(gn.y))}; }
        v = v * f;
        if (tag == 2) st_bf4(merged + (size_t)row * DM + col, v);
    }
    __device__ __forceinline__ void operator()(int tag, int row, int pn, int cj, f32x4& lo, f32x4& hi) const { one(tag, row, pn * 256 + cj, lo); one(tag, row, pn * 256 + 128 + cj, hi); }
};
struct EpiF32 {
    static constexpr bool CHAIN = false;
    float* out;
    __device__ __forceinline__ void operator()(int, int row, int pn, int cj, f32x4& lo, f32x4& hi) const {
        float* p = out + (size_t)row * DM + pn * 256 + cj; *(f32x4*)p = lo; *(f32x4*)(p + 128) = hi;
    }
};
struct EpiG5 {
    static constexpr bool CHAIN = false;
    bf16_t* act;
    __device__ __forceinline__ void operator()(int, int row, int pn, int cj, f32x4& lo, f32x4& hi) const {
        f32x4 v;
#pragma unroll
        for (int e = 0; e < 4; ++e) v[e] = lo[e] * sigmoidf_(lo[e]) * hi[e];
        st_bf4(act + (size_t)row * DFF + pn * 128 + cj, v);
    }
};

template <class EF, class Sched>
__device__ __forceinline__ void gemm_simple(int K, int lda, int ldb, const Sched& S, const EF& E) {
    const int tid = threadIdx.x, wid = tid >> 6, lane = tid & 63, wr = wid >> 2, q = wid & 3, fr = lane & 15, fq = lane >> 4;
    Unit u;
#pragma unroll 1
    for (int i = 0; S.next(i, u); ++i) {
        const bf16_t* Ab = (const bf16_t*)u.A; const bf16_t* Bb = (const bf16_t*)u.B;
#pragma unroll 1
        for (int rb = 0; rb < 8; ++rb) {
            const int rloc = wr * 128 + rb * 16 + fr;
            f32x4 acc[4] = {};
            static_assert(!EF::CHAIN, "gemm_simple: no chained epilogues");
            const bf16_t* ap = Ab + (size_t)rloc * lda + fq * 8;
            const bf16_t* bp[4];
#pragma unroll
            for (int n = 0; n < 4; ++n) bp[n] = Bb + (size_t)((n >> 1) * 128 + q * 32 + (n & 1) * 16 + fr) * ldb + fq * 8;
#pragma unroll 2
            for (int k = 0; k < K; k += 32) {
                const bf16x8 a = *(const bf16x8*)(ap + k);
#pragma unroll
                for (int n = 0; n < 4; ++n) { const bf16x8 b = *(const bf16x8*)(bp[n] + k); acc[n] = __builtin_amdgcn_mfma_f32_16x16x32_bf16(b, a, acc[n], 0, 0, 0); }
            }
            const int row = u.pm * 256 + rloc;
#pragma unroll
            for (int n = 0; n < 2; ++n) E(u.tag, row, u.pn, q * 32 + n * 16 + 4 * fq, acc[n], acc[2 + n]);
        }
    }
}

namespace pg8 {
constexpr int BK = 64, HALF = 128, HTB = HALF * BK * 2, STAGE_BYTES = 8 * HTB;
__device__ __forceinline__ int lds_byte(int r, int c) { const int st = (r >> 4) * 2 + (c >> 5), rr = r & 15, cc = c & 31, ob = rr * 64 + cc * 2; return st * 1024 + (ob ^ (((ob >> 9) & 1) << 5)); }
__device__ __forceinline__ void stage_rc(int b, int& R, int& C) { const int st = b / 1024, sb = b % 1024, swz = sb ^ (((sb >> 9) & 1) << 5); R = (st >> 1) * 16 + swz / 64; C = (st & 1) * 32 + (swz % 64) / 2; }

template <class EF, class Sched, bool ALIGN_EPI>
__device__ __forceinline__ void gemm_phase(LAS unsigned char* lds, const int K, const int lda, const int ldb, const Sched& S, const EF& E) {
    int tid = threadIdx.x; asm volatile("" : "+v"(tid));
    const int wid = __builtin_amdgcn_readfirstlane(tid >> 6), lane = tid & 63, wr = wid >> 2, wc = wid & 3, fr = lane & 15, fq = lane >> 4;
    const int nt = K / BK;
    unsigned voffA[2], voffB[2];
#pragma unroll
    for (int i = 0; i < 2; ++i) { int R, C; stage_rc(tid * 16 + i * 8192, R, C); voffA[i] = (unsigned)(R * lda + C) * 2u; voffB[i] = (unsigned)(R * ldb + C) * 2u; }
    const size_t kstep = (size_t)(BK * 2);
    const size_t hstepA = (size_t)HALF * lda * 2, hstepB = (size_t)HALF * ldb * 2;
    const unsigned ldsw = (unsigned)wid * 1024u;
    const int aoff = lds_byte(wr * 64 + fr, fq * 8), boff = lds_byte(wc * 32 + fr, fq * 8);
#define PG8_SA(b, h) (((b) * 2 + (h)) * HTB)
#define PG8_SB(b, h) ((4 + (b) * 2 + (h)) * HTB)
#define PG8_STAGE(bufoff, gbase, voff) do { _Pragma("unroll") for (int _i = 0; _i < 2; ++_i) \
        __builtin_amdgcn_global_load_lds((const unsigned*)((const char*)(gbase) + (voff)[_i]), (LAS unsigned*)(lds + (bufoff) + ldsw + _i * 8192), 16, 0, 0); } while (0)
#define PG8_LDA(dst, b, h) do { _Pragma("unroll") for (int m = 0; m < 4; ++m) _Pragma("unroll") for (int k = 0; k < 2; ++k) dst[m][k] = *(const LAS bf16x8*)(lds + PG8_SA(b, h) + aoff + m * 2048 + k * 1024); } while (0)
#define PG8_LDB(dst, b, h) do { _Pragma("unroll") for (int n = 0; n < 2; ++n) _Pragma("unroll") for (int k = 0; k < 2; ++k) dst[n][k] = *(const LAS bf16x8*)(lds + PG8_SB(b, h) + boff + n * 2048 + k * 1024); } while (0)
#define PG8_MMA(ai, bj, At, Bt) do { __builtin_amdgcn_s_setprio(1); _Pragma("unroll") for (int m = 0; m < 4; ++m) _Pragma("unroll") for (int n = 0; n < 2; ++n) _Pragma("unroll") for (int k = 0; k < 2; ++k) \
        acc[ai][bj][m][n] = __builtin_amdgcn_mfma_f32_16x16x32_bf16(Bt[n][k], At[m][k], acc[ai][bj][m][n], 0, 0, 0); __builtin_amdgcn_s_setprio(0); } while (0)
#define PG8_WAIT_V(n) asm volatile("s_waitcnt vmcnt(" #n ")" ::: "memory")
#define PG8_WAIT_L(n) asm volatile("s_waitcnt lgkmcnt(" #n ")" ::: "memory")
#define PG8_BAR __builtin_amdgcn_s_barrier()
#define PG8_SCHED __builtin_amdgcn_sched_barrier(0)
    Unit cur, nxt; int ui = 0;
    if (!S.next(0, cur)) return;
    f32x4 acc[2][2][4][2];
#pragma unroll
    for (int a = 0; a < 2; ++a)
#pragma unroll
        for (int b = 0; b < 2; ++b)
#pragma unroll
            for (int m = 0; m < 4; ++m)
#pragma unroll
                for (int n = 0; n < 2; ++n) acc[a][b][m][n] = (f32x4){0.f, 0.f, 0.f, 0.f};
    bf16x8 At[4][2], B0[2][2], B1[2][2];
    const char* cA = cur.A; const char* cB = cur.B;
    PG8_STAGE(PG8_SB(0, 0), cB, voffB); PG8_STAGE(PG8_SB(0, 1), cB + hstepB, voffB); PG8_STAGE(PG8_SA(0, 0), cA, voffA); PG8_STAGE(PG8_SA(0, 1), cA + hstepA, voffA);
    if (wr == 1) PG8_BAR;
    PG8_WAIT_V(2); PG8_BAR;
    PG8_STAGE(PG8_SB(1, 0), cB + kstep, voffB); PG8_STAGE(PG8_SA(1, 0), cA + kstep, voffA); PG8_STAGE(PG8_SB(1, 1), cB + hstepB + kstep, voffB);
    PG8_WAIT_V(6); PG8_BAR;
    for (;;) {
        const bool has_next = S.next(ui + 1, nxt);
        const char* nA = has_next ? nxt.A : cA; const char* nB = has_next ? nxt.B : cB;
        for (int t = 0; t < nt; t += 2) {
            const bool last = (t == nt - 2);
            const char* a1 = cA + (size_t)(t + 1) * kstep;
            const char* a2 = last ? nA : cA + (size_t)(t + 2) * kstep; const char* b2 = last ? nB : cB + (size_t)(t + 2) * kstep;
            const char* a3 = a2 + kstep; const char* b3 = b2 + kstep;
            PG8_LDB(B0, 0, 0); PG8_LDB(B1, 0, 1); PG8_SCHED; PG8_LDA(At, 0, 0); PG8_STAGE(PG8_SA(1, 1), a1 + hstepA, voffA);
            PG8_WAIT_V(8); PG8_WAIT_L(0); PG8_BAR; PG8_MMA(0, 0, At, B0); PG8_MMA(0, 1, At, B1); PG8_BAR; PG8_SCHED;
            PG8_LDA(At, 0, 1); PG8_STAGE(PG8_SB(0, 0), b2, voffB); PG8_STAGE(PG8_SB(0, 1), b2 + hstepB, voffB); PG8_STAGE(PG8_SA(0, 0), a2, voffA);
            PG8_WAIT_V(8); PG8_WAIT_L(0); PG8_BAR; PG8_MMA(1, 0, At, B0); PG8_MMA(1, 1, At, B1); PG8_BAR; PG8_SCHED;
            PG8_LDB(B0, 1, 0); PG8_LDB(B1, 1, 1); PG8_SCHED; PG8_LDA(At, 1, 0); PG8_STAGE(PG8_SA(0, 1), a2 + hstepA, voffA);
            PG8_WAIT_V(8); PG8_WAIT_L(0); PG8_BAR; PG8_MMA(0, 0, At, B0); PG8_MMA(0, 1, At, B1); PG8_BAR; PG8_SCHED;
            PG8_LDA(At, 1, 1); PG8_STAGE(PG8_SB(1, 0), b3, voffB); PG8_STAGE(PG8_SB(1, 1), b3 + hstepB, voffB); PG8_STAGE(PG8_SA(1, 0), a3, voffA);
            PG8_WAIT_V(8); PG8_WAIT_L(0); PG8_BAR; PG8_MMA(1, 0, At, B0); PG8_MMA(1, 1, At, B1); PG8_BAR; PG8_SCHED;
        }
        if constexpr (ALIGN_EPI) { if (wr == 0) PG8_BAR; }
        {
#pragma unroll
            for (int ai = 0; ai < 2; ++ai)
#pragma unroll
                for (int m = 0; m < 4; ++m) { const int row = cur.pm * 256 + ai * HALF + wr * 64 + m * 16 + fr;
#pragma unroll
                    for (int n = 0; n < 2; ++n) E(cur.tag, row, cur.pn, wc * 32 + n * 16 + 4 * fq, acc[ai][0][m][n], acc[ai][1][m][n]); }
        }
        if (!has_next) break;
        if (!EF::CHAIN || cur.tag == 2) {
#pragma unroll
        for (int a = 0; a < 2; ++a)
#pragma unroll
            for (int b = 0; b < 2; ++b)
#pragma unroll
                for (int m = 0; m < 4; ++m)
#pragma unroll
                    for (int n = 0; n < 2; ++n) acc[a][b][m][n] = (f32x4){0.f, 0.f, 0.f, 0.f};
        }
        cur = nxt; cA = nA; cB = nB; ++ui;
        if constexpr (ALIGN_EPI) { if (wr == 1) PG8_BAR; }
    }
    PG8_WAIT_V(0);
    if constexpr (!ALIGN_EPI) { if (wr == 0) PG8_BAR; }
    PG8_BAR;
#undef PG8_SA
#undef PG8_SB
#undef PG8_STAGE
#undef PG8_LDA
#undef PG8_LDB
#undef PG8_MMA
#undef PG8_WAIT_V
#undef PG8_WAIT_L
#undef PG8_BAR
#undef PG8_SCHED
}
}

template <class EF, class Sched>
__device__ __forceinline__ void run_gemm(LAS unsigned char* lds, int K, int lda, int ldb, const Sched& S, const EF& E) {
#if FAST_GEMM
    pg8::gemm_phase<EF, Sched, true>(lds, K, lda, ldb, S, E);
#else
    gemm_simple<EF, Sched>(K, lda, ldb, S, E);
#endif
}

template <class EF>
__device__ __forceinline__ void skinny_gemm(LAS unsigned char* lds, const bf16_t* A, int lda, const bf16_t* Bt, int ldb, int K, int nitems, int nbr, int tag0, const EF& E, int G, int bid) {
    int tid = threadIdx.x; asm volatile("" : "+v"(tid));
    const int wid = __builtin_amdgcn_readfirstlane(tid >> 6), lane = tid & 63, fr = lane & 15, fq = lane >> 4;
    LAS f32x4* red = (LAS f32x4*)lds;
    const int kw = K / 8;
#pragma unroll 1
    for (int p = G - 1 - bid; p < nitems; p += G) {
        const int pn = p >> 3, q = p & 7;
        f32x4 tlo = {0.f, 0.f, 0.f, 0.f}, thi = {0.f, 0.f, 0.f, 0.f};
#pragma unroll 1
        for (int br = 0; br < nbr; ++br) {
            const bf16_t* ap = A + (size_t)fr * lda + br * K + wid * kw + fq * 8;
            const bf16_t* blo = Bt + (size_t)(pn * 256 + q * 16 + fr) * ldb + br * K + wid * kw + fq * 8;
            const bf16_t* bhi = blo + (size_t)128 * ldb;
            f32x4 alo = {0.f, 0.f, 0.f, 0.f}, ahi = {0.f, 0.f, 0.f, 0.f};
#pragma unroll 4
            for (int k = 0; k < kw; k += 32) { const bf16x8 a = *(const bf16x8*)(ap + k), b0 = *(const bf16x8*)(blo + k), b1 = *(const bf16x8*)(bhi + k);
                alo = __builtin_amdgcn_mfma_f32_16x16x32_bf16(b0, a, alo, 0, 0, 0); ahi = __builtin_amdgcn_mfma_f32_16x16x32_bf16(b1, a, ahi, 0, 0, 0); }
            red[(wid * 64 + lane) * 2] = alo; red[(wid * 64 + lane) * 2 + 1] = ahi;
            __syncthreads();
            if (wid == 0) {
#pragma unroll
                for (int w = 0; w < 8; ++w) { tlo += red[(w * 64 + lane) * 2]; thi += red[(w * 64 + lane) * 2 + 1]; }
                E(tag0 + br, MREAL + fr, pn, q * 16 + 4 * fq, tlo, thi);
                if (!EF::CHAIN) { tlo = (f32x4){0.f, 0.f, 0.f, 0.f}; thi = (f32x4){0.f, 0.f, 0.f, 0.f}; }
            }
            __syncthreads();
        }
    }
}

__device__ __forceinline__ int perm_col(int kind, int n) {
    if (kind == 0) {
        if (n < 1024) return n;
        if (n < 1280) { const int j = n - 1024; return j < 64 ? 1024 + j : (j < 72 ? 7232 + (j - 64) : -1); }
        if (n < PC_FQ) return 1088 + (n - 1280);
        if (n < PC_GATE) return 4160 + (n - PC_FQ);
        return 7240 + (n - PC_GATE);
    }
    if (kind == 1) {
        const int h = n / HQK, j = n - h * HQK; if (j < 128) return n; const int p = j - 128; return h * HQK + 128 + (p >> 1) + 32 * (p & 1);
    }
    if (kind == 2) {
        const int tl = n >> 8, j = n & 255; return j < 128 ? tl * 128 + j : DFF + tl * 128 + (j - 128);
    }
    return n;
}
__device__ __forceinline__ void transpose_item(const float* W, int Nsrc, bf16_t* WT, int ldd, int koff, int kind, LAS float* scr, int kb, int nb, int lane) {
    const int k0 = 64 * kb, n0 = 32 * nb; const int sc = perm_col(kind, n0 + (lane & 31));
#pragma unroll 8
    for (int i = 0; i < 32; ++i) { const int kk = 2 * i + (lane >> 5); scr[kk * 33 + (lane & 31)] = sc >= 0 ? W[(size_t)(k0 + kk) * Nsrc + sc] : 0.f; }
    LDS_WAIT(); asm volatile("" ::: "memory");
    const int c = lane & 7;
#pragma unroll
    for (int j = 0; j < 4; ++j) { const int n = (lane >> 3) + 8 * j; const LAS float* s = scr + (8 * c) * 33 + n;
        u32x4 o; o.x = cvtpk(s[0 * 33], s[1 * 33]); o.y = cvtpk(s[2 * 33], s[3 * 33]); o.z = cvtpk(s[4 * 33], s[5 * 33]); o.w = cvtpk(s[6 * 33], s[7 * 33]);
        *(u32x4*)(WT + (size_t)(n0 + n) * ldd + koff + k0 + 8 * c) = o; }
    LDS_WAIT(); asm volatile("" ::: "memory");
}
struct Ins { const float *x, *meta, *w_in, *b_forget, *g_q, *g_kv, *w_uq, *w_ukv, *conv_w, *w_branch, *w_out, *w_f1, *w_f2, *g_mix_pre, *g_mix_post, *g_ffn_pre, *g_ffn_post; };

__device__ __forceinline__ void sincos_d(double x, float& c, float& s) {
    const double k = __builtin_rint(x * 0.63661977236758134308);
    const double r = (x - k * 1.57079632679489655800e+00) - k * 6.12323399573676603587e-17;
    const double r2 = r * r;
    double sp = -1.0 / 1307674368000.0; sp = sp * r2 + 1.0 / 6227020800.0; sp = sp * r2 - 1.0 / 39916800.0; sp = sp * r2 + 1.0 / 362880.0; sp = sp * r2 - 1.0 / 5040.0; sp = sp * r2 + 1.0 / 120.0; sp = sp * r2 - 1.0 / 6.0; sp = sp * r2 + 1.0; sp *= r;
    double cp = 1.0 / 20922789888000.0; cp = cp * r2 - 1.0 / 87178291200.0; cp = cp * r2 + 1.0 / 479001600.0; cp = cp * r2 - 1.0 / 3628800.0; cp = cp * r2 + 1.0 / 40320.0; cp = cp * r2 - 1.0 / 720.0; cp = cp * r2 + 1.0 / 24.0; cp = cp * r2 - 0.5; cp = cp * r2 + 1.0;
    const int qd = (int)((long long)k & 3);
    const double cc = (qd == 0) ? cp : (qd == 1) ? -sp : (qd == 2) ? -cp : sp;
    const double ss = (qd == 0) ? sp : (qd == 1) ? cp : (qd == 2) ? -sp : -cp;
    c = (float)cc; s = (float)ss;
}

constexpr int IT_W1 = 32 * (N1 / 32), IT_WUQ = 8 * 48, IT_WUKV = 8 * 64, IT_WBR = 16 * 64, IT_WOUT = 32 * 64, IT_WF1 = 32 * (2 * DFF / 32), IT_WF2 = (DFF / 64) * 64;
constexpr int IT_LAYER = IT_W1 + IT_WUQ + IT_WUKV + 3 * IT_WBR + IT_WOUT + IT_WF1 + IT_WF2;

__device__ __forceinline__ void p0_weights(const Ins& in, unsigned char* ws, LAS unsigned char* lds, int gw, int NGW, int wave, int lane) {
    LAS float* scr = (LAS float*)(lds + wave * 16384);
#pragma unroll 1
    for (int it = gw; it < DEPTH * IT_LAYER; it += NGW) {
        const int l = it / IT_LAYER; int r = it - l * IT_LAYER;
        unsigned char* wl = ws + WS_W + (size_t)l * W_LAYER;
        if (r < IT_W1) { const int nbk = N1 / 32; transpose_item(in.w_in + (size_t)l * DM * DIN, DIN, (bf16_t*)(wl + WO_W1), DM, 0, 0, scr, r / nbk, r % nbk, lane); continue; } r -= IT_W1;
        if (r < IT_WUQ) { transpose_item(in.w_uq + (size_t)l * 512 * 1536, 1536, (bf16_t*)(wl + WO_WUQ), 512, 0, 1, scr, r / 48, r % 48, lane); continue; } r -= IT_WUQ;
        if (r < IT_WUKV) { transpose_item(in.w_ukv + (size_t)l * 512 * 2048, 2048, (bf16_t*)(wl + WO_WUKV), 512, 0, 3, scr, r / 64, r % 64, lane); continue; } r -= IT_WUKV;
        if (r < 3 * IT_WBR) { const int br = r / IT_WBR; r -= br * IT_WBR;
            transpose_item(in.w_branch + ((size_t)l * 3 + br) * 1024 * DM, DM, (bf16_t*)(wl + WO_WBR), 3072, br * 1024, 3, scr, r / 64, r % 64, lane); continue; } r -= 3 * IT_WBR;
        if (r < IT_WOUT) { transpose_item(in.w_out + (size_t)l * DM * DM, DM, (bf16_t*)(wl + WO_WOUT), DM, 0, 3, scr, r / 64, r % 64, lane); continue; } r -= IT_WOUT;
        if (r < IT_WF1) { const int nbk = 2 * DFF / 32; transpose_item(in.w_f1 + (size_t)l * DM * 2 * DFF, 2 * DFF, (bf16_t*)(wl + WO_WF1), DM, 0, 2, scr, r / nbk, r % nbk, lane); continue; } r -= IT_WF1;
        transpose_item(in.w_f2 + (size_t)l * DFF * DM, DM, (bf16_t*)(wl + WO_WF2), DFF, 0, 3, scr, r / 64, r % 64, lane);
    }
}
__device__ __forceinline__ void p0_rope(float* rope, int gtid, int ngt) {
    for (int idx = gtid; idx < LSEQ * 32; idx += ngt) {
        const int t = idx >> 5, i = idx & 31;
        double pwd = 1.0; for (int e = 0; e < i; ++e) pwd *= 1.3335214321633240;
        const float pw = (float)pwd;
        const float inv = 1.0f / pw;
        const float ang = (float)t * inv;
        float c, s; sincos_d((double)ang, c, s);
        rope[idx * 2] = c; rope[idx * 2 + 1] = s;
    }
}

__device__ __forceinline__ void t_norm(int mode, bool last, const Ins& in, float* H, const float* MIX, bf16_t* HN, float* out, const float* gpost, const float* gpre, int gw, int NGW, int lane) {
    asm volatile("" : "+v"(lane));
#pragma unroll 1
    for (int r = gw; r < MTOK; r += NGW) {
        f32x4 v[8];
        if (mode == 0) {
            const float* src = r < MREAL ? in.x + (size_t)r * DM : in.meta + (size_t)(r - MREAL) * DM;
#pragma unroll
            for (int j = 0; j < 8; ++j) v[j] = *(const f32x4*)(src + 256 * j + 4 * lane);
        } else {
            f32x4 m[8]; float ss = 0.f;
#pragma unroll
            for (int j = 0; j < 8; ++j) { m[j] = *(const f32x4*)(MIX + (size_t)r * DM + 256 * j + 4 * lane); ss += (m[j][0] * m[j][0] + m[j][1] * m[j][1]) + (m[j][2] * m[j][2] + m[j][3] * m[j][3]); }
            const float rstd = 1.0f / sqrtf(wave_sum(ss) * (1.0f / DM) + EPS);
#pragma unroll
            for (int j = 0; j < 8; ++j) { const f32x4 g = *(const f32x4*)(gpost + 256 * j + 4 * lane); const f32x4 hb = *(const f32x4*)(H + (size_t)r * DM + 256 * j + 4 * lane); v[j] = hb + (m[j] * rstd) * g; }
        }
        if (last) {
            if (r < MREAL) {
#pragma unroll
                for (int j = 0; j < 8; ++j) *(f32x4*)(out + (size_t)r * DM + 256 * j + 4 * lane) = v[j];
            }
            continue;
        }
        float ss = 0.f;
#pragma unroll
        for (int j = 0; j < 8; ++j) { *(f32x4*)(H + (size_t)r * DM + 256 * j + 4 * lane) = v[j]; ss += (v[j][0] * v[j][0] + v[j][1] * v[j][1]) + (v[j][2] * v[j][2] + v[j][3] * v[j][3]); }
        const float rstd = 1.0f / sqrtf(wave_sum(ss) * (1.0f / DM) + EPS);
#pragma unroll
        for (int j = 0; j < 8; ++j) { const f32x4 g = *(const f32x4*)(gpre + 256 * j + 4 * lane); const f32x4 y = (v[j] * rstd) * g; st_bf4(HN + (size_t)r * DM + 256 * j + 4 * lane, y); }
    }
}

__device__ __forceinline__ void t1_phase(int l, const Ins& in, const bf16_t* PROJ, const float* MISC, bf16_t* CQN, bf16_t* CKVN, bf16_t* KA, bf16_t* OCAT, float* CB, const float* rope, LAS float* scr, int gw, int NGW, int lane) {
    asm volatile("" : "+v"(lane));
    if (gw < 32) {
        const int b = gw >> 3, h = gw & 7; const float bias = in.b_forget[l * NH + h];
        {
            float x[33];
#pragma unroll
            for (int c = 0; c < 33; ++c) { const int t = c * 64 + lane; x[c] = t < LSEQ ? MISC[(size_t)row_of(b, t) * 128 + 64 + h] + bias : 0.f; }
#pragma unroll
            for (int c = 0; c < 33; ++c) scr[c * 64 + lane] = x[c];
        }
        LDS_WAIT(); asm volatile("" ::: "memory");
        float carry = 0.f;
#pragma unroll 1
        for (int c = 0; c < 33; ++c) { const int t = c * 64 + lane; const float xv = scr[c * 64 + lane];
            float lf = fminf(xv, 0.f) - log1pf(expf(-fabsf(xv))); if (t >= LSEQ) lf = 0.f;
#pragma unroll
            for (int o = 1; o < 64; o <<= 1) { const float y = __shfl_up(lf, o); if (lane >= o) lf += y; }
            lf += carry; carry = __shfl(lf, 63);
            if (t < LSEQ) CB[gw * CBLD + t] = lf; }
    }
    const float* gq = in.g_q + l * 512; const float* gkv = in.g_kv + l * 512; const float* cw = in.conv_w + (size_t)l * 3 * 1024;
#pragma unroll 1
    for (int r = gw; r < MTOK; r += NGW) {
        {
            const int half = lane >> 5, c0 = (lane & 31) * 16;
            const bf16_t* src = PROJ + (size_t)r * N1 + half * 512 + c0;
            const u32x4 a = *(const u32x4*)src, b = *(const u32x4*)(src + 8);
            float v[16] = {bflo(a.x), bfhi(a.x), bflo(a.y), bfhi(a.y), bflo(a.z), bfhi(a.z), bflo(a.w), bfhi(a.w), bflo(b.x), bfhi(b.x), bflo(b.y), bfhi(b.y), bflo(b.z), bfhi(b.z), bflo(b.w), bfhi(b.w)};
            float ss = 0.f;
#pragma unroll
            for (int e = 0; e < 16; ++e) ss += v[e] * v[e];
#pragma unroll
            for (int o = 1; o < 32; o <<= 1) ss += __shfl_xor(ss, o);
            const float rstd = 1.0f / sqrtf(ss * (1.0f / 512.0f) + EPS);
            const float* g = (half ? gkv : gq) + c0;
            u32x4 o0, o1;
            o0.x = cvtpk(v[0] * rstd * g[0], v[1] * rstd * g[1]); o0.y = cvtpk(v[2] * rstd * g[2], v[3] * rstd * g[3]); o0.z = cvtpk(v[4] * rstd * g[4], v[5] * rstd * g[5]); o0.w = cvtpk(v[6] * rstd * g[6], v[7] * rstd * g[7]);
            o1.x = cvtpk(v[8] * rstd * g[8], v[9] * rstd * g[9]); o1.y = cvtpk(v[10] * rstd * g[10], v[11] * rstd * g[11]); o1.z = cvtpk(v[12] * rstd * g[12], v[13] * rstd * g[13]); o1.w = cvtpk(v[14] * rstd * g[14], v[15] * rstd * g[15]);
            bf16_t* dst = (half ? CKVN : CQN) + (size_t)r * 512 + c0;
            *(u32x4*)dst = o0; *(u32x4*)(dst + 8) = o1;
        }
        const int t = t_of(r), b = r < MREAL ? (r >> 11) : 0;
        if (lane < 32) {
            const float x1 = MISC[(size_t)r * 128 + lane], x2 = MISC[(size_t)r * 128 + 32 + lane];
            const f32x2 cs = *(const f32x2*)(rope + ((size_t)t * 32 + lane) * 2);
            const unsigned w = cvtpk(x1 * cs[0] - x2 * cs[1], x1 * cs[1] + x2 * cs[0]);
#pragma unroll
            for (int h = 0; h < NH; ++h) *(unsigned*)(KA + (size_t)r * 1536 + h * HQK + 128 + 2 * lane) = w;
        }
        {
            const int c0 = lane * 16; float acc[16];
#pragma unroll
            for (int e = 0; e < 16; ++e) acc[e] = 0.f;
#pragma unroll
            for (int kk = 0; kk < 3; ++kk) {
                const int tt = t - 2 + kk; if (tt < 0) continue;
                const size_t rr = (size_t)row_of(b, tt);
                const u32x4 c0v = *(const u32x4*)(PROJ + rr * N1 + PC_CONVC + c0), c1v = *(const u32x4*)(PROJ + rr * N1 + PC_CONVC + c0 + 8);
                const u32x4 x0v = *(const u32x4*)(PROJ + rr * N1 + PC_CONVX + c0), x1v = *(const u32x4*)(PROJ + rr * N1 + PC_CONVX + c0 + 8);
                const float* w = cw + kk * 1024 + c0;
                const unsigned cc[8] = {c0v.x, c0v.y, c0v.z, c0v.w, c1v.x, c1v.y, c1v.z, c1v.w}; const unsigned xx[8] = {x0v.x, x0v.y, x0v.z, x0v.w, x1v.x, x1v.y, x1v.z, x1v.w};
#pragma unroll
                for (int e = 0; e < 8; ++e) { acc[2 * e] += w[2 * e] * (bflo(cc[e]) * bflo(xx[e])); acc[2 * e + 1] += w[2 * e + 1] * (bfhi(cc[e]) * bfhi(xx[e])); }
            }
            const u32x4 b0v = *(const u32x4*)(PROJ + (size_t)r * N1 + PC_CONVB + c0), b1v = *(const u32x4*)(PROJ + (size_t)r * N1 + PC_CONVB + c0 + 8);
            const unsigned bb[8] = {b0v.x, b0v.y, b0v.z, b0v.w, b1v.x, b1v.y, b1v.z, b1v.w};
            unsigned o[8];
#pragma unroll
            for (int e = 0; e < 8; ++e) o[e] = cvtpk(bflo(bb[e]) * acc[2 * e], bfhi(bb[e]) * acc[2 * e + 1]);
            bf16_t* dst = OCAT + (size_t)r * 3072 + 1024 + c0;
            *(u32x4*)dst = (u32x4){o[0], o[1], o[2], o[3]}; *(u32x4*)(dst + 8) = (u32x4){o[4], o[5], o[6], o[7]};
        }
    }
}

__device__ __forceinline__ void attn_naive(LAS unsigned char* lds, const bf16_t* PROJ, const bf16_t* QA, const bf16_t* KA, const bf16_t* VA, const float* CB, bf16_t* OCAT, int tmax, int nb, int gw, int NGW, int wave, int lane) {
    asm volatile("" : "+v"(lane));
    LAS float* sc = (LAS float*)lds + wave * 2304; LAS float* qs = sc + 2112;
#pragma unroll 1
    for (int it = gw; it < 2 * nb * NH * tmax; it += NGW) {
        const int t = it % tmax; const int r_ = it / tmax; const int h = r_ & 7, b = (r_ >> 3) % nb, ty = (r_ >> 3) / nb;
        const int row = row_of(b, t); const int dk = ty ? 128 : HQK;
        const bf16_t* qp = ty ? PROJ + (size_t)row * N1 + PC_FQ + h * 128 : QA + (size_t)row * 1536 + h * HQK;
        const bf16_t* kbase = ty ? PROJ + PC_FK + h * 128 : KA + h * HQK; const int ldk = ty ? N1 : 1536;
        const bf16_t* vbase = ty ? PROJ + PC_FV + h * 128 : VA + h * 128; const int ldv = ty ? N1 : 1024;
        const float scale = ty ? 0.08838834764831845f : 0.07216878364870323f;
        const float* cb = CB + (b * NH + h) * CBLD;
        for (int d = lane; d < dk; d += 64) qs[d] = bf2f(qp[d]);
        LDS_WAIT(); asm volatile("" ::: "memory");
        const float ct = ty ? cb[t] : 0.f;
        float mx = -1e30f;
#pragma unroll 1
        for (int s = lane; s <= t; s += 64) {
            const bf16_t* kp = kbase + (size_t)row_of(b, s) * ldk; float dot = 0.f;
#pragma unroll 4
            for (int d8 = 0; d8 < dk; d8 += 8) { const u32x4 kv = *(const u32x4*)(kp + d8);
                dot += qs[d8] * bflo(kv.x) + qs[d8 + 1] * bfhi(kv.x) + qs[d8 + 2] * bflo(kv.y) + qs[d8 + 3] * bfhi(kv.y) + qs[d8 + 4] * bflo(kv.z) + qs[d8 + 5] * bfhi(kv.z) + qs[d8 + 6] * bflo(kv.w) + qs[d8 + 7] * bfhi(kv.w); }
            float v = dot * scale; if (ty) v += ct - cb[s];
            sc[s] = v; mx = fmaxf(mx, v);
        }
        mx = wave_max(mx);
        float sum = 0.f;
        for (int s = lane; s <= t; s += 64) { const float p = __expf(sc[s] - mx); sc[s] = p; sum += p; }
        sum = wave_sum(sum);
        LDS_WAIT(); asm volatile("" ::: "memory");
        float a0 = 0.f, a1 = 0.f;
#pragma unroll 4
        for (int s = 0; s <= t; ++s) { const float p = sc[s]; const unsigned w = *(const unsigned*)(vbase + (size_t)row_of(b, s) * ldv + 2 * lane); a0 += p * bflo(w); a1 += p * bfhi(w); }
        const float inv = 1.0f / sum;
        *(unsigned*)(OCAT + (size_t)row * 3072 + (ty ? 2048 : 0) + h * 128 + 2 * lane) = cvtpk(a0 * inv, a1 * inv);
        LDS_WAIT(); asm volatile("" ::: "memory");
    }
}

namespace fa {
constexpr int NW = 8, QBLK = 32, KVBLK = 64, QB = NW * QBLK, DV = 128;
constexpr int SHM_V = KVBLK * DV * 2;
typedef short s16x4 __attribute__((ext_vector_type(4)));
typedef float f32x16 __attribute__((ext_vector_type(16)));
#define FA_SBAR() __builtin_amdgcn_sched_barrier(0)
__device__ __forceinline__ int v_st(int k, int c) { const int kk = (k & ~0xC) | ((k & 4) << 1) | ((k & 8) >> 1); return ((kk >> 3) * 4 + (c >> 5)) * 512 + ((kk & 7) * 32 + (c & 31)) * 2; }
__device__ __forceinline__ int v_rd_base(int lane) { return ((lane & 3) << 3) | (((lane >> 2) & 3) << 6) | (((lane >> 4) & 1) << 5) | (((lane >> 5) & 1) << 8); }
constexpr int v_rd_off(int d0, int ks, int half) { return d0 * 512 + ks * 4096 + half * 2048; }
__device__ __forceinline__ int crow(int r, int hi) { return (r & 3) + 8 * (r >> 2) + 4 * hi; }
__device__ __forceinline__ unsigned cvtpk_a(float lo, float hi) { unsigned r; asm volatile("v_cvt_pk_bf16_f32 %0, %1, %2" : "=v"(r) : "v"(lo), "v"(hi)); return r; }
__device__ __forceinline__ void mask_tile(f32x16& p0, f32x16& p1, int dq) {
    const float NEG = -__builtin_inff();
#pragma unroll
    for (int r = 0; r < 16; ++r) { const int c = (r & 3) + 8 * (r >> 2); if (dq - c < 0) p0[r] = NEG; if (dq - c - 32 < 0) p1[r] = NEG; }
}
__device__ __forceinline__ void mask_meta(f32x16& p0, f32x16& p1) {
    const float NEG = -__builtin_inff();
#pragma unroll
    for (int r = 8; r < 16; ++r) p0[r] = NEG;
#pragma unroll
    for (int r = 0; r < 16; ++r) p1[r] = NEG;
}
__device__ __forceinline__ void partialSM(f32x16& p0, f32x16& p1, float& m_reg, float& mn, float& alpha, const float SCALE) {
    float pmax = p0[0];
#pragma unroll
    for (int r = 1; r < 16; ++r) pmax = fmaxf(pmax, p0[r]);
#pragma unroll
    for (int r = 0; r < 16; ++r) pmax = fmaxf(pmax, p1[r]);
    { auto rr = __builtin_amdgcn_permlane32_swap(__float_as_uint(pmax), __float_as_uint(pmax), false, false); pmax = fmaxf(__uint_as_float(rr[0]), __uint_as_float(rr[1])); }
    const float C2 = 1.4426950408889634f * SCALE;
    if (__builtin_expect(__all((pmax - m_reg) * SCALE <= 8.f), 1)) { mn = m_reg; alpha = 1.f; }
    else { mn = fmaxf(m_reg, pmax); alpha = __builtin_amdgcn_exp2f((m_reg - mn) * C2); m_reg = mn; }
    const float mnL = -mn * C2;
#pragma unroll
    for (int r = 0; r < 16; ++r) p0[r] = fmaf(p0[r], C2, mnL);
#pragma unroll
    for (int r = 0; r < 16; ++r) p1[r] = fmaf(p1[r], C2, mnL);
#pragma unroll
    for (int r = 0; r < 16; ++r) p0[r] = __builtin_amdgcn_exp2f(p0[r]);
}
__device__ __forceinline__ void finishSM(f32x16& p0, f32x16& p1, float alpha, float& l_reg, bf16x8& pa0, bf16x8& pa1, bf16x8& pa2, bf16x8& pa3) {
#pragma unroll
    for (int r = 0; r < 16; ++r) p1[r] = __builtin_amdgcn_exp2f(p1[r]);
    float ps = 0;
#pragma unroll
    for (int r = 0; r < 16; ++r) ps += p0[r];
#pragma unroll
    for (int r = 0; r < 16; ++r) ps += p1[r];
    { auto rr = __builtin_amdgcn_permlane32_swap(__float_as_uint(ps), __float_as_uint(ps), false, false); ps = __uint_as_float(rr[0]) + __uint_as_float(rr[1]); }
    l_reg = l_reg * alpha + ps;
#define FA_PK4(P, B_, OUT) do { unsigned a0 = cvtpk_a(P[B_+0], P[B_+1]), a1 = cvtpk_a(P[B_+2], P[B_+3]); unsigned b0 = cvtpk_a(P[B_+4], P[B_+5]), b1 = cvtpk_a(P[B_+6], P[B_+7]); \
        auto r0 = __builtin_amdgcn_permlane32_swap(a0, b0, false, false); auto r1 = __builtin_amdgcn_permlane32_swap(a1, b1, false, false); \
        u32x4 w = {r0[0], r1[0], r0[1], r1[1]}; OUT = *reinterpret_cast<bf16x8*>(&w); } while (0)
    FA_PK4(p0, 0, pa0); FA_PK4(p0, 8, pa1); FA_PK4(p1, 0, pa2); FA_PK4(p1, 8, pa3);
#undef FA_PK4
}
template <int DK> __device__ __forceinline__ int kswz(int row, int colB) { return row * (2 * DK) + (colB ^ ((row & 7) << 4)); }
template <int DK, int KB, bool BIAS>
__device__ __forceinline__ void qkt(f32x16& p0, f32x16& p1, const char* K_lds, const float* bias_lds, int r32, int hi, const bf16x8* qr) {
    constexpr int SHM_K = KVBLK * DK * 2;
    if constexpr (BIAS) {
        const float* bp = bias_lds + KB * 64 + 4 * hi;
#pragma unroll
        for (int g = 0; g < 4; ++g) { const f32x4 a = *(const f32x4*)(bp + 8 * g), b = *(const f32x4*)(bp + 32 + 8 * g);
            p0[4 * g] = a[0]; p0[4 * g + 1] = a[1]; p0[4 * g + 2] = a[2]; p0[4 * g + 3] = a[3]; p1[4 * g] = b[0]; p1[4 * g + 1] = b[1]; p1[4 * g + 2] = b[2]; p1[4 * g + 3] = b[3]; }
    } else { p0 = f32x16{}; p1 = f32x16{}; }
    const char* kb[4];
#pragma unroll
    for (int dd = 0; dd < 4; ++dd) kb[dd] = K_lds + KB * SHM_K + kswz<DK>(r32, (dd * 16 + hi * 8) * 2);
#pragma unroll
    for (int d0 = 0; d0 < DK / 16; ++d0) { const char* a = kb[d0 & 3] + (d0 >> 2) * 128;
        bf16x8 b0 = *reinterpret_cast<const bf16x8*>(a);
        bf16x8 b1 = *reinterpret_cast<const bf16x8*>(a + 32 * 2 * DK);
        p0 = __builtin_amdgcn_mfma_f32_32x32x16_bf16(b0, qr[d0], p0, 0, 0, 0);
        p1 = __builtin_amdgcn_mfma_f32_32x32x16_bf16(b1, qr[d0], p1, 0, 0, 0); }
}
template <int VB>
__device__ __forceinline__ void pv_tile(f32x16* o, int vb0, bf16x8 pa0, bf16x8 pa1, bf16x8 pa2, bf16x8 pa3) {
#define FA_TRRD(dst, off) asm volatile("ds_read_b64_tr_b16 %0, %1 offset:%2" : "=&v"(dst) : "v"(vb0), "i"(off) : "memory")
#define FA_PV_D0(d0) do { s16x4 l0, l1, l2, l3, h0, h1, h2, h3; constexpr int b_ = VB * SHM_V + v_rd_off(d0, 0, 0); \
        FA_TRRD(l0, b_); FA_TRRD(h0, b_ + 2048); FA_TRRD(l1, b_ + 4096); FA_TRRD(h1, b_ + 6144); FA_TRRD(l2, b_ + 8192); FA_TRRD(h2, b_ + 10240); FA_TRRD(l3, b_ + 12288); FA_TRRD(h3, b_ + 14336); \
        asm volatile("s_waitcnt lgkmcnt(0)" ::: "memory"); FA_SBAR(); \
        o[d0] = __builtin_amdgcn_mfma_f32_32x32x16_bf16(pa0, (bf16x8){l0[0], l0[1], l0[2], l0[3], h0[0], h0[1], h0[2], h0[3]}, o[d0], 0, 0, 0); \
        o[d0] = __builtin_amdgcn_mfma_f32_32x32x16_bf16(pa1, (bf16x8){l1[0], l1[1], l1[2], l1[3], h1[0], h1[1], h1[2], h1[3]}, o[d0], 0, 0, 0); \
        o[d0] = __builtin_amdgcn_mfma_f32_32x32x16_bf16(pa2, (bf16x8){l2[0], l2[1], l2[2], l2[3], h2[0], h2[1], h2[2], h2[3]}, o[d0], 0, 0, 0); \
        o[d0] = __builtin_amdgcn_mfma_f32_32x32x16_bf16(pa3, (bf16x8){l3[0], l3[1], l3[2], l3[3], h3[0], h3[1], h3[2], h3[3]}, o[d0], 0, 0, 0); } while (0)
    FA_PV_D0(0); FA_PV_D0(1); FA_PV_D0(2); FA_PV_D0(3);
#undef FA_PV_D0
#undef FA_TRRD
}
struct Blk { const bf16_t* Q; const bf16_t* Kr; const bf16_t* Km; const bf16_t* Vr; const bf16_t* Vm; const float* cbr; const float* cbm; bf16_t* O; int P0; };
template <int DK> struct Seam { bf16x8 qr[DK / 16]; bf16x8 st_v0, st_v1; bf16x8 st_k[DK / 64]; float st_b; };
template <int DK> constexpr int lds_bytes() { return 2 * SHM_V + 2 * KVBLK * DK * 2 + NW * 64 * 4 + 2 * 64 * 4; }

#define FA_VMW() asm volatile("s_waitcnt vmcnt(0)" ::: "memory")
template <int DK, bool BIAS>
__device__ __forceinline__ void fa_load_tile(const Blk& B, int kb, int ldk, int ldv, int tid, Seam<DK>& S, const float BSC) {
    const bf16_t* Kp = kb == 0 ? B.Km : B.Kr; const bf16_t* Vp = kb == 0 ? B.Vm : B.Vr;
    const int sr = tid >> 4, sc = (tid & 15) * 8;
    S.st_v0 = *(const bf16x8*)(Vp + (size_t)(kb + sr) * ldv + sc); S.st_v1 = *(const bf16x8*)(Vp + (size_t)(kb + 32 + sr) * ldv + sc);
#pragma unroll
    for (int j = 0; j < DK / 64; ++j) { const int ci = tid + 512 * j, row = ci / (DK / 8), cc = ci % (DK / 8); S.st_k[j] = *(const bf16x8*)(Kp + (size_t)(kb + row) * ldk + cc * 8); }
    if constexpr (BIAS) { const float* cp = kb == 0 ? B.cbm : B.cbr; S.st_b = cp[kb + (tid & 63)] * BSC; }
}
template <int DK, bool BIAS>
__device__ __forceinline__ void fa_write_k(char* K_lds, float* bias_lds, int bf, int tid, const Seam<DK>& S) {
    constexpr int SHM_K = KVBLK * DK * 2;
#pragma unroll
    for (int j = 0; j < DK / 64; ++j) { const int ci = tid + 512 * j, row = ci / (DK / 8), cc = ci % (DK / 8); *(bf16x8*)(K_lds + bf * SHM_K + kswz<DK>(row, cc * 16)) = S.st_k[j]; }
    if constexpr (BIAS) { if (tid < 64) bias_lds[bf * 64 + tid] = S.st_b; }
}
template <int DK>
__device__ __forceinline__ void fa_write_v(char* V_lds, int bf, int tid, const Seam<DK>& S) {
    const int sr = tid >> 4, sc = (tid & 15) * 8;
    *(bf16x8*)(V_lds + bf * SHM_V + v_st(sr, sc)) = S.st_v0; *(bf16x8*)(V_lds + bf * SHM_V + v_st(32 + sr, sc)) = S.st_v1;
}
template <int DK, bool BIAS>
__device__ __forceinline__ void fa_prime(const int tid, const Blk& cur, int ldq, int ldk, int ldv, char* lds, Seam<DK>& S, const float BSC) {
    const int wid = __builtin_amdgcn_readfirstlane(tid >> 6), lane = tid & 63, r32 = lane & 31, hi = lane >> 5;
    constexpr int SHM_K = KVBLK * DK * 2;
    char* K_lds = lds + 2 * SHM_V; float* bias_lds = (float*)(lds + 2 * SHM_V + 2 * SHM_K + NW * 64 * 4);
#pragma unroll
    for (int d0 = 0; d0 < DK / 16; ++d0) S.qr[d0] = *(const bf16x8*)(cur.Q + (size_t)(wid * QBLK + r32) * ldq + d0 * 16 + hi * 8);
    fa_load_tile<DK, BIAS>(cur, 0, ldk, ldv, tid, S, BSC); FA_VMW(); fa_write_k<DK, BIAS>(K_lds, bias_lds, 0, tid, S);
    __syncthreads();
}
template <int DK, bool BIAS>
__device__ __forceinline__ void fa_block(const int tid, const Blk& cur, const Blk& nxt, int ldq, int ldk, int ldv, int ldo, char* lds, Seam<DK>& S, const float SCALE, const float BSC) {
    const int wid = __builtin_amdgcn_readfirstlane(tid >> 6), lane = tid & 63, r32 = lane & 31, hi = lane >> 5;
    constexpr int SHM_K = KVBLK * DK * 2;
    const int NT = (cur.P0 + QB - 1) / KVBLK + 1;
    const int qlo = cur.P0 + wid * QBLK, qm = qlo + r32 - 4 * hi;
    char* V_lds = lds; char* K_lds = lds + 2 * SHM_V;
    float* ws = (float*)(lds + 2 * SHM_V + 2 * SHM_K) + wid * 64; float* li_l = ws; float* al_l = ws + 32;
    float* bias_lds = (float*)(lds + 2 * SHM_V + 2 * SHM_K + NW * 64 * 4);
    float m_reg = -1e30f, l_reg = 0; f32x16 o[4] = {};
    const int vb0 = (int)(uintptr_t)V_lds + v_rd_base(lane);
#define FA_RESC(a) do { if (__any((a) < 1.f)) { if (hi == 0) al_l[r32] = (a); asm volatile("s_waitcnt lgkmcnt(0)" ::: "memory"); \
                     _Pragma("unroll") for (int d_ = 0; d_ < 4; ++d_) _Pragma("unroll") for (int r = 0; r < 16; ++r) o[d_][r] *= al_l[crow(r, hi)]; } } while (0)
#define FA_KBASE(t) ((t) * KVBLK)
#define FA_MASKT(P0_, P1_, t) do { const int kb_ = FA_KBASE(t); if (kb_ == 0) mask_meta(P0_, P1_); else if (kb_ + KVBLK - 1 > qlo) mask_tile(P0_, P1_, qm - kb_); } while (0)
    f32x16 pA0, pA1, pB0, pB1; float mnA, mnB, alA, alB; bf16x8 pa0, pa1, pa2, pa3;
    fa_write_v<DK>(V_lds, 0, tid, S); FA_SBAR();
    if (NT > 1) fa_load_tile<DK, BIAS>(cur, FA_KBASE(1), ldk, ldv, tid, S, BSC);
    FA_SBAR(); qkt<DK, 0, BIAS>(pA0, pA1, K_lds, bias_lds, r32, hi, S.qr);
    FA_MASKT(pA0, pA1, 0); partialSM(pA0, pA1, m_reg, mnA, alA, SCALE);
    if (NT > 1) { FA_VMW(); fa_write_v<DK>(V_lds, 1, tid, S); fa_write_k<DK, BIAS>(K_lds, bias_lds, 1, tid, S); }
    __syncthreads();
#define FA_HALF_STEP(PX0, PX1, mnX, alX, PY0, PY1, alY, t, KB, VB, SB) do { \
        FA_SBAR(); qkt<DK, KB, BIAS>(PX0, PX1, K_lds, bias_lds, r32, hi, S.qr); \
        finishSM(PY0, PY1, alY, l_reg, pa0, pa1, pa2, pa3); FA_SBAR(); \
        if ((t) + 1 < NT) { fa_load_tile<DK, BIAS>(cur, FA_KBASE((t) + 1), ldk, ldv, tid, S, BSC); FA_SBAR(); } \
        pv_tile<VB>(o, vb0, pa0, pa1, pa2, pa3); FA_MASKT(PX0, PX1, (t)); partialSM(PX0, PX1, m_reg, mnX, alX, SCALE); \
        __syncthreads(); \
        if ((t) + 1 < NT) { FA_VMW(); fa_write_v<DK>(V_lds, SB, tid, S); fa_write_k<DK, BIAS>(K_lds, bias_lds, SB, tid, S); } \
        FA_RESC(alX); __syncthreads(); } while (0)
    for (int t = 1; t + 1 < NT; t += 2) {
        FA_HALF_STEP(pB0, pB1, mnB, alB, pA0, pA1, alA, t, 1, 0, 0);
        FA_HALF_STEP(pA0, pA1, mnA, alA, pB0, pB1, alB, t + 1, 0, 1, 1);
    }
    const bool even = (NT & 1) == 0;
    if (even) { FA_SBAR(); qkt<DK, 1, BIAS>(pB0, pB1, K_lds, bias_lds, r32, hi, S.qr); FA_SBAR(); }
    fa_load_tile<DK, BIAS>(nxt, 0, ldk, ldv, tid, S, BSC); FA_SBAR();
#pragma unroll
    for (int d0 = 0; d0 < DK / 16; ++d0) S.qr[d0] = *(const bf16x8*)(nxt.Q + (size_t)(wid * QBLK + r32) * ldq + d0 * 16 + hi * 8);
    FA_SBAR();
    finishSM(pA0, pA1, alA, l_reg, pa0, pa1, pa2, pa3); FA_SBAR();
    pv_tile<0>(o, vb0, pa0, pa1, pa2, pa3);
    if (even) { FA_MASKT(pB0, pB1, NT - 1); partialSM(pB0, pB1, m_reg, mnB, alB, SCALE); __syncthreads(); FA_RESC(alB);
        finishSM(pB0, pB1, alB, l_reg, pa0, pa1, pa2, pa3); FA_SBAR(); pv_tile<1>(o, vb0, pa0, pa1, pa2, pa3); }
    FA_SBAR();
    asm volatile("s_waitcnt vmcnt(%0)" :: "i"(DK / 16) : "memory");
    fa_write_k<DK, BIAS>(K_lds, bias_lds, 0, tid, S); FA_SBAR();
    if (hi == 0) li_l[r32] = l_reg; asm volatile("s_waitcnt lgkmcnt(0)" ::: "memory");
    float rli[16];
#pragma unroll
    for (int r = 0; r < 16; ++r) rli[r] = __builtin_amdgcn_rcpf(li_l[crow(r, hi)]);
    bf16_t* Ow = cur.O + (size_t)(wid * QBLK) * ldo;
#pragma unroll
    for (int r = 0; r < 16; ++r) { const int orow = crow(r, hi);
#pragma unroll
        for (int d0 = 0; d0 < 4; ++d0) { const float v = o[d0][r] * rli[r]; const float vn = __shfl_xor(v, 1);
            if ((r32 & 1) == 0) *(unsigned*)(Ow + (size_t)orow * ldo + d0 * 32 + r32) = cvtpk_a(v, vn); } }
    __syncthreads();
#undef FA_RESC
#undef FA_KBASE
#undef FA_MASKT
#undef FA_HALF_STEP
}
template <int DK, bool BIAS>
__device__ __forceinline__ void fa_block_sb(const int tid, const Blk& cur, int ldk, int ldv, int ldo, char* lds, Seam<DK>& S, const float SCALE, const float BSC) {
    const int wid = __builtin_amdgcn_readfirstlane(tid >> 6), lane = tid & 63, r32 = lane & 31, hi = lane >> 5;
    constexpr int SHM_K = KVBLK * DK * 2;
    const int NT = (cur.P0 + QB - 1) / KVBLK + 1;
    const int qlo = cur.P0 + wid * QBLK, qm = qlo + r32 - 4 * hi;
    char* V_lds = lds; char* K_lds = lds + 2 * SHM_V;
    float* ws = (float*)(lds + 2 * SHM_V + 2 * SHM_K) + wid * 64; float* li_l = ws; float* al_l = ws + 32;
    float* bias_lds = (float*)(lds + 2 * SHM_V + 2 * SHM_K + NW * 64 * 4);
    float m_reg = -1e30f, l_reg = 0; f32x16 o[4] = {};
    const int vb0 = (int)(uintptr_t)V_lds + v_rd_base(lane);
    fa_write_v<DK>(V_lds, 0, tid, S);
    __syncthreads();
#define FA_STEP(t, KB) do { f32x16 p0, p1; float mn, al; bf16x8 pa0, pa1, pa2, pa3; \
        if ((t) + 1 < NT) { fa_load_tile<DK, BIAS>(cur, ((t) + 1) * KVBLK, ldk, ldv, tid, S, BSC); FA_SBAR(); } \
        qkt<DK, KB, BIAS>(p0, p1, K_lds, bias_lds, r32, hi, S.qr); \
        { const int kb_ = (t) * KVBLK; if (kb_ == 0) mask_meta(p0, p1); else if (kb_ + KVBLK - 1 > qlo) mask_tile(p0, p1, qm - kb_); } \
        partialSM(p0, p1, m_reg, mn, al, SCALE); \
        if (__any(al < 1.f)) { if (hi == 0) al_l[r32] = al; asm volatile("s_waitcnt lgkmcnt(0)" ::: "memory"); \
            _Pragma("unroll") for (int d_ = 0; d_ < 4; ++d_) _Pragma("unroll") for (int r = 0; r < 16; ++r) o[d_][r] *= al_l[crow(r, hi)]; } \
        finishSM(p0, p1, al, l_reg, pa0, pa1, pa2, pa3); FA_SBAR(); \
        pv_tile<KB>(o, vb0, pa0, pa1, pa2, pa3); \
        if ((t) + 1 < NT) { FA_VMW(); fa_write_v<DK>(V_lds, 1 - KB, tid, S); fa_write_k<DK, BIAS>(K_lds, bias_lds, 1 - KB, tid, S); } \
        __syncthreads(); } while (0)
    int t = 0;
    for (; t + 1 < NT; t += 2) { FA_STEP(t, 0); FA_STEP(t + 1, 1); }
    if (t < NT) FA_STEP(t, 0);
#undef FA_STEP
    if (hi == 0) li_l[r32] = l_reg; asm volatile("s_waitcnt lgkmcnt(0)" ::: "memory");
    float rli[16];
#pragma unroll
    for (int r = 0; r < 16; ++r) rli[r] = __builtin_amdgcn_rcpf(li_l[crow(r, hi)]);
    bf16_t* Ow = cur.O + (size_t)(wid * QBLK) * ldo;
#pragma unroll
    for (int r = 0; r < 16; ++r) { const int orow = crow(r, hi);
#pragma unroll
        for (int d0 = 0; d0 < 4; ++d0) { const float v = o[d0][r] * rli[r]; const float vn = __shfl_xor(v, 1);
            if ((r32 & 1) == 0) *(unsigned*)(Ow + (size_t)orow * ldo + d0 * 32 + r32) = cvtpk_a(v, vn); } }
    __syncthreads();
}
}

__device__ __forceinline__ void attn_fast(char* lds, const bf16_t* PROJ, const bf16_t* QA, const bf16_t* KA, const bf16_t* VA, const float* CB, bf16_t* OCAT, int vcu, int G) {
    for (int v = vcu; v < NBATCH * NH * 8; v += G) {
        const int bh = v >> 3, qb = v & 7, b = bh >> 3, h = bh & 7;
#ifndef FA_ONLY
#define FA_ONLY 3
#endif
        if (FA_ONLY & 1) {
            fa::Blk B; const size_t r0 = (size_t)b * SEQ + qb * 256, rm = (size_t)MREAL;
            B.Q = QA + r0 * 1536 + h * HQK; B.Kr = KA + ((size_t)b * SEQ) * 1536 + h * HQK - (size_t)64 * 1536; B.Km = KA + rm * 1536 + h * HQK;
            B.Vr = VA + ((size_t)b * SEQ) * 1024 + h * 128 - (size_t)64 * 1024; B.Vm = VA + rm * 1024 + h * 128; B.cbr = nullptr; B.cbm = nullptr;
            B.O = OCAT + r0 * 3072 + h * 128; B.P0 = 64 + qb * 256;
            int tl = threadIdx.x; asm volatile("" : "+v"(tl));
            fa::Seam<192> S; fa::fa_prime<192, false>(tl, B, 1536, 1536, 1024, lds, S, 0.f);
            fa::fa_block_sb<192, false>(tl, B, 1536, 1024, 3072, lds, S, 0.07216878364870323f, 0.f);
        }
        if (FA_ONLY & 2) {
            const int qf = 7 - qb; fa::Blk B; const size_t r0 = (size_t)b * SEQ + qf * 256, rm = (size_t)MREAL;
            B.Q = PROJ + r0 * N1 + PC_FQ + h * 128; B.Kr = PROJ + ((size_t)b * SEQ) * N1 + PC_FK + h * 128 - (size_t)64 * N1; B.Km = PROJ + rm * N1 + PC_FK + h * 128;
            B.Vr = PROJ + ((size_t)b * SEQ) * N1 + PC_FV + h * 128 - (size_t)64 * N1; B.Vm = PROJ + rm * N1 + PC_FV + h * 128;
            B.cbm = CB + bh * CBLD; B.cbr = CB + bh * CBLD - 48;
            B.O = OCAT + r0 * 3072 + 2048 + h * 128; B.P0 = 64 + qf * 256;
            int tl = threadIdx.x; asm volatile("" : "+v"(tl));
            fa::Seam<128> S; fa::fa_prime<128, true>(tl, B, N1, N1, N1, lds, S, -11.313708498984761f);
            fa::fa_block<128, true>(tl, B, B, N1, N1, N1, 3072, lds, S, 0.08838834764831845f, -11.313708498984761f);
        }
    }
}

struct Args { const float* in[17]; float* out; unsigned char* ws; int ph_lo, ph_hi; };
__global__ void __launch_bounds__(NTHREADS, 2) fwd(Args args) {
    extern __shared__ __attribute__((aligned(16))) unsigned char lds_raw[];
    LAS unsigned char* lds = (LAS unsigned char*)lds_raw;
    volatile LAS unsigned* MISCW = (volatile LAS unsigned*)(lds + MISC_OFF);
    const int tid = threadIdx.x, lane = tid & 63, wave = __builtin_amdgcn_readfirstlane(tid >> 6);
    const int G = gridDim.x, bid = blockIdx.x;
    const int gw = bid * NWAVES + wave, NGW = G * NWAVES;
    const int vcu = (G % 8 == 0) ? (bid % 8) * (G / 8) + bid / 8 : bid;
    unsigned char* ws = args.ws;
    Ins in; in.x = args.in[0]; in.meta = args.in[1]; in.w_in = args.in[2]; in.b_forget = args.in[3]; in.g_q = args.in[4]; in.g_kv = args.in[5]; in.w_uq = args.in[6]; in.w_ukv = args.in[7];
    in.conv_w = args.in[8]; in.w_branch = args.in[9]; in.w_out = args.in[10]; in.w_f1 = args.in[11]; in.w_f2 = args.in[12]; in.g_mix_pre = args.in[13]; in.g_mix_post = args.in[14]; in.g_ffn_pre = args.in[15]; in.g_ffn_post = args.in[16];
    float* H = (float*)(ws + WS_H); bf16_t* HN = (bf16_t*)(ws + WS_HN); bf16_t* PROJ = (bf16_t*)(ws + WS_PROJ); float* MISC = (float*)(ws + WS_MISC);
    bf16_t* CQN = (bf16_t*)(ws + WS_CQN); bf16_t* CKVN = (bf16_t*)(ws + WS_CKVN); bf16_t* QA = (bf16_t*)(ws + WS_QA); bf16_t* KA = (bf16_t*)(ws + WS_KA); bf16_t* VA = (bf16_t*)(ws + WS_VA);
    float* CB = (float*)(ws + WS_CB); bf16_t* OCAT = (bf16_t*)(ws + WS_OCAT); float* MIXF = (float*)(ws + WS_MIXF); bf16_t* MERGED = (bf16_t*)(ws + WS_MERGED); bf16_t* ACT = (bf16_t*)(ws + WS_ACT);
    float* ROPE = (float*)(ws + WS_ROPE);

    for (int u = tid; u < (LDS_BYTES - RING_BYTES) / 4; u += NTHREADS) ((LAS unsigned*)(lds + RING_BYTES))[u] = 0u;
    __syncthreads();
    const int lo = args.ph_lo, hi = args.ph_hi;
    XcdBarrier bar; bar.bar = (unsigned*)(ws + WS_CTL) + 4096; bar.x = 0; bar.st = nullptr;
    if (hi - lo > 1) bar = xcd_barrier_post((unsigned*)(ws + WS_CTL) + 4096, MISCW + 8);
#ifndef SKIPMASK
#define SKIPMASK 0
#endif
#ifndef REPMASK
#define REPMASK 0
#endif
#define REP(k) for (int rep_ = 0; rep_ < 1 + ((REPMASK >> ((k) == 0 ? 0 : 1 + ((k) - 1) % 10)) & 1); ++rep_)
#define IN(k) (lo <= (k) && (k) < hi && !((SKIPMASK >> ((k) == 0 ? 0 : 1 + ((k) - 1) % 10)) & 1))
#define SEAM(k) do { if (IN(k) && IN((k) + 1)) xcd_barrier(bar); } while (0)

    if (IN(0)) REP(0) {
        if (rep_) xcd_barrier(bar);
        p0_weights(in, ws, lds, gw, NGW, wave, lane);
        p0_rope(ROPE, bid * NTHREADS + tid, G * NTHREADS);
        t_norm(0, false, in, H, nullptr, HN, nullptr, nullptr, in.g_mix_pre, gw, NGW, lane);
    }
    SEAM(0);
#pragma unroll 1
    for (int l = 0; l < DEPTH; ++l) {
        const int pb = 1 + 10 * l;
        const unsigned char* wl = ws + WS_W + (size_t)l * W_LAYER;
        if (IN(pb + 0)) REP(pb + 0) {
            if (rep_) xcd_barrier(bar);
            SchedPlain S{(const char*)HN, (const char*)(wl + WO_W1), DM, DM, N1T, G, bid}; EpiG1 E{PROJ, MISC};
            run_gemm(lds, DM, DM, DM, S, E);
            skinny_gemm(lds, HN + (size_t)MREAL * DM, DM, (const bf16_t*)(wl + WO_W1), DM, DM, N1 / 32, 1, 0, E, G, bid);
        }
        SEAM(pb + 0);
        if (IN(pb + 1)) REP(pb + 1) { if (rep_) xcd_barrier(bar); t1_phase(l, in, PROJ, MISC, CQN, CKVN, KA, OCAT, CB, ROPE, (LAS float*)(lds + wave * 16384), gw, NGW, lane); }
        SEAM(pb + 1);
        if (IN(pb + 2)) REP(pb + 2) {
            if (rep_) xcd_barrier(bar);
            SchedG2 S{(const char*)CKVN, (const char*)(wl + WO_WUKV), (const char*)CQN, (const char*)(wl + WO_WUQ), G, bid}; EpiG2 E{QA, KA, VA, ROPE};
            run_gemm(lds, 512, 512, 512, S, E);
            skinny_gemm(lds, CKVN + (size_t)MREAL * 512, 512, (const bf16_t*)(wl + WO_WUKV), 512, 512, 2048 / 32, 1, 0, E, G, bid);
            skinny_gemm(lds, CQN + (size_t)MREAL * 512, 512, (const bf16_t*)(wl + WO_WUQ), 512, 512, 1536 / 32, 1, 1, E, G, bid);
        }
        SEAM(pb + 2);
        if (IN(pb + 3)) REP(pb + 3) {
            if (rep_) xcd_barrier(bar);
#if FAST_ATTN
            attn_fast((char*)lds_raw, PROJ, QA, KA, VA, CB, OCAT, vcu, G);
            attn_naive(lds, PROJ, QA, KA, VA, CB, OCAT, NMETA, 1, gw, NGW, wave, lane);
#else
            attn_naive(lds, PROJ, QA, KA, VA, CB, OCAT, LSEQ, NBATCH, gw, NGW, wave, lane);
#endif
        }
        SEAM(pb + 3);
        if (IN(pb + 4)) REP(pb + 4) {
            if (rep_) xcd_barrier(bar);
            SchedG3 S{(const char*)OCAT, (const char*)(wl + WO_WBR), G, bid}; EpiG3 E{PROJ, MERGED};
            run_gemm(lds, 1024, 3072, 3072, S, E);
            skinny_gemm(lds, OCAT + (size_t)MREAL * 3072, 3072, (const bf16_t*)(wl + WO_WBR), 3072, 1024, DM / 32, 3, 0, E, G, bid);
        }
        SEAM(pb + 4);
        if (IN(pb + 5)) REP(pb + 5) {
            if (rep_) xcd_barrier(bar);
            SchedPlain S{(const char*)MERGED, (const char*)(wl + WO_WOUT), DM, DM, 8, G, bid}; EpiF32 E{MIXF};
            run_gemm(lds, DM, DM, DM, S, E);
            skinny_gemm(lds, MERGED + (size_t)MREAL * DM, DM, (const bf16_t*)(wl + WO_WOUT), DM, DM, DM / 32, 1, 0, E, G, bid);
        }
        SEAM(pb + 5);
        if (IN(pb + 6)) t_norm(1, false, in, H, MIXF, HN, nullptr, in.g_mix_post + l * DM, in.g_ffn_pre + l * DM, gw, NGW, lane);
        SEAM(pb + 6);
        if (IN(pb + 7)) REP(pb + 7) {
            if (rep_) xcd_barrier(bar);
            SchedPlain S{(const char*)HN, (const char*)(wl + WO_WF1), DM, DM, 2 * DFF / 256, G, bid}; EpiG5 E{ACT};
            run_gemm(lds, DM, DM, DM, S, E);
            skinny_gemm(lds, HN + (size_t)MREAL * DM, DM, (const bf16_t*)(wl + WO_WF1), DM, DM, 2 * DFF / 32, 1, 0, E, G, bid);
        }
        SEAM(pb + 7);
        if (IN(pb + 8)) REP(pb + 8) {
            if (rep_) xcd_barrier(bar);
            SchedPlain S{(const char*)ACT, (const char*)(wl + WO_WF2), DFF, DFF, 8, G, bid}; EpiF32 E{MIXF};
            run_gemm(lds, DFF, DFF, DFF, S, E);
            skinny_gemm(lds, ACT + (size_t)MREAL * DFF, DFF, (const bf16_t*)(wl + WO_WF2), DFF, DFF, DM / 32, 1, 0, E, G, bid);
        }
        SEAM(pb + 8);
        if (IN(pb + 9)) t_norm(1, l == DEPTH - 1, in, H, MIXF, HN, args.out, in.g_ffn_post + l * DM, in.g_mix_pre + (l + 1 < DEPTH ? l + 1 : 0) * DM, gw, NGW, lane);
        SEAM(pb + 9);
    }
#undef IN
#undef SEAM
}

extern "C" void kernel_launch(void* const* d_in, const int* in_sizes, int n_in, void* d_out, int out_size, void* d_ws, size_t ws_size, hipStream_t stream) {
    static int grid = 0;
    if (grid == 0) {
        if (n_in != 17 || out_size != MREAL * DM || ws_size < WS_END) { fprintf(stderr, "kernel_launch: unexpected shapes: n_in %d out %d ws %zu (need %zu)\n", n_in, out_size, ws_size, (size_t)WS_END); grid = -1; return; }
        int dev = 0, cus = 0, per_cu = 0;
        if (hipGetDevice(&dev) != hipSuccess || hipDeviceGetAttribute(&cus, hipDeviceAttributeMultiprocessorCount, dev) != hipSuccess) { grid = -1; return; }
        if (hipFuncSetAttribute((const void*)fwd, hipFuncAttributeMaxDynamicSharedMemorySize, LDS_BYTES) != hipSuccess) { fprintf(stderr, "kernel_launch: hipFuncSetAttribute failed\n"); grid = -1; return; }
        if (hipOccupancyMaxActiveBlocksPerMultiprocessor(&per_cu, (const void*)fwd, NTHREADS, LDS_BYTES) != hipSuccess || per_cu < 1) fprintf(stderr, "kernel_launch: occupancy query says %d\n", per_cu);
        (void)hipGetLastError();
        grid = cus;
    }
    if (grid < 0) return;
    (void)hipMemsetAsync((char*)d_ws + WS_CTL, 0, CTL_ZERO_BYTES, stream);
    Args a{};
    for (int i = 0; i < 17; ++i) a.in[i] = (const float*)d_in[i];
    a.out = (float*)d_out; a.ws = (unsigned char*)d_ws;
#if MK_ONE_LAUNCH
    a.ph_lo = 0; a.ph_hi = NPHASES;
    hipLaunchKernelGGL(fwd, dim3(grid), dim3(NTHREADS), LDS_BYTES, stream, a);
#else
    for (int p = 0; p < NPHASES; ++p) { a.ph_lo = p; a.ph_hi = p + 1; hipLaunchKernelGGL(fwd, dim3(grid), dim3(NTHREADS), LDS_BYTES, stream, a); }
#endif
}
```

```cpp
#include <hip/hip_runtime.h>
#include <cstdio>
#include <cstdint>

#ifndef MK_ONE_LAUNCH
#define MK_ONE_LAUNCH 1
#endif
#ifndef FAST_GEMM
#define FAST_GEMM 1
#endif
#ifndef FAST_ATTN
#define FAST_ATTN 1
#endif

#define GAS __attribute__((address_space(1)))
#define LAS __attribute__((address_space(3)))
typedef unsigned short bf16_t;
typedef short bf16x8 __attribute__((ext_vector_type(8)));
typedef float f32x4 __attribute__((ext_vector_type(4)));
typedef float f32x2 __attribute__((ext_vector_type(2)));
typedef unsigned u32x4 __attribute__((ext_vector_type(4)));
typedef unsigned u32x2 __attribute__((ext_vector_type(2)));
typedef __bf16 bf16x2_t __attribute__((ext_vector_type(2)));

constexpr int DM = 2048, NBATCH = 4, SEQ = 2048, DEPTH = 4, NMETA = 16, LSEQ = SEQ + NMETA;
constexpr int MREAL = NBATCH * SEQ;
constexpr int MTOK = MREAL + NMETA;
constexpr int MP = MREAL + 64, NPM = MREAL / 256;
constexpr int DIN = 13384, N1 = 13568, N1T = N1 / 256;
constexpr int DFF = 5632, NH = 8, HQK = 192;
constexpr float EPS = 1e-6f;
constexpr int PC_CQ = 0, PC_CKV = 512, PC_MISC = 1024, PC_CONVB = 1280, PC_CONVC = 2304, PC_CONVX = 3328, PC_FQ = 4352, PC_FK = 5376, PC_FV = 6400, PC_GATE = 7424;
constexpr int CBLD = 2112;

constexpr size_t al256(size_t x) { return (x + 255) & ~(size_t)255; }
constexpr size_t WS_CTL = 0, CTL_ZERO_BYTES = 1u << 20;
constexpr size_t SZ_W1 = (size_t)N1 * DM * 2, SZ_WUQ = (size_t)1536 * 512 * 2, SZ_WUKV = (size_t)2048 * 512 * 2, SZ_WBR = (size_t)DM * 3072 * 2,
                 SZ_WOUT = (size_t)DM * DM * 2, SZ_WF1 = (size_t)2 * DFF * DM * 2, SZ_WF2 = (size_t)DM * DFF * 2;
constexpr size_t WO_W1 = 0, WO_WUQ = WO_W1 + SZ_W1, WO_WUKV = WO_WUQ + SZ_WUQ, WO_WBR = WO_WUKV + SZ_WUKV, WO_WOUT = WO_WBR + SZ_WBR,
                 WO_WF1 = WO_WOUT + SZ_WOUT, WO_WF2 = WO_WF1 + SZ_WF1, W_LAYER = WO_WF2 + SZ_WF2;
constexpr size_t WS_W = CTL_ZERO_BYTES;
constexpr size_t WS_H = al256(WS_W + DEPTH * W_LAYER);
constexpr size_t WS_HN = al256(WS_H + (size_t)MP * DM * 4);
constexpr size_t WS_PROJ = al256(WS_HN + (size_t)MP * DM * 2);
constexpr size_t WS_MISC = al256(WS_PROJ + (size_t)MP * N1 * 2);
constexpr size_t WS_CQN = al256(WS_MISC + (size_t)MP * 128 * 4);
constexpr size_t WS_CKVN = al256(WS_CQN + (size_t)MP * 512 * 2);
constexpr size_t WS_QA = al256(WS_CKVN + (size_t)MP * 512 * 2);
constexpr size_t WS_KA = al256(WS_QA + (size_t)MP * 1536 * 2);
constexpr size_t WS_VA = al256(WS_KA + (size_t)MP * 1536 * 2);
constexpr size_t WS_CB = al256(WS_VA + (size_t)MP * 1024 * 2);
constexpr size_t WS_OCAT = al256(WS_CB + (size_t)32 * CBLD * 4);
constexpr size_t WS_MIXF = al256(WS_OCAT + (size_t)MP * 3072 * 2);
constexpr size_t WS_MERGED = al256(WS_MIXF + (size_t)MP * DM * 4);
constexpr size_t WS_ACT = al256(WS_MERGED + (size_t)MP * DM * 2);
constexpr size_t WS_ROPE = al256(WS_ACT + (size_t)MP * DFF * 2);
constexpr size_t WS_RSTD = al256(WS_ROPE + (size_t)LSEQ * 32 * 2 * 4);
constexpr size_t WS_END = al256(WS_RSTD + (size_t)MP * 4);

constexpr int NWAVES = 8, NTHREADS = NWAVES * 64;
constexpr int LDS_BYTES = 147456;
constexpr int RING_BYTES = 131072, MISC_OFF = LDS_BYTES - 256;
constexpr int NPHASES = 1 + 10 * DEPTH;

__device__ __forceinline__ unsigned cvtpk(float lo, float hi) { f32x2 v = {lo, hi}; bf16x2_t b = __builtin_convertvector(v, bf16x2_t); return __builtin_bit_cast(unsigned, b); }
__device__ __forceinline__ float bf2f(unsigned short u) { return __uint_as_float((unsigned)u << 16); }
__device__ __forceinline__ float bflo(unsigned w) { return __uint_as_float(w << 16); }
__device__ __forceinline__ float bfhi(unsigned w) { return __uint_as_float(w & 0xffff0000u); }
__device__ __forceinline__ float wave_sum(float v) {
#pragma unroll
    for (int o = 1; o < 64; o <<= 1) v += __shfl_xor(v, o);
    return v;
}
__device__ __forceinline__ float wave_max(float v) {
#pragma unroll
    for (int o = 1; o < 64; o <<= 1) v = fmaxf(v, __shfl_xor(v, o));
    return v;
}
__device__ __forceinline__ float sigmoidf_(float x) { return __builtin_amdgcn_rcpf(1.0f + __builtin_amdgcn_exp2f(-1.4426950408889634f * x)); }
__device__ __forceinline__ int row_of(int b, int t) { return t < NMETA ? MREAL + t : b * SEQ + t - NMETA; }
__device__ __forceinline__ int t_of(int r) { return r < MREAL ? NMETA + (r & (SEQ - 1)) : ((r - MREAL) & (NMETA - 1)); }
#define LDS_WAIT() asm volatile("s_waitcnt lgkmcnt(0)" ::: "memory")
#define VM_WAIT() asm volatile("s_waitcnt vmcnt(0)" ::: "memory")

#define XB_TMO      128
#define XB_XCNT(j)  (256  + 64 * (j))
#define XB_XSUB(j)  (1280 + 64 * (j))
#define XB_XGEN(j)  (2304 + 64 * (j))
#define XB_TOP      3328
#define XB_TOPGEN   3392
#define XCD_BAR_WORDS 3456
#define XB_SPIN_CAP (1u << 18)
__device__ __forceinline__ unsigned xb_ld(unsigned* p)              { return __hip_atomic_load(p, __ATOMIC_RELAXED, __HIP_MEMORY_SCOPE_AGENT); }
__device__ __forceinline__ unsigned xb_add(unsigned* p, unsigned v) { return __hip_atomic_fetch_add(p, v, __ATOMIC_RELAXED, __HIP_MEMORY_SCOPE_AGENT); }
__device__ __forceinline__ unsigned xb_xcc_id() { return (unsigned)__builtin_amdgcn_s_getreg((3 << 11) | 20) & 0xFu; }
#define XB_SPIN(cond, bar) do { unsigned _sp = 0; while (cond) { __builtin_amdgcn_s_sleep(1); \
    if ((++_sp & 255u) == 0u) { if (xb_ld(&(bar)[XB_TMO])) break; if (_sp > XB_SPIN_CAP) { atomicAdd(&(bar)[XB_TMO], 1u); break; } } } } while (0)
struct XcdBarrier { unsigned* bar; unsigned x; volatile LAS unsigned* st; };
__device__ __forceinline__ XcdBarrier xcd_barrier_post(unsigned* bar, volatile LAS unsigned* st) {
    XcdBarrier b; b.bar = bar; b.x = xb_xcc_id(); b.st = st;
    if (threadIdx.x == 0) (void)xb_add(&bar[XB_XCNT(b.x)], 1u);
    return b;
}
__device__ __forceinline__ void xcd_barrier_complete(unsigned* bar, unsigned x, unsigned& nloc, unsigned& nx) {
    const unsigned G = gridDim.x * gridDim.y * gridDim.z;
    unsigned sum, cnt, mine, sp = 0u;
    for (;;) {
        sum = 0u; cnt = 0u; mine = 0u;
#pragma unroll
        for (unsigned j = 0; j < 16; ++j) { const unsigned c = xb_ld(&bar[XB_XCNT(j)]); sum += c; cnt += (c > 0u) ? 1u : 0u; mine = (j == x) ? c : mine; }
        if (sum == G) break;
        __builtin_amdgcn_s_sleep(1);
        if ((++sp & 255u) == 0u) { if (xb_ld(&bar[XB_TMO])) break; if (sp > XB_SPIN_CAP) { atomicAdd(&bar[XB_TMO], 1u); break; } }
    }
    nloc = mine > 0u ? mine : 1u; nx = cnt > 0u ? cnt : 1u;
}
__device__ __forceinline__ void xcd_barrier(const XcdBarrier& b) {
    asm volatile("s_waitcnt vmcnt(0)" ::: "memory");
    __syncthreads();
    if (threadIdx.x == 0) {
        unsigned* bar = b.bar; asm volatile("" : "+s"(bar));
        __builtin_amdgcn_s_waitcnt(0);
        unsigned nloc = b.st[0], nx = b.st[1];
        if (nloc == 0u) { xcd_barrier_complete(bar, b.x, nloc, nx); b.st[0] = nloc; b.st[1] = nx; }
        const unsigned old = xb_add(&bar[XB_XSUB(b.x)], 1u);
        const unsigned gen = old / nloc;
        if (old + 1u == (gen + 1u) * nloc) {
            __builtin_amdgcn_fence(__ATOMIC_RELEASE, "agent");
            asm volatile("s_waitcnt vmcnt(0)" ::: "memory");
            const unsigned og = xb_add(&bar[XB_TOP], 1u);
            const unsigned tg = og / nx;
            if (og + 1u == (tg + 1u) * nx) xb_add(&bar[XB_TOPGEN], 1u);
            else XB_SPIN(xb_ld(&bar[XB_TOPGEN]) == tg, bar);
            __builtin_amdgcn_fence(__ATOMIC_ACQUIRE, "agent");
            xb_add(&bar[XB_XGEN(b.x)], 1u);
            asm volatile("s_waitcnt vmcnt(0)" ::: "memory");
        } else {
            XB_SPIN(xb_ld(&bar[XB_XGEN(b.x)]) == gen, bar);
            __builtin_amdgcn_fence(__ATOMIC_ACQUIRE, "agent");
            asm volatile("s_waitcnt vmcnt(0)" ::: "memory");
        }
    }
    __syncthreads();
}

struct Unit { int pm, pn, tag; const char* A; const char* B; };

__device__ __forceinline__ void tile_decode(int L, int nM, int nN, int& pm, int& pn) {
    const int nwg = nM * nN; int wgid = L;
    { const int q = nwg / 8, r = nwg % 8, xcd = wgid % 8, off = wgid / 8; wgid = (xcd < r ? xcd * (q + 1) : r * (q + 1) + (xcd - r) * q) + off; }
    const int nig = 8 * nN, gid = wgid / nig, fm = gid * 8, gsz = (nM - fm) < 8 ? (nM - fm) : 8;
    pm = fm + ((wgid % nig) % gsz); pn = (wgid % nig) / gsz;
}
struct SchedPlain {
    const char* A; const char* B; int lda, ldb, nN, G, c;
    __device__ __forceinline__ bool next(int i, Unit& u) const {
        const int L = i * G + c; if (L >= NPM * nN) return false;
        tile_decode(L, NPM, nN, u.pm, u.pn); u.tag = 0;
        u.A = A + (size_t)u.pm * 256 * lda * 2; u.B = B + (size_t)u.pn * 256 * ldb * 2; return true;
    }
};
struct SchedG2 {
    const char* Akv; const char* Bkv; const char* Aq; const char* Bq; int G, c;
    __device__ __forceinline__ bool next(int i, Unit& u) const {
        int L = i * G + c; if (L >= NPM * 14) return false;
        if (L < NPM * 8) { tile_decode(L, NPM, 8, u.pm, u.pn); u.tag = 0; u.A = Akv + (size_t)u.pm * 256 * 1024; u.B = Bkv + (size_t)u.pn * 256 * 1024; }
        else { L -= NPM * 8; tile_decode(L, NPM, 6, u.pm, u.pn); u.tag = 1; u.A = Aq + (size_t)u.pm * 256 * 1024; u.B = Bq + (size_t)u.pn * 256 * 1024; }
        return true;
    }
};
struct SchedG3 {
    const char* A; const char* B; int G, c;
    __device__ __forceinline__ bool next(int i, Unit& u) const {
        const int br = i % 3, L = (i / 3) * G + c; if (L >= NPM * 8) return false;
        tile_decode(L, NPM, 8, u.pm, u.pn); u.tag = br;
        u.A = A + ((size_t)u.pm * 256 * 3072 + br * 1024) * 2; u.B = B + ((size_t)u.pn * 256 * 3072 + br * 1024) * 2; return true;
    }
};

__device__ __forceinline__ void st_bf4(bf16_t* p, f32x4 v) { u32x2 w; w.x = cvtpk(v[0], v[1]); w.y = cvtpk(v[2], v[3]); *(u32x2*)p = w; }
struct EpiG1 {
    static constexpr bool CHAIN = false;
    bf16_t* proj; float* misc; const float* rstd;
    __device__ __forceinline__ void operator()(int, int row, int pn, int cj, f32x4& lo, f32x4& hi) const {
        const float rs = rstd[row]; lo = lo * rs; hi = hi * rs;
        if (pn >= PC_GATE / 256) {
#pragma unroll
            for (int e = 0; e < 4; ++e) { lo[e] = fmaxf(sigmoidf_(lo[e]), 7.888609052210118e-31f); hi[e] = fmaxf(sigmoidf_(hi[e]), 7.888609052210118e-31f); }
        }
        bf16_t* p = proj + (size_t)row * N1 + pn * 256 + cj;
        st_bf4(p, lo); st_bf4(p + 128, hi);
        if (pn == PC_MISC / 256) *(f32x4*)(misc + (size_t)row * 128 + cj) = lo;
    }
};
struct EpiG2 {
    static constexpr bool CHAIN = false;
    bf16_t* qa; bf16_t* ka; bf16_t* va; const float* rope;
    __device__ __forceinline__ void qcols(int row, int col, f32x4 v) const {
        const int h = col / HQK, j = col - h * HQK;
        if (j >= 128) {
            const int i0 = (j - 128) >> 1; const float* rp = rope + ((size_t)t_of(row) * 32 + i0) * 2;
            const f32x4 cs = *(const f32x4*)rp;
            v = (f32x4){v[0] * cs[0] - v[1] * cs[1], v[0] * cs[1] + v[1] * cs[0], v[2] * cs[2] - v[3] * cs[3], v[2] * cs[3] + v[3] * cs[2]};
        }
        st_bf4(qa + (size_t)row * 1536 + col, v);
    }
    __device__ __forceinline__ void operator()(int tag, int row, int pn, int cj, f32x4& lo, f32x4& hi) const {
        if (tag == 0) { st_bf4(ka + (size_t)row * 1536 + pn * HQK + cj, lo); st_bf4(va + (size_t)row * 1024 + pn * 128 + cj, hi); }
        else { qcols(row, pn * 256 + cj, lo); qcols(row, pn * 256 + 128 + cj, hi); }
    }
};
struct EpiG3 {
    static constexpr bool CHAIN = true;
    const bf16_t* proj; bf16_t* merged;
    __device__ __forceinline__ void one(int tag, int row, int col, f32x4& v) const {
        const bf16_t* gp = proj + (size_t)row * N1 + PC_GATE + tag * DM + col;
        const u32x2 g = *(const u32x2*)gp;
        f32x4 f = {bflo(g.x), bfhi(g.x), bflo(g.y), bfhi(g.y)};
        if (tag < 2) { const u32x2 gn = *(const u32x2*)(gp + DM);
            f = (f32x4){f[0] * __builtin_amdgcn_rcpf(bflo(gn.x)), f[1] * __builtin_amdgcn_rcpf(bfhi(gn.x)), f[2] * __builtin_amdgcn_rcpf(bflo(gn.y)), f[3] * __builtin_amdgcn_rcpf(bfhi(gn.y))}; }
        v = v * f;
        if (tag == 2) st_bf4(merged + (size_t)row * DM + col, v);
    }
    __device__ __forceinline__ void operator()(int tag, int row, int pn, int cj, f32x4& lo, f32x4& hi) const { one(tag, row, pn * 256 + cj, lo); one(tag, row, pn * 256 + 128 + cj, hi); }
};
struct EpiF32 {
    static constexpr bool CHAIN = false;
    float* out;
    __device__ __forceinline__ void operator()(int, int row, int pn, int cj, f32x4& lo, f32x4& hi) const {
        float* p = out + (size_t)row * DM + pn * 256 + cj; *(f32x4*)p = lo; *(f32x4*)(p + 128) = hi;
    }
};
struct EpiG5 {
    static constexpr bool CHAIN = false;
    bf16_t* act; const float* rstd;
    __device__ __forceinline__ void operator()(int, int row, int pn, int cj, f32x4& lo, f32x4& hi) const {
        const float rs = rstd[row]; lo = lo * rs; hi = hi * rs;
        f32x4 v;
#pragma unroll
        for (int e = 0; e < 4; ++e) v[e] = lo[e] * sigmoidf_(lo[e]) * hi[e];
        st_bf4(act + (size_t)row * DFF + pn * 128 + cj, v);
    }
};

template <class EF, class Sched>
__device__ __forceinline__ void gemm_simple(int K, int lda, int ldb, const Sched& S, const EF& E) {
    const int tid = threadIdx.x, wid = tid >> 6, lane = tid & 63, wr = wid >> 2, q = wid & 3, fr = lane & 15, fq = lane >> 4;
    Unit u;
#pragma unroll 1
    for (int i = 0; S.next(i, u); ++i) {
        const bf16_t* Ab = (const bf16_t*)u.A; const bf16_t* Bb = (const bf16_t*)u.B;
#pragma unroll 1
        for (int rb = 0; rb < 8; ++rb) {
            const int rloc = wr * 128 + rb * 16 + fr;
            f32x4 acc[4] = {};
            static_assert(!EF::CHAIN, "gemm_simple: no chained epilogues");
            const bf16_t* ap = Ab + (size_t)rloc * lda + fq * 8;
            const bf16_t* bp[4];
#pragma unroll
            for (int n = 0; n < 4; ++n) bp[n] = Bb + (size_t)((n >> 1) * 128 + q * 32 + (n & 1) * 16 + fr) * ldb + fq * 8;
#pragma unroll 2
            for (int k = 0; k < K; k += 32) {
                const bf16x8 a = *(const bf16x8*)(ap + k);
#pragma unroll
                for (int n = 0; n < 4; ++n) { const bf16x8 b = *(const bf16x8*)(bp[n] + k); acc[n] = __builtin_amdgcn_mfma_f32_16x16x32_bf16(b, a, acc[n], 0, 0, 0); }
            }
            const int row = u.pm * 256 + rloc;
#pragma unroll
            for (int n = 0; n < 2; ++n) E(u.tag, row, u.pn, q * 32 + n * 16 + 4 * fq, acc[n], acc[2 + n]);
        }
    }
}

namespace pg8 {
constexpr int BK = 64, HALF = 128, HTB = HALF * BK * 2, STAGE_BYTES = 8 * HTB;
__device__ __forceinline__ int lds_byte(int r, int c) { const int st = (r >> 4) * 2 + (c >> 5), rr = r & 15, cc = c & 31, ob = rr * 64 + cc * 2; return st * 1024 + (ob ^ (((ob >> 9) & 1) << 5)); }
__device__ __forceinline__ void stage_rc(int b, int& R, int& C) { const int st = b / 1024, sb = b % 1024, swz = sb ^ (((sb >> 9) & 1) << 5); R = (st >> 1) * 16 + swz / 64; C = (st & 1) * 32 + (swz % 64) / 2; }

template <class EF, class Sched, bool ALIGN_EPI>
__device__ __forceinline__ void gemm_phase(LAS unsigned char* lds, const int K, const int lda, const int ldb, const Sched& S, const EF& E) {
    int tid = threadIdx.x; asm volatile("" : "+v"(tid));
    const int wid = __builtin_amdgcn_readfirstlane(tid >> 6), lane = tid & 63, wr = wid >> 2, wc = wid & 3, fr = lane & 15, fq = lane >> 4;
    const int nt = K / BK;
    unsigned voffA[2], voffB[2];
#pragma unroll
    for (int i = 0; i < 2; ++i) { int R, C; stage_rc(tid * 16 + i * 8192, R, C); voffA[i] = (unsigned)(R * lda + C) * 2u; voffB[i] = (unsigned)(R * ldb + C) * 2u; }
    const size_t kstep = (size_t)(BK * 2);
    const size_t hstepA = (size_t)HALF * lda * 2, hstepB = (size_t)HALF * ldb * 2;
    const unsigned ldsw = (unsigned)wid * 1024u;
    const int aoff = lds_byte(wr * 64 + fr, fq * 8), boff = lds_byte(wc * 32 + fr, fq * 8);
#define PG8_SA(b, h) (((b) * 2 + (h)) * HTB)
#define PG8_SB(b, h) ((4 + (b) * 2 + (h)) * HTB)
#define PG8_STAGE(bufoff, gbase, voff) do { _Pragma("unroll") for (int _i = 0; _i < 2; ++_i) \
        __builtin_amdgcn_global_load_lds((const unsigned*)((const char*)(gbase) + (voff)[_i]), (LAS unsigned*)(lds + (bufoff) + ldsw + _i * 8192), 16, 0, 0); } while (0)
#define PG8_LDA(dst, b, h) do { _Pragma("unroll") for (int m = 0; m < 4; ++m) _Pragma("unroll") for (int k = 0; k < 2; ++k) dst[m][k] = *(const LAS bf16x8*)(lds + PG8_SA(b, h) + aoff + m * 2048 + k * 1024); } while (0)
#define PG8_LDB(dst, b, h) do { _Pragma("unroll") for (int n = 0; n < 2; ++n) _Pragma("unroll") for (int k = 0; k < 2; ++k) dst[n][k] = *(const LAS bf16x8*)(lds + PG8_SB(b, h) + boff + n * 2048 + k * 1024); } while (0)
#define PG8_MMA(ai, bj, At, Bt) do { __builtin_amdgcn_s_setprio(1); _Pragma("unroll") for (int m = 0; m < 4; ++m) _Pragma("unroll") for (int n = 0; n < 2; ++n) _Pragma("unroll") for (int k = 0; k < 2; ++k) \
        acc[ai][bj][m][n] = __builtin_amdgcn_mfma_f32_16x16x32_bf16(Bt[n][k], At[m][k], acc[ai][bj][m][n], 0, 0, 0); __builtin_amdgcn_s_setprio(0); } while (0)
#define PG8_WAIT_V(n) asm volatile("s_waitcnt vmcnt(" #n ")" ::: "memory")
#define PG8_WAIT_L(n) asm volatile("s_waitcnt lgkmcnt(" #n ")" ::: "memory")
#define PG8_BAR __builtin_amdgcn_s_barrier()
#define PG8_SCHED __builtin_amdgcn_sched_barrier(0)
    Unit cur, nxt; int ui = 0;
    if (!S.next(0, cur)) return;
    f32x4 acc[2][2][4][2];
#pragma unroll
    for (int a = 0; a < 2; ++a)
#pragma unroll
        for (int b = 0; b < 2; ++b)
#pragma unroll
            for (int m = 0; m < 4; ++m)
#pragma unroll
                for (int n = 0; n < 2; ++n) acc[a][b][m][n] = (f32x4){0.f, 0.f, 0.f, 0.f};
    bf16x8 At[4][2], B0[2][2], B1[2][2];
    const char* cA = cur.A; const char* cB = cur.B;
    PG8_STAGE(PG8_SB(0, 0), cB, voffB); PG8_STAGE(PG8_SB(0, 1), cB + hstepB, voffB); PG8_STAGE(PG8_SA(0, 0), cA, voffA); PG8_STAGE(PG8_SA(0, 1), cA + hstepA, voffA);
    if (wr == 1) PG8_BAR;
    PG8_WAIT_V(2); PG8_BAR;
    PG8_STAGE(PG8_SB(1, 0), cB + kstep, voffB); PG8_STAGE(PG8_SA(1, 0), cA + kstep, voffA); PG8_STAGE(PG8_SB(1, 1), cB + hstepB + kstep, voffB);
    PG8_WAIT_V(6); PG8_BAR;
    for (;;) {
        const bool has_next = S.next(ui + 1, nxt);
        const char* nA = has_next ? nxt.A : cA; const char* nB = has_next ? nxt.B : cB;
        for (int t = 0; t < nt; t += 2) {
            const bool last = (t == nt - 2);
            const char* a1 = cA + (size_t)(t + 1) * kstep;
            const char* a2 = last ? nA : cA + (size_t)(t + 2) * kstep; const char* b2 = last ? nB : cB + (size_t)(t + 2) * kstep;
            const char* a3 = a2 + kstep; const char* b3 = b2 + kstep;
            PG8_LDB(B0, 0, 0); PG8_LDB(B1, 0, 1); PG8_SCHED; PG8_LDA(At, 0, 0); PG8_STAGE(PG8_SA(1, 1), a1 + hstepA, voffA);
            PG8_WAIT_V(8); PG8_WAIT_L(0); PG8_BAR; PG8_MMA(0, 0, At, B0); PG8_MMA(0, 1, At, B1); PG8_BAR; PG8_SCHED;
            PG8_LDA(At, 0, 1); PG8_STAGE(PG8_SB(0, 0), b2, voffB); PG8_STAGE(PG8_SB(0, 1), b2 + hstepB, voffB); PG8_STAGE(PG8_SA(0, 0), a2, voffA);
            PG8_WAIT_V(8); PG8_WAIT_L(0); PG8_BAR; PG8_MMA(1, 0, At, B0); PG8_MMA(1, 1, At, B1); PG8_BAR; PG8_SCHED;
            PG8_LDB(B0, 1, 0); PG8_LDB(B1, 1, 1); PG8_SCHED; PG8_LDA(At, 1, 0); PG8_STAGE(PG8_SA(0, 1), a2 + hstepA, voffA);
            PG8_WAIT_V(8); PG8_WAIT_L(0); PG8_BAR; PG8_MMA(0, 0, At, B0); PG8_MMA(0, 1, At, B1); PG8_BAR; PG8_SCHED;
            PG8_LDA(At, 1, 1); PG8_STAGE(PG8_SB(1, 0), b3, voffB); PG8_STAGE(PG8_SB(1, 1), b3 + hstepB, voffB); PG8_STAGE(PG8_SA(1, 0), a3, voffA);
            PG8_WAIT_V(8); PG8_WAIT_L(0); PG8_BAR; PG8_MMA(1, 0, At, B0); PG8_MMA(1, 1, At, B1); PG8_BAR; PG8_SCHED;
        }
        if constexpr (ALIGN_EPI) { if (wr == 0) PG8_BAR; }
        {
#pragma unroll
            for (int ai = 0; ai < 2; ++ai)
#pragma unroll
                for (int m = 0; m < 4; ++m) { const int row = cur.pm * 256 + ai * HALF + wr * 64 + m * 16 + fr;
#pragma unroll
                    for (int n = 0; n < 2; ++n) E(cur.tag, row, cur.pn, wc * 32 + n * 16 + 4 * fq, acc[ai][0][m][n], acc[ai][1][m][n]); }
        }
        if (!has_next) break;
        if (!EF::CHAIN || cur.tag == 2) {
#pragma unroll
        for (int a = 0; a < 2; ++a)
#pragma unroll
            for (int b = 0; b < 2; ++b)
#pragma unroll
                for (int m = 0; m < 4; ++m)
#pragma unroll
                    for (int n = 0; n < 2; ++n) acc[a][b][m][n] = (f32x4){0.f, 0.f, 0.f, 0.f};
        }
        cur = nxt; cA = nA; cB = nB; ++ui;
        if constexpr (ALIGN_EPI) { if (wr == 1) PG8_BAR; }
    }
    PG8_WAIT_V(0);
    if constexpr (!ALIGN_EPI) { if (wr == 0) PG8_BAR; }
    PG8_BAR;
#undef PG8_SA
#undef PG8_SB
#undef PG8_STAGE
#undef PG8_LDA
#undef PG8_LDB
#undef PG8_MMA
#undef PG8_WAIT_V
#undef PG8_WAIT_L
#undef PG8_BAR
#undef PG8_SCHED
}
}

template <class EF, class Sched>
__device__ __forceinline__ void run_gemm(LAS unsigned char* lds, int K, int lda, int ldb, const Sched& S, const EF& E) {
#if FAST_GEMM
    pg8::gemm_phase<EF, Sched, true>(lds, K, lda, ldb, S, E);
#else
    gemm_simple<EF, Sched>(K, lda, ldb, S, E);
#endif
}

template <class EF>
__device__ __forceinline__ void skinny_gemm(LAS unsigned char* lds, const bf16_t* A, int lda, const bf16_t* Bt, int ldb, int K, int nitems, int nbr, int tag0, const EF& E, int G, int bid) {
    int tid = threadIdx.x; asm volatile("" : "+v"(tid));
    const int wid = __builtin_amdgcn_readfirstlane(tid >> 6), lane = tid & 63, fr = lane & 15, fq = lane >> 4;
    LAS f32x4* red = (LAS f32x4*)lds;
    const int kw = K / 8;
#pragma unroll 1
    for (int p = G - 1 - bid; p < nitems; p += G) {
        const int pn = p >> 3, q = p & 7;
        f32x4 tlo = {0.f, 0.f, 0.f, 0.f}, thi = {0.f, 0.f, 0.f, 0.f};
#pragma unroll 1
        for (int br = 0; br < nbr; ++br) {
            const bf16_t* ap = A + (size_t)fr * lda + br * K + wid * kw + fq * 8;
            const bf16_t* blo = Bt + (size_t)(pn * 256 + q * 16 + fr) * ldb + br * K + wid * kw + fq * 8;
            const bf16_t* bhi = blo + (size_t)128 * ldb;
            f32x4 alo = {0.f, 0.f, 0.f, 0.f}, ahi = {0.f, 0.f, 0.f, 0.f};
#pragma unroll 4
            for (int k = 0; k < kw; k += 32) { const bf16x8 a = *(const bf16x8*)(ap + k), b0 = *(const bf16x8*)(blo + k), b1 = *(const bf16x8*)(bhi + k);
                alo = __builtin_amdgcn_mfma_f32_16x16x32_bf16(b0, a, alo, 0, 0, 0); ahi = __builtin_amdgcn_mfma_f32_16x16x32_bf16(b1, a, ahi, 0, 0, 0); }
            red[(wid * 64 + lane) * 2] = alo; red[(wid * 64 + lane) * 2 + 1] = ahi;
            __syncthreads();
            if (wid == 0) {
#pragma unroll
                for (int w = 0; w < 8; ++w) { tlo += red[(w * 64 + lane) * 2]; thi += red[(w * 64 + lane) * 2 + 1]; }
                E(tag0 + br, MREAL + fr, pn, q * 16 + 4 * fq, tlo, thi);
                if (!EF::CHAIN) { tlo = (f32x4){0.f, 0.f, 0.f, 0.f}; thi = (f32x4){0.f, 0.f, 0.f, 0.f}; }
            }
            __syncthreads();
        }
    }
}

__device__ __forceinline__ int perm_col(int kind, int n) {
    if (kind == 0) {
        if (n < 1024) return n;
        if (n < 1280) { const int j = n - 1024; return j < 64 ? 1024 + j : (j < 72 ? 7232 + (j - 64) : -1); }
        if (n < PC_FQ) return 1088 + (n - 1280);
        if (n < PC_GATE) return 4160 + (n - PC_FQ);
        return 7240 + (n - PC_GATE);
    }
    if (kind == 1) {
        const int h = n / HQK, j = n - h * HQK; if (j < 128) return n; const int p = j - 128; return h * HQK + 128 + (p >> 1) + 32 * (p & 1);
    }
    if (kind == 2) {
        const int tl = n >> 8, j = n & 255; return j < 128 ? tl * 128 + j : DFF + tl * 128 + (j - 128);
    }
    return n;
}
__device__ __forceinline__ void transpose_item(const float* W, int Nsrc, bf16_t* WT, int ldd, int koff, int kind, LAS float* scr, int kb, int nb, int lane) {
    const int k0 = 64 * kb, n0 = 32 * nb; const int sc = perm_col(kind, n0 + (lane & 31));
#pragma unroll 8
    for (int i = 0; i < 32; ++i) { const int kk = 2 * i + (lane >> 5); scr[kk * 33 + (lane & 31)] = sc >= 0 ? W[(size_t)(k0 + kk) * Nsrc + sc] : 0.f; }
    LDS_WAIT(); asm volatile("" ::: "memory");
    const int c = lane & 7;
#pragma unroll
    for (int j = 0; j < 4; ++j) { const int n = (lane >> 3) + 8 * j; const LAS float* s = scr + (8 * c) * 33 + n;
        u32x4 o; o.x = cvtpk(s[0 * 33], s[1 * 33]); o.y = cvtpk(s[2 * 33], s[3 * 33]); o.z = cvtpk(s[4 * 33], s[5 * 33]); o.w = cvtpk(s[6 * 33], s[7 * 33]);
        *(u32x4*)(WT + (size_t)(n0 + n) * ldd + koff + k0 + 8 * c) = o; }
    LDS_WAIT(); asm volatile("" ::: "memory");
}
__device__ __forceinline__ void transpose_item64(const float* W, int Nsrc, bf16_t* WT, int ldd, int koff, int kind, LAS float* scr, int kb, int nb, int lane) {
    const int k0 = 64 * kb, n0 = 64 * nb, n4 = (lane & 15) * 4; const int sc = perm_col(kind, n0 + n4);
#pragma unroll 8
    for (int i = 0; i < 16; ++i) { const int kk = 4 * i + (lane >> 4);
        const f32x4 v = sc >= 0 ? *(const f32x4*)(W + (size_t)(k0 + kk) * Nsrc + sc) : (f32x4){0.f, 0.f, 0.f, 0.f};
        LAS float* d = scr + kk * 65 + n4; d[0] = v[0]; d[1] = v[1]; d[2] = v[2]; d[3] = v[3]; }
    LDS_WAIT(); asm volatile("" ::: "memory");
    const int c = lane & 7;
#pragma unroll
    for (int j = 0; j < 8; ++j) { const int n = (lane >> 3) + 8 * j; const LAS float* s = scr + (8 * c) * 65 + n;
        u32x4 o; o.x = cvtpk(s[0 * 65], s[1 * 65]); o.y = cvtpk(s[2 * 65], s[3 * 65]); o.z = cvtpk(s[4 * 65], s[5 * 65]); o.w = cvtpk(s[6 * 65], s[7 * 65]);
        *(u32x4*)(WT + (size_t)(n0 + n) * ldd + koff + k0 + 8 * c) = o; }
    LDS_WAIT(); asm volatile("" ::: "memory");
}
struct Ins { const float *x, *meta, *w_in, *b_forget, *g_q, *g_kv, *w_uq, *w_ukv, *conv_w, *w_branch, *w_out, *w_f1, *w_f2, *g_mix_pre, *g_mix_post, *g_ffn_pre, *g_ffn_post; };

__device__ __forceinline__ void sincos_d(double x, float& c, float& s) {
    const double k = __builtin_rint(x * 0.63661977236758134308);
    const double r = (x - k * 1.57079632679489655800e+00) - k * 6.12323399573676603587e-17;
    const double r2 = r * r;
    double sp = -1.0 / 1307674368000.0; sp = sp * r2 + 1.0 / 6227020800.0; sp = sp * r2 - 1.0 / 39916800.0; sp = sp * r2 + 1.0 / 362880.0; sp = sp * r2 - 1.0 / 5040.0; sp = sp * r2 + 1.0 / 120.0; sp = sp * r2 - 1.0 / 6.0; sp = sp * r2 + 1.0; sp *= r;
    double cp = 1.0 / 20922789888000.0; cp = cp * r2 - 1.0 / 87178291200.0; cp = cp * r2 + 1.0 / 479001600.0; cp = cp * r2 - 1.0 / 3628800.0; cp = cp * r2 + 1.0 / 40320.0; cp = cp * r2 - 1.0 / 720.0; cp = cp * r2 + 1.0 / 24.0; cp = cp * r2 - 0.5; cp = cp * r2 + 1.0;
    const int qd = (int)((long long)k & 3);
    const double cc = (qd == 0) ? cp : (qd == 1) ? -sp : (qd == 2) ? -cp : sp;
    const double ss = (qd == 0) ? sp : (qd == 1) ? cp : (qd == 2) ? -sp : -cp;
    c = (float)cc; s = (float)ss;
}

constexpr int IT_W1 = 32 * (N1 / 64), IT_WUQ = 8 * 48, IT_WUKV = 8 * 32, IT_WBR = 16 * 32, IT_WOUT = 32 * 32, IT_WF1 = 32 * (2 * DFF / 64), IT_WF2 = (DFF / 64) * 32;
constexpr int IT_LAYER = IT_W1 + IT_WUQ + IT_WUKV + 3 * IT_WBR + IT_WOUT + IT_WF1 + IT_WF2;

struct TItem { const float* src; bf16_t* dst; int nsrc, ldd; };
__device__ __forceinline__ TItem titem(const float* W, int Nsrc, bf16_t* WT, int ldd, int koff, int kind, int kb, int nb, int lane) {
    const int k0 = 64 * kb, n0 = 64 * nb, n4 = (lane & 15) * 4; const int sc = perm_col(kind, n0 + n4);
    TItem t; t.src = sc >= 0 ? W + (size_t)(k0 + (lane >> 4)) * Nsrc + sc : nullptr; t.dst = WT + (size_t)(n0 + (lane >> 3)) * ldd + koff + k0 + 8 * (lane & 7); t.nsrc = Nsrc; t.ldd = ldd; return t;
}
__device__ __forceinline__ TItem p0_decode(const Ins& in, unsigned char* ws, int it, int lane) {
    constexpr int ITL = IT_LAYER - IT_WUQ;
    const int l = it / ITL; int r = it - l * ITL;
    unsigned char* wl = ws + WS_W + (size_t)l * W_LAYER;
    if (r < IT_W1) { const int nbk = N1 / 64; return titem(in.w_in + (size_t)l * DM * DIN, DIN, (bf16_t*)(wl + WO_W1), DM, 0, 0, r / nbk, r % nbk, lane); } r -= IT_W1;
    if (r < IT_WUKV) return titem(in.w_ukv + (size_t)l * 512 * 2048, 2048, (bf16_t*)(wl + WO_WUKV), 512, 0, 3, r / 32, r % 32, lane); r -= IT_WUKV;
    if (r < 3 * IT_WBR) { const int br = r / IT_WBR; r -= br * IT_WBR; return titem(in.w_branch + ((size_t)l * 3 + br) * 1024 * DM, DM, (bf16_t*)(wl + WO_WBR), 3072, br * 1024, 3, r / 32, r % 32, lane); } r -= 3 * IT_WBR;
    if (r < IT_WOUT) return titem(in.w_out + (size_t)l * DM * DM, DM, (bf16_t*)(wl + WO_WOUT), DM, 0, 3, r / 32, r % 32, lane); r -= IT_WOUT;
    if (r < IT_WF1) { const int nbk = 2 * DFF / 64; return titem(in.w_f1 + (size_t)l * DM * 2 * DFF, 2 * DFF, (bf16_t*)(wl + WO_WF1), DM, 0, 2, r / nbk, r % nbk, lane); } r -= IT_WF1;
    return titem(in.w_f2 + (size_t)l * DFF * DM, DM, (bf16_t*)(wl + WO_WF2), DFF, 0, 3, r / 32, r % 32, lane);
}
__device__ __forceinline__ void titem_load(const TItem& t, f32x4 (&v)[16]) {
#pragma unroll
    for (int i = 0; i < 16; ++i) v[i] = t.src ? *(const f32x4*)(t.src + (size_t)(4 * i) * t.nsrc) : (f32x4){0.f, 0.f, 0.f, 0.f};
}
__device__ __forceinline__ void p0_weights(const Ins& in, unsigned char* ws, LAS unsigned char* lds, int gw, int NGW, int wave, int lane) {
    LAS float* scr = (LAS float*)(lds + wave * 16640);
    constexpr int NIT = DEPTH * (IT_LAYER - IT_WUQ);
    if (gw < NIT) {
        TItem cur = p0_decode(in, ws, gw, lane); f32x4 vc[16]; titem_load(cur, vc);
#pragma unroll 1
        for (int it = gw; it < NIT; it += NGW) {
            const int itn = it + NGW < NIT ? it + NGW : it;
            const TItem nxt = p0_decode(in, ws, itn, lane); f32x4 vn[16]; titem_load(nxt, vn);
            const int n4 = (lane & 15) * 4;
#pragma unroll
            for (int i = 0; i < 16; ++i) { LAS float* d = scr + (4 * i + (lane >> 4)) * 65 + n4; d[0] = vc[i][0]; d[1] = vc[i][1]; d[2] = vc[i][2]; d[3] = vc[i][3]; }
            LDS_WAIT(); asm volatile("" ::: "memory");
            const int c = lane & 7;
#pragma unroll
            for (int j = 0; j < 8; ++j) { const LAS float* s = scr + (8 * c) * 65 + (lane >> 3) + 8 * j;
                u32x4 o; o.x = cvtpk(s[0 * 65], s[1 * 65]); o.y = cvtpk(s[2 * 65], s[3 * 65]); o.z = cvtpk(s[4 * 65], s[5 * 65]); o.w = cvtpk(s[6 * 65], s[7 * 65]);
                *(u32x4*)(cur.dst + (size_t)(8 * j) * cur.ldd) = o; }
            LDS_WAIT(); asm volatile("" ::: "memory");
            cur = nxt;
#pragma unroll
            for (int i = 0; i < 16; ++i) vc[i] = vn[i];
        }
    }
#pragma unroll 1
    for (int it = gw; it < DEPTH * IT_WUQ; it += NGW) { const int l = it / IT_WUQ, r = it - l * IT_WUQ;
        transpose_item(in.w_uq + (size_t)l * 512 * 1536, 1536, (bf16_t*)(ws + WS_W + (size_t)l * W_LAYER + WO_WUQ), 512, 0, 1, scr, r / 48, r % 48, lane); }
}
__device__ __forceinline__ void p0_rope(float* rope, int gtid, int ngt) {
    for (int idx = gtid; idx < LSEQ * 32; idx += ngt) {
        const int t = idx >> 5, i = idx & 31;
        double pwd = 1.0; for (int e = 0; e < i; ++e) pwd *= 1.3335214321633240;
        const float pw = (float)pwd;
        const float inv = 1.0f / pw;
        const float ang = (float)t * inv;
        float c, s; sincos_d((double)ang, c, s);
        rope[idx * 2] = c; rope[idx * 2 + 1] = s;
    }
}

struct TRow { f32x4 m[8]; f32x4 h[8]; };
__device__ __forceinline__ void t_load(TRow& R, int mode, int r, const Ins& in, const float* H, const float* MIX, int lane) {
    if (mode == 0) {
        const float* src = r < MREAL ? in.x + (size_t)r * DM : in.meta + (size_t)(r - MREAL) * DM;
#pragma unroll
        for (int j = 0; j < 8; ++j) R.h[j] = *(const f32x4*)(src + 256 * j + 4 * lane);
    } else {
#pragma unroll
        for (int j = 0; j < 8; ++j) { R.m[j] = *(const f32x4*)(MIX + (size_t)r * DM + 256 * j + 4 * lane); R.h[j] = *(const f32x4*)(H + (size_t)r * DM + 256 * j + 4 * lane); }
    }
}
__device__ __forceinline__ void t_norm(int mode, bool last, const Ins& in, const float* H, float* Hout, const float* MIX, bf16_t* HB, float* RSTD, float* out, const float* gpost, const float* gpre, int gw, int NGW, int lane) {
    asm volatile("" : "+v"(lane));
    if (gw >= MTOK) return;
    TRow cur; t_load(cur, mode, gw, in, H, MIX, lane);
#pragma unroll 1
    for (int r = gw; r < MTOK; r += NGW) {
        TRow nxt; const int rn = r + NGW < MTOK ? r + NGW : r;
        t_load(nxt, mode, rn, in, H, MIX, lane);
        f32x4 v[8];
        if (mode == 0) {
#pragma unroll
            for (int j = 0; j < 8; ++j) v[j] = cur.h[j];
        } else {
            float ss = 0.f;
#pragma unroll
            for (int j = 0; j < 8; ++j) ss += (cur.m[j][0] * cur.m[j][0] + cur.m[j][1] * cur.m[j][1]) + (cur.m[j][2] * cur.m[j][2] + cur.m[j][3] * cur.m[j][3]);
            const float rstd = 1.0f / sqrtf(wave_sum(ss) * (1.0f / DM) + EPS);
#pragma unroll
            for (int j = 0; j < 8; ++j) { const f32x4 g = *(const f32x4*)(gpost + 256 * j + 4 * lane); v[j] = cur.h[j] + (cur.m[j] * rstd) * g; }
        }
        if (last) {
            if (r < MREAL) {
#pragma unroll
                for (int j = 0; j < 8; ++j) *(f32x4*)(out + (size_t)r * DM + 256 * j + 4 * lane) = v[j];
            }
        } else {
            float ss = 0.f;
#pragma unroll
            for (int j = 0; j < 8; ++j) { if (mode != 0) *(f32x4*)(Hout + (size_t)r * DM + 256 * j + 4 * lane) = v[j];
                const f32x4 g = *(const f32x4*)(gpre + 256 * j + 4 * lane); st_bf4(HB + (size_t)r * DM + 256 * j + 4 * lane, v[j] * g);
                ss += (v[j][0] * v[j][0] + v[j][1] * v[j][1]) + (v[j][2] * v[j][2] + v[j][3] * v[j][3]); }
            if (mode == 0) {
#pragma unroll
                for (int j = 0; j < 8; ++j) *(f32x4*)(Hout + (size_t)r * DM + 256 * j + 4 * lane) = v[j];
            }
            const float rstd = 1.0f / sqrtf(wave_sum(ss) * (1.0f / DM) + EPS);
            if (lane == 0) RSTD[r] = rstd;
        }
        cur = nxt;
    }
}

__device__ __forceinline__ void t1_phase(int l, const Ins& in, const bf16_t* PROJ, const float* MISC, bf16_t* CQN, bf16_t* CKVN, bf16_t* KA, bf16_t* OCAT, float* CB, const float* rope, LAS float* scr, int gw, int NGW, int lane) {
    asm volatile("" : "+v"(lane));
    if (gw < 32) {
        const int b = gw >> 3, h = gw & 7; const float bias = in.b_forget[l * NH + h];
        {
            float x[33];
#pragma unroll
            for (int c = 0; c < 33; ++c) { const int t = c * 64 + lane; x[c] = t < LSEQ ? MISC[(size_t)row_of(b, t) * 128 + 64 + h] + bias : 0.f; }
#pragma unroll
            for (int c = 0; c < 33; ++c) scr[c * 64 + lane] = x[c];
        }
        LDS_WAIT(); asm volatile("" ::: "memory");
        float carry = 0.f;
#pragma unroll 1
        for (int c = 0; c < 33; ++c) { const int t = c * 64 + lane; const float xv = scr[c * 64 + lane];
            float lf = fminf(xv, 0.f) - log1pf(expf(-fabsf(xv))); if (t >= LSEQ) lf = 0.f;
#pragma unroll
            for (int o = 1; o < 64; o <<= 1) { const float y = __shfl_up(lf, o); if (lane >= o) lf += y; }
            lf += carry; carry = __shfl(lf, 63);
            if (t < LSEQ) CB[gw * CBLD + t] = lf; }
    }
    const float* gq = in.g_q + l * 512; const float* gkv = in.g_kv + l * 512; const float* cw = in.conv_w + (size_t)l * 3 * 1024;
#pragma unroll 1
    for (int r = gw; r < MTOK; r += NGW) {
        {
            const int half = lane >> 5, c0 = (lane & 31) * 16;
            const bf16_t* src = PROJ + (size_t)r * N1 + half * 512 + c0;
            const u32x4 a = *(const u32x4*)src, b = *(const u32x4*)(src + 8);
            float v[16] = {bflo(a.x), bfhi(a.x), bflo(a.y), bfhi(a.y), bflo(a.z), bfhi(a.z), bflo(a.w), bfhi(a.w), bflo(b.x), bfhi(b.x), bflo(b.y), bfhi(b.y), bflo(b.z), bfhi(b.z), bflo(b.w), bfhi(b.w)};
            float ss = 0.f;
#pragma unroll
            for (int e = 0; e < 16; ++e) ss += v[e] * v[e];
#pragma unroll
            for (int o = 1; o < 32; o <<= 1) ss += __shfl_xor(ss, o);
            const float rstd = 1.0f / sqrtf(ss * (1.0f / 512.0f) + EPS);
            const float* g = (half ? gkv : gq) + c0;
            u32x4 o0, o1;
            o0.x = cvtpk(v[0] * rstd * g[0], v[1] * rstd * g[1]); o0.y = cvtpk(v[2] * rstd * g[2], v[3] * rstd * g[3]); o0.z = cvtpk(v[4] * rstd * g[4], v[5] * rstd * g[5]); o0.w = cvtpk(v[6] * rstd * g[6], v[7] * rstd * g[7]);
            o1.x = cvtpk(v[8] * rstd * g[8], v[9] * rstd * g[9]); o1.y = cvtpk(v[10] * rstd * g[10], v[11] * rstd * g[11]); o1.z = cvtpk(v[12] * rstd * g[12], v[13] * rstd * g[13]); o1.w = cvtpk(v[14] * rstd * g[14], v[15] * rstd * g[15]);
            bf16_t* dst = (half ? CKVN : CQN) + (size_t)r * 512 + c0;
            *(u32x4*)dst = o0; *(u32x4*)(dst + 8) = o1;
        }
        const int t = t_of(r), b = r < MREAL ? (r >> 11) : 0;
        if (lane < 32) {
            const float x1 = MISC[(size_t)r * 128 + lane], x2 = MISC[(size_t)r * 128 + 32 + lane];
            const f32x2 cs = *(const f32x2*)(rope + ((size_t)t * 32 + lane) * 2);
            const unsigned w = cvtpk(x1 * cs[0] - x2 * cs[1], x1 * cs[1] + x2 * cs[0]);
#pragma unroll
            for (int h = 0; h < NH; ++h) *(unsigned*)(KA + (size_t)r * 1536 + h * HQK + 128 + 2 * lane) = w;
        }
        {
            const int c0 = lane * 16; float acc[16];
#pragma unroll
            for (int e = 0; e < 16; ++e) acc[e] = 0.f;
#pragma unroll
            for (int kk = 0; kk < 3; ++kk) {
                const int tt = t - 2 + kk; if (tt < 0) continue;
                const size_t rr = (size_t)row_of(b, tt);
                const u32x4 c0v = *(const u32x4*)(PROJ + rr * N1 + PC_CONVC + c0), c1v = *(const u32x4*)(PROJ + rr * N1 + PC_CONVC + c0 + 8);
                const u32x4 x0v = *(const u32x4*)(PROJ + rr * N1 + PC_CONVX + c0), x1v = *(const u32x4*)(PROJ + rr * N1 + PC_CONVX + c0 + 8);
                const float* w = cw + kk * 1024 + c0;
                const unsigned cc[8] = {c0v.x, c0v.y, c0v.z, c0v.w, c1v.x, c1v.y, c1v.z, c1v.w}; const unsigned xx[8] = {x0v.x, x0v.y, x0v.z, x0v.w, x1v.x, x1v.y, x1v.z, x1v.w};
#pragma unroll
                for (int e = 0; e < 8; ++e) { acc[2 * e] += w[2 * e] * (bflo(cc[e]) * bflo(xx[e])); acc[2 * e + 1] += w[2 * e + 1] * (bfhi(cc[e]) * bfhi(xx[e])); }
            }
            const u32x4 b0v = *(const u32x4*)(PROJ + (size_t)r * N1 + PC_CONVB + c0), b1v = *(const u32x4*)(PROJ + (size_t)r * N1 + PC_CONVB + c0 + 8);
            const unsigned bb[8] = {b0v.x, b0v.y, b0v.z, b0v.w, b1v.x, b1v.y, b1v.z, b1v.w};
            unsigned o[8];
#pragma unroll
            for (int e = 0; e < 8; ++e) o[e] = cvtpk(bflo(bb[e]) * acc[2 * e], bfhi(bb[e]) * acc[2 * e + 1]);
            bf16_t* dst = OCAT + (size_t)r * 3072 + 1024 + c0;
            *(u32x4*)dst = (u32x4){o[0], o[1], o[2], o[3]}; *(u32x4*)(dst + 8) = (u32x4){o[4], o[5], o[6], o[7]};
        }
    }
}

__device__ __forceinline__ void attn_naive(LAS unsigned char* lds, const bf16_t* PROJ, const bf16_t* QA, const bf16_t* KA, const bf16_t* VA, const float* CB, bf16_t* OCAT, int tmax, int nb, int gw, int NGW, int wave, int lane) {
    asm volatile("" : "+v"(lane));
    LAS float* sc = (LAS float*)lds + wave * 2304; LAS float* qs = sc + 2112;
#pragma unroll 1
    for (int it = gw; it < 2 * nb * NH * tmax; it += NGW) {
        const int t = it % tmax; const int r_ = it / tmax; const int h = r_ & 7, b = (r_ >> 3) % nb, ty = (r_ >> 3) / nb;
        const int row = row_of(b, t); const int dk = ty ? 128 : HQK;
        const bf16_t* qp = ty ? PROJ + (size_t)row * N1 + PC_FQ + h * 128 : QA + (size_t)row * 1536 + h * HQK;
        const bf16_t* kbase = ty ? PROJ + PC_FK + h * 128 : KA + h * HQK; const int ldk = ty ? N1 : 1536;
        const bf16_t* vbase = ty ? PROJ + PC_FV + h * 128 : VA + h * 128; const int ldv = ty ? N1 : 1024;
        const float scale = ty ? 0.08838834764831845f : 0.07216878364870323f;
        const float* cb = CB + (b * NH + h) * CBLD;
        for (int d = lane; d < dk; d += 64) qs[d] = bf2f(qp[d]);
        LDS_WAIT(); asm volatile("" ::: "memory");
        const float ct = ty ? cb[t] : 0.f;
        float mx = -1e30f;
#pragma unroll 1
        for (int s = lane; s <= t; s += 64) {
            const bf16_t* kp = kbase + (size_t)row_of(b, s) * ldk; float dot = 0.f;
#pragma unroll 4
            for (int d8 = 0; d8 < dk; d8 += 8) { const u32x4 kv = *(const u32x4*)(kp + d8);
                dot += qs[d8] * bflo(kv.x) + qs[d8 + 1] * bfhi(kv.x) + qs[d8 + 2] * bflo(kv.y) + qs[d8 + 3] * bfhi(kv.y) + qs[d8 + 4] * bflo(kv.z) + qs[d8 + 5] * bfhi(kv.z) + qs[d8 + 6] * bflo(kv.w) + qs[d8 + 7] * bfhi(kv.w); }
            float v = dot * scale; if (ty) v += ct - cb[s];
            sc[s] = v; mx = fmaxf(mx, v);
        }
        mx = wave_max(mx);
        float sum = 0.f;
        for (int s = lane; s <= t; s += 64) { const float p = __expf(sc[s] - mx); sc[s] = p; sum += p; }
        sum = wave_sum(sum);
        LDS_WAIT(); asm volatile("" ::: "memory");
        float a0 = 0.f, a1 = 0.f;
#pragma unroll 4
        for (int s = 0; s <= t; ++s) { const float p = sc[s]; const unsigned w = *(const unsigned*)(vbase + (size_t)row_of(b, s) * ldv + 2 * lane); a0 += p * bflo(w); a1 += p * bfhi(w); }
        const float inv = 1.0f / sum;
        *(unsigned*)(OCAT + (size_t)row * 3072 + (ty ? 2048 : 0) + h * 128 + 2 * lane) = cvtpk(a0 * inv, a1 * inv);
        LDS_WAIT(); asm volatile("" ::: "memory");
    }
}

namespace fa {
constexpr int NW = 8, QBLK = 32, KVBLK = 64, QB = NW * QBLK, DV = 128;
constexpr int SHM_V = KVBLK * DV * 2;
typedef short s16x4 __attribute__((ext_vector_type(4)));
typedef float f32x16 __attribute__((ext_vector_type(16)));
#define FA_SBAR() __builtin_amdgcn_sched_barrier(0)
__device__ __forceinline__ int v_st(int k, int c) { const int kk = (k & ~0xC) | ((k & 4) << 1) | ((k & 8) >> 1); return ((kk >> 3) * 4 + (c >> 5)) * 512 + ((kk & 7) * 32 + (c & 31)) * 2; }
__device__ __forceinline__ int v_rd_base(int lane) { return ((lane & 3) << 3) | (((lane >> 2) & 3) << 6) | (((lane >> 4) & 1) << 5) | (((lane >> 5) & 1) << 8); }
constexpr int v_rd_off(int d0, int ks, int half) { return d0 * 512 + ks * 4096 + half * 2048; }
__device__ __forceinline__ int crow(int r, int hi) { return (r & 3) + 8 * (r >> 2) + 4 * hi; }
__device__ __forceinline__ unsigned cvtpk_a(float lo, float hi) { unsigned r; asm volatile("v_cvt_pk_bf16_f32 %0, %1, %2" : "=v"(r) : "v"(lo), "v"(hi)); return r; }
__device__ __forceinline__ void mask_tile(f32x16& p0, f32x16& p1, int dq) {
    const float NEG = -__builtin_inff();
#pragma unroll
    for (int r = 0; r < 16; ++r) { const int c = (r & 3) + 8 * (r >> 2); if (dq - c < 0) p0[r] = NEG; if (dq - c - 32 < 0) p1[r] = NEG; }
}
__device__ __forceinline__ void mask_meta(f32x16& p0, f32x16& p1) {
    const float NEG = -__builtin_inff();
#pragma unroll
    for (int r = 8; r < 16; ++r) p0[r] = NEG;
#pragma unroll
    for (int r = 0; r < 16; ++r) p1[r] = NEG;
}
__device__ __forceinline__ void partialSM(f32x16& p0, f32x16& p1, float& m_reg, float& mn, float& alpha, const float SCALE) {
    float pmax = p0[0];
#pragma unroll
    for (int r = 1; r < 16; ++r) pmax = fmaxf(pmax, p0[r]);
#pragma unroll
    for (int r = 0; r < 16; ++r) pmax = fmaxf(pmax, p1[r]);
    { auto rr = __builtin_amdgcn_permlane32_swap(__float_as_uint(pmax), __float_as_uint(pmax), false, false); pmax = fmaxf(__uint_as_float(rr[0]), __uint_as_float(rr[1])); }
    const float C2 = 1.4426950408889634f * SCALE;
    if (__builtin_expect(__all((pmax - m_reg) * SCALE <= 8.f), 1)) { mn = m_reg; alpha = 1.f; }
    else { mn = fmaxf(m_reg, pmax); alpha = __builtin_amdgcn_exp2f((m_reg - mn) * C2); m_reg = mn; }
    const float mnL = -mn * C2;
#pragma unroll
    for (int r = 0; r < 16; ++r) p0[r] = fmaf(p0[r], C2, mnL);
#pragma unroll
    for (int r = 0; r < 16; ++r) p1[r] = fmaf(p1[r], C2, mnL);
#pragma unroll
    for (int r = 0; r < 16; ++r) p0[r] = __builtin_amdgcn_exp2f(p0[r]);
}
__device__ __forceinline__ void finishSM(f32x16& p0, f32x16& p1, float alpha, float& l_reg, bf16x8& pa0, bf16x8& pa1, bf16x8& pa2, bf16x8& pa3) {
#pragma unroll
    for (int r = 0; r < 16; ++r) p1[r] = __builtin_amdgcn_exp2f(p1[r]);
    float ps = 0;
#pragma unroll
    for (int r = 0; r < 16; ++r) ps += p0[r];
#pragma unroll
    for (int r = 0; r < 16; ++r) ps += p1[r];
    { auto rr = __builtin_amdgcn_permlane32_swap(__float_as_uint(ps), __float_as_uint(ps), false, false); ps = __uint_as_float(rr[0]) + __uint_as_float(rr[1]); }
    l_reg = l_reg * alpha + ps;
#define FA_PK4(P, B_, OUT) do { unsigned a0 = cvtpk_a(P[B_+0], P[B_+1]), a1 = cvtpk_a(P[B_+2], P[B_+3]); unsigned b0 = cvtpk_a(P[B_+4], P[B_+5]), b1 = cvtpk_a(P[B_+6], P[B_+7]); \
        auto r0 = __builtin_amdgcn_permlane32_swap(a0, b0, false, false); auto r1 = __builtin_amdgcn_permlane32_swap(a1, b1, false, false); \
        u32x4 w = {r0[0], r1[0], r0[1], r1[1]}; OUT = *reinterpret_cast<bf16x8*>(&w); } while (0)
    FA_PK4(p0, 0, pa0); FA_PK4(p0, 8, pa1); FA_PK4(p1, 0, pa2); FA_PK4(p1, 8, pa3);
#undef FA_PK4
}
template <int DK> __device__ __forceinline__ int kswz(int row, int colB) { return row * (2 * DK) + (colB ^ ((row & 7) << 4)); }
template <int DK, int KB, bool BIAS>
__device__ __forceinline__ void qkt(f32x16& p0, f32x16& p1, const char* K_lds, const float* bias_lds, int r32, int hi, const bf16x8* qr) {
    constexpr int SHM_K = KVBLK * DK * 2;
    if constexpr (BIAS) {
        const float* bp = bias_lds + KB * 64 + 4 * hi;
#pragma unroll
        for (int g = 0; g < 4; ++g) { const f32x4 a = *(const f32x4*)(bp + 8 * g), b = *(const f32x4*)(bp + 32 + 8 * g);
            p0[4 * g] = a[0]; p0[4 * g + 1] = a[1]; p0[4 * g + 2] = a[2]; p0[4 * g + 3] = a[3]; p1[4 * g] = b[0]; p1[4 * g + 1] = b[1]; p1[4 * g + 2] = b[2]; p1[4 * g + 3] = b[3]; }
    } else { p0 = f32x16{}; p1 = f32x16{}; }
    const char* kb[4];
#pragma unroll
    for (int dd = 0; dd < 4; ++dd) kb[dd] = K_lds + KB * SHM_K + kswz<DK>(r32, (dd * 16 + hi * 8) * 2);
#pragma unroll
    for (int d0 = 0; d0 < DK / 16; ++d0) { const char* a = kb[d0 & 3] + (d0 >> 2) * 128;
        bf16x8 b0 = *reinterpret_cast<const bf16x8*>(a);
        bf16x8 b1 = *reinterpret_cast<const bf16x8*>(a + 32 * 2 * DK);
        p0 = __builtin_amdgcn_mfma_f32_32x32x16_bf16(b0, qr[d0], p0, 0, 0, 0);
        p1 = __builtin_amdgcn_mfma_f32_32x32x16_bf16(b1, qr[d0], p1, 0, 0, 0); }
}
template <int VB>
__device__ __forceinline__ void pv_tile(f32x16* o, int vb0, bf16x8 pa0, bf16x8 pa1, bf16x8 pa2, bf16x8 pa3) {
#define FA_TRRD(dst, off) asm volatile("ds_read_b64_tr_b16 %0, %1 offset:%2" : "=&v"(dst) : "v"(vb0), "i"(off) : "memory")
#define FA_PV_D0(d0) do { s16x4 l0, l1, l2, l3, h0, h1, h2, h3; constexpr int b_ = VB * SHM_V + v_rd_off(d0, 0, 0); \
        FA_TRRD(l0, b_); FA_TRRD(h0, b_ + 2048); FA_TRRD(l1, b_ + 4096); FA_TRRD(h1, b_ + 6144); FA_TRRD(l2, b_ + 8192); FA_TRRD(h2, b_ + 10240); FA_TRRD(l3, b_ + 12288); FA_TRRD(h3, b_ + 14336); \
        asm volatile("s_waitcnt lgkmcnt(0)" ::: "memory"); FA_SBAR(); \
        o[d0] = __builtin_amdgcn_mfma_f32_32x32x16_bf16(pa0, (bf16x8){l0[0], l0[1], l0[2], l0[3], h0[0], h0[1], h0[2], h0[3]}, o[d0], 0, 0, 0); \
        o[d0] = __builtin_amdgcn_mfma_f32_32x32x16_bf16(pa1, (bf16x8){l1[0], l1[1], l1[2], l1[3], h1[0], h1[1], h1[2], h1[3]}, o[d0], 0, 0, 0); \
        o[d0] = __builtin_amdgcn_mfma_f32_32x32x16_bf16(pa2, (bf16x8){l2[0], l2[1], l2[2], l2[3], h2[0], h2[1], h2[2], h2[3]}, o[d0], 0, 0, 0); \
        o[d0] = __builtin_amdgcn_mfma_f32_32x32x16_bf16(pa3, (bf16x8){l3[0], l3[1], l3[2], l3[3], h3[0], h3[1], h3[2], h3[3]}, o[d0], 0, 0, 0); } while (0)
    FA_PV_D0(0); FA_PV_D0(1); FA_PV_D0(2); FA_PV_D0(3);
#undef FA_PV_D0
#undef FA_TRRD
}
struct Blk { const bf16_t* Q; const bf16_t* Kr; const bf16_t* Km; const bf16_t* Vr; const bf16_t* Vm; const float* cbr; const float* cbm; bf16_t* O; int P0; };
template <int DK> struct Seam { bf16x8 qr[DK / 16]; bf16x8 st_v0, st_v1; bf16x8 st_k[DK / 64]; float st_b; };
template <int DK> constexpr int lds_bytes() { return 2 * SHM_V + 2 * KVBLK * DK * 2 + NW * 64 * 4 + 2 * 64 * 4; }

#define FA_VMW() asm volatile("s_waitcnt vmcnt(0)" ::: "memory")
template <int DK, bool BIAS>
__device__ __forceinline__ void fa_load_tile(const Blk& B, int kb, int ldk, int ldv, int tid, Seam<DK>& S, const float BSC) {
    const bf16_t* Kp = kb == 0 ? B.Km : B.Kr; const bf16_t* Vp = kb == 0 ? B.Vm : B.Vr;
    const int sr = tid >> 4, sc = (tid & 15) * 8;
    S.st_v0 = *(const bf16x8*)(Vp + (size_t)(kb + sr) * ldv + sc); S.st_v1 = *(const bf16x8*)(Vp + (size_t)(kb + 32 + sr) * ldv + sc);
#pragma unroll
    for (int j = 0; j < DK / 64; ++j) { const int ci = tid + 512 * j, row = ci / (DK / 8), cc = ci % (DK / 8); S.st_k[j] = *(const bf16x8*)(Kp + (size_t)(kb + row) * ldk + cc * 8); }
    if constexpr (BIAS) { const float* cp = kb == 0 ? B.cbm : B.cbr; S.st_b = cp[kb + (tid & 63)] * BSC; }
}
template <int DK, bool BIAS>
__device__ __forceinline__ void fa_write_k(char* K_lds, float* bias_lds, int bf, int tid, const Seam<DK>& S) {
    constexpr int SHM_K = KVBLK * DK * 2;
#pragma unroll
    for (int j = 0; j < DK / 64; ++j) { const int ci = tid + 512 * j, row = ci / (DK / 8), cc = ci % (DK / 8); *(bf16x8*)(K_lds + bf * SHM_K + kswz<DK>(row, cc * 16)) = S.st_k[j]; }
    if constexpr (BIAS) { if (tid < 64) bias_lds[bf * 64 + tid] = S.st_b; }
}
template <int DK>
__device__ __forceinline__ void fa_write_v(char* V_lds, int bf, int tid, const Seam<DK>& S) {
    const int sr = tid >> 4, sc = (tid & 15) * 8;
    *(bf16x8*)(V_lds + bf * SHM_V + v_st(sr, sc)) = S.st_v0; *(bf16x8*)(V_lds + bf * SHM_V + v_st(32 + sr, sc)) = S.st_v1;
}
template <int DK, bool BIAS>
__device__ __forceinline__ void fa_prime(const int tid, const Blk& cur, int ldq, int ldk, int ldv, char* lds, Seam<DK>& S, const float BSC) {
    const int wid = __builtin_amdgcn_readfirstlane(tid >> 6), lane = tid & 63, r32 = lane & 31, hi = lane >> 5;
    constexpr int SHM_K = KVBLK * DK * 2;
    char* K_lds = lds + 2 * SHM_V; float* bias_lds = (float*)(lds + 2 * SHM_V + 2 * SHM_K + NW * 64 * 4);
#pragma unroll
    for (int d0 = 0; d0 < DK / 16; ++d0) S.qr[d0] = *(const bf16x8*)(cur.Q + (size_t)(wid * QBLK + r32) * ldq + d0 * 16 + hi * 8);
    fa_load_tile<DK, BIAS>(cur, 0, ldk, ldv, tid, S, BSC); FA_VMW(); fa_write_k<DK, BIAS>(K_lds, bias_lds, 0, tid, S);
    __syncthreads();
}
template <int DK, bool BIAS>
__device__ __forceinline__ void fa_block(const int tid, const Blk& cur, const Blk& nxt, int ldq, int ldk, int ldv, int ldo, char* lds, Seam<DK>& S, const float SCALE, const float BSC) {
    const int wid = __builtin_amdgcn_readfirstlane(tid >> 6), lane = tid & 63, r32 = lane & 31, hi = lane >> 5;
    constexpr int SHM_K = KVBLK * DK * 2;
    const int NT = (cur.P0 + QB - 1) / KVBLK + 1;
    const int qlo = cur.P0 + wid * QBLK, qm = qlo + r32 - 4 * hi;
    char* V_lds = lds; char* K_lds = lds + 2 * SHM_V;
    float* ws = (float*)(lds + 2 * SHM_V + 2 * SHM_K) + wid * 64; float* li_l = ws; float* al_l = ws + 32;
    float* bias_lds = (float*)(lds + 2 * SHM_V + 2 * SHM_K + NW * 64 * 4);
    float m_reg = -1e30f, l_reg = 0; f32x16 o[4] = {};
    const int vb0 = (int)(uintptr_t)V_lds + v_rd_base(lane);
#define FA_RESC(a) do { if (__any((a) < 1.f)) { if (hi == 0) al_l[r32] = (a); asm volatile("s_waitcnt lgkmcnt(0)" ::: "memory"); \
                     _Pragma("unroll") for (int d_ = 0; d_ < 4; ++d_) _Pragma("unroll") for (int r = 0; r < 16; ++r) o[d_][r] *= al_l[crow(r, hi)]; } } while (0)
#define FA_KBASE(t) ((t) * KVBLK)
#define FA_MASKT(P0_, P1_, t) do { const int kb_ = FA_KBASE(t); if (kb_ == 0) mask_meta(P0_, P1_); else if (kb_ + KVBLK - 1 > qlo) mask_tile(P0_, P1_, qm - kb_); } while (0)
    f32x16 pA0, pA1, pB0, pB1; float mnA, mnB, alA, alB; bf16x8 pa0, pa1, pa2, pa3;
    fa_write_v<DK>(V_lds, 0, tid, S); FA_SBAR();
    if (NT > 1) fa_load_tile<DK, BIAS>(cur, FA_KBASE(1), ldk, ldv, tid, S, BSC);
    FA_SBAR(); qkt<DK, 0, BIAS>(pA0, pA1, K_lds, bias_lds, r32, hi, S.qr);
    FA_MASKT(pA0, pA1, 0); partialSM(pA0, pA1, m_reg, mnA, alA, SCALE);
    if (NT > 1) { FA_VMW(); fa_write_v<DK>(V_lds, 1, tid, S); fa_write_k<DK, BIAS>(K_lds, bias_lds, 1, tid, S); }
    __syncthreads();
#define FA_HALF_STEP(PX0, PX1, mnX, alX, PY0, PY1, alY, t, KB, VB, SB) do { \
        FA_SBAR(); qkt<DK, KB, BIAS>(PX0, PX1, K_lds, bias_lds, r32, hi, S.qr); \
        finishSM(PY0, PY1, alY, l_reg, pa0, pa1, pa2, pa3); FA_SBAR(); \
        if ((t) + 1 < NT) { fa_load_tile<DK, BIAS>(cur, FA_KBASE((t) + 1), ldk, ldv, tid, S, BSC); FA_SBAR(); } \
        pv_tile<VB>(o, vb0, pa0, pa1, pa2, pa3); FA_MASKT(PX0, PX1, (t)); partialSM(PX0, PX1, m_reg, mnX, alX, SCALE); \
        __syncthreads(); \
        if ((t) + 1 < NT) { FA_VMW(); fa_write_v<DK>(V_lds, SB, tid, S); fa_write_k<DK, BIAS>(K_lds, bias_lds, SB, tid, S); } \
        FA_RESC(alX); __syncthreads(); } while (0)
    for (int t = 1; t + 1 < NT; t += 2) {
        FA_HALF_STEP(pB0, pB1, mnB, alB, pA0, pA1, alA, t, 1, 0, 0);
        FA_HALF_STEP(pA0, pA1, mnA, alA, pB0, pB1, alB, t + 1, 0, 1, 1);
    }
    const bool even = (NT & 1) == 0;
    if (even) { FA_SBAR(); qkt<DK, 1, BIAS>(pB0, pB1, K_lds, bias_lds, r32, hi, S.qr); FA_SBAR(); }
    fa_load_tile<DK, BIAS>(nxt, 0, ldk, ldv, tid, S, BSC); FA_SBAR();
#pragma unroll
    for (int d0 = 0; d0 < DK / 16; ++d0) S.qr[d0] = *(const bf16x8*)(nxt.Q + (size_t)(wid * QBLK + r32) * ldq + d0 * 16 + hi * 8);
    FA_SBAR();
    finishSM(pA0, pA1, alA, l_reg, pa0, pa1, pa2, pa3); FA_SBAR();
    pv_tile<0>(o, vb0, pa0, pa1, pa2, pa3);
    if (even) { FA_MASKT(pB0, pB1, NT - 1); partialSM(pB0, pB1, m_reg, mnB, alB, SCALE); __syncthreads(); FA_RESC(alB);
        finishSM(pB0, pB1, alB, l_reg, pa0, pa1, pa2, pa3); FA_SBAR(); pv_tile<1>(o, vb0, pa0, pa1, pa2, pa3); }
    FA_SBAR();
    asm volatile("s_waitcnt vmcnt(%0)" :: "i"(DK / 16) : "memory");
    fa_write_k<DK, BIAS>(K_lds, bias_lds, 0, tid, S); FA_SBAR();
    if (hi == 0) li_l[r32] = l_reg; asm volatile("s_waitcnt lgkmcnt(0)" ::: "memory");
    float rli[16];
#pragma unroll
    for (int r = 0; r < 16; ++r) rli[r] = __builtin_amdgcn_rcpf(li_l[crow(r, hi)]);
    bf16_t* Ow = cur.O + (size_t)(wid * QBLK) * ldo;
#pragma unroll
    for (int r = 0; r < 16; ++r) { const int orow = crow(r, hi);
#pragma unroll
        for (int d0 = 0; d0 < 4; ++d0) { const float v = o[d0][r] * rli[r]; const float vn = __shfl_xor(v, 1);
            if ((r32 & 1) == 0) *(unsigned*)(Ow + (size_t)orow * ldo + d0 * 32 + r32) = cvtpk_a(v, vn); } }
    __syncthreads();
#undef FA_RESC
#undef FA_KBASE
#undef FA_MASKT
#undef FA_HALF_STEP
}
template <int DK, bool BIAS>
__device__ __forceinline__ void fa_block_sb(const int tid, const Blk& cur, int ldk, int ldv, int ldo, char* lds, Seam<DK>& S, const float SCALE, const float BSC) {
    const int wid = __builtin_amdgcn_readfirstlane(tid >> 6), lane = tid & 63, r32 = lane & 31, hi = lane >> 5;
    constexpr int SHM_K = KVBLK * DK * 2;
    const int NT = (cur.P0 + QB - 1) / KVBLK + 1;
    const int qlo = cur.P0 + wid * QBLK, qm = qlo + r32 - 4 * hi;
    char* V_lds = lds; char* K_lds = lds + 2 * SHM_V;
    float* ws = (float*)(lds + 2 * SHM_V + 2 * SHM_K) + wid * 64; float* li_l = ws; float* al_l = ws + 32;
    float* bias_lds = (float*)(lds + 2 * SHM_V + 2 * SHM_K + NW * 64 * 4);
    float m_reg = -1e30f, l_reg = 0; f32x16 o[4] = {};
    const int vb0 = (int)(uintptr_t)V_lds + v_rd_base(lane);
    fa_write_v<DK>(V_lds, 0, tid, S);
    __syncthreads();
#define FA_STEP(t, KB) do { f32x16 p0, p1; float mn, al; bf16x8 pa0, pa1, pa2, pa3; \
        if ((t) + 1 < NT) { fa_load_tile<DK, BIAS>(cur, ((t) + 1) * KVBLK, ldk, ldv, tid, S, BSC); FA_SBAR(); } \
        qkt<DK, KB, BIAS>(p0, p1, K_lds, bias_lds, r32, hi, S.qr); \
        { const int kb_ = (t) * KVBLK; if (kb_ == 0) mask_meta(p0, p1); else if (kb_ + KVBLK - 1 > qlo) mask_tile(p0, p1, qm - kb_); } \
        partialSM(p0, p1, m_reg, mn, al, SCALE); \
        if (__any(al < 1.f)) { if (hi == 0) al_l[r32] = al; asm volatile("s_waitcnt lgkmcnt(0)" ::: "memory"); \
            _Pragma("unroll") for (int d_ = 0; d_ < 4; ++d_) _Pragma("unroll") for (int r = 0; r < 16; ++r) o[d_][r] *= al_l[crow(r, hi)]; } \
        finishSM(p0, p1, al, l_reg, pa0, pa1, pa2, pa3); FA_SBAR(); \
        pv_tile<KB>(o, vb0, pa0, pa1, pa2, pa3); \
        if ((t) + 1 < NT) { FA_VMW(); fa_write_v<DK>(V_lds, 1 - KB, tid, S); fa_write_k<DK, BIAS>(K_lds, bias_lds, 1 - KB, tid, S); } \
        __syncthreads(); } while (0)
    int t = 0;
    for (; t + 1 < NT; t += 2) { FA_STEP(t, 0); FA_STEP(t + 1, 1); }
    if (t < NT) FA_STEP(t, 0);
#undef FA_STEP
    if (hi == 0) li_l[r32] = l_reg; asm volatile("s_waitcnt lgkmcnt(0)" ::: "memory");
    float rli[16];
#pragma unroll
    for (int r = 0; r < 16; ++r) rli[r] = __builtin_amdgcn_rcpf(li_l[crow(r, hi)]);
    bf16_t* Ow = cur.O + (size_t)(wid * QBLK) * ldo;
#pragma unroll
    for (int r = 0; r < 16; ++r) { const int orow = crow(r, hi);
#pragma unroll
        for (int d0 = 0; d0 < 4; ++d0) { const float v = o[d0][r] * rli[r]; const float vn = __shfl_xor(v, 1);
            if ((r32 & 1) == 0) *(unsigned*)(Ow + (size_t)orow * ldo + d0 * 32 + r32) = cvtpk_a(v, vn); } }
    __syncthreads();
}
}

__device__ __forceinline__ void attn_fast(char* lds, const bf16_t* PROJ, const bf16_t* QA, const bf16_t* KA, const bf16_t* VA, const float* CB, bf16_t* OCAT, int vcu, int G) {
    for (int v = vcu; v < NBATCH * NH * 8; v += G) {
        const int bh = v >> 3, qb = v & 7, b = bh >> 3, h = bh & 7;
#ifndef FA_ONLY
#define FA_ONLY 3
#endif
        if (FA_ONLY & 1) {
            fa::Blk B; const size_t r0 = (size_t)b * SEQ + qb * 256, rm = (size_t)MREAL;
            B.Q = QA + r0 * 1536 + h * HQK; B.Kr = KA + ((size_t)b * SEQ) * 1536 + h * HQK - (size_t)64 * 1536; B.Km = KA + rm * 1536 + h * HQK;
            B.Vr = VA + ((size_t)b * SEQ) * 1024 + h * 128 - (size_t)64 * 1024; B.Vm = VA + rm * 1024 + h * 128; B.cbr = nullptr; B.cbm = nullptr;
            B.O = OCAT + r0 * 3072 + h * 128; B.P0 = 64 + qb * 256;
            int tl = threadIdx.x; asm volatile("" : "+v"(tl));
            fa::Seam<192> S; fa::fa_prime<192, false>(tl, B, 1536, 1536, 1024, lds, S, 0.f);
            fa::fa_block_sb<192, false>(tl, B, 1536, 1024, 3072, lds, S, 0.07216878364870323f, 0.f);
        }
        if (FA_ONLY & 2) {
            const int qf = 7 - qb; fa::Blk B; const size_t r0 = (size_t)b * SEQ + qf * 256, rm = (size_t)MREAL;
            B.Q = PROJ + r0 * N1 + PC_FQ + h * 128; B.Kr = PROJ + ((size_t)b * SEQ) * N1 + PC_FK + h * 128 - (size_t)64 * N1; B.Km = PROJ + rm * N1 + PC_FK + h * 128;
            B.Vr = PROJ + ((size_t)b * SEQ) * N1 + PC_FV + h * 128 - (size_t)64 * N1; B.Vm = PROJ + rm * N1 + PC_FV + h * 128;
            B.cbm = CB + bh * CBLD; B.cbr = CB + bh * CBLD - 48;
            B.O = OCAT + r0 * 3072 + 2048 + h * 128; B.P0 = 64 + qf * 256;
            int tl = threadIdx.x; asm volatile("" : "+v"(tl));
            fa::Seam<128> S; fa::fa_prime<128, true>(tl, B, N1, N1, N1, lds, S, -11.313708498984761f);
            fa::fa_block<128, true>(tl, B, B, N1, N1, N1, 3072, lds, S, 0.08838834764831845f, -11.313708498984761f);
        }
    }
}

struct Args { const float* in[17]; float* out; unsigned char* ws; int ph_lo, ph_hi; };
__global__ void __launch_bounds__(NTHREADS, 2) fwd(Args args) {
    extern __shared__ __attribute__((aligned(16))) unsigned char lds_raw[];
    LAS unsigned char* lds = (LAS unsigned char*)lds_raw;
    volatile LAS unsigned* MISCW = (volatile LAS unsigned*)(lds + MISC_OFF);
    const int tid = threadIdx.x, lane = tid & 63, wave = __builtin_amdgcn_readfirstlane(tid >> 6);
    const int G = gridDim.x, bid = blockIdx.x;
    const int gw = bid * NWAVES + wave, NGW = G * NWAVES;
    const int vcu = (G % 8 == 0) ? (bid % 8) * (G / 8) + bid / 8 : bid;
    unsigned char* ws = args.ws;
    Ins in; in.x = args.in[0]; in.meta = args.in[1]; in.w_in = args.in[2]; in.b_forget = args.in[3]; in.g_q = args.in[4]; in.g_kv = args.in[5]; in.w_uq = args.in[6]; in.w_ukv = args.in[7];
    in.conv_w = args.in[8]; in.w_branch = args.in[9]; in.w_out = args.in[10]; in.w_f1 = args.in[11]; in.w_f2 = args.in[12]; in.g_mix_pre = args.in[13]; in.g_mix_post = args.in[14]; in.g_ffn_pre = args.in[15]; in.g_ffn_post = args.in[16];
    float* H = (float*)(ws + WS_H); bf16_t* HN = (bf16_t*)(ws + WS_HN); bf16_t* PROJ = (bf16_t*)(ws + WS_PROJ); float* MISC = (float*)(ws + WS_MISC);
    bf16_t* CQN = (bf16_t*)(ws + WS_CQN); bf16_t* CKVN = (bf16_t*)(ws + WS_CKVN); bf16_t* QA = (bf16_t*)(ws + WS_QA); bf16_t* KA = (bf16_t*)(ws + WS_KA); bf16_t* VA = (bf16_t*)(ws + WS_VA);
    float* CB = (float*)(ws + WS_CB); bf16_t* OCAT = (bf16_t*)(ws + WS_OCAT); float* MIXF = (float*)(ws + WS_MIXF); bf16_t* MERGED = (bf16_t*)(ws + WS_MERGED); bf16_t* ACT = (bf16_t*)(ws + WS_ACT);
    float* ROPE = (float*)(ws + WS_ROPE); float* RSTD = (float*)(ws + WS_RSTD);

    for (int u = tid; u < (LDS_BYTES - RING_BYTES) / 4; u += NTHREADS) ((LAS unsigned*)(lds + RING_BYTES))[u] = 0u;
    __syncthreads();
    const int lo = args.ph_lo, hi = args.ph_hi;
    XcdBarrier bar; bar.bar = (unsigned*)(ws + WS_CTL) + 4096; bar.x = 0; bar.st = nullptr;
    if (hi - lo > 1) bar = xcd_barrier_post((unsigned*)(ws + WS_CTL) + 4096, MISCW + 8);
#ifndef SKIPMASK
#define SKIPMASK 0
#endif
#ifndef REPMASK
#define REPMASK 0
#endif
#define REP(k) for (int rep_ = 0; rep_ < 1 + ((REPMASK >> ((k) == 0 ? 0 : 1 + ((k) - 1) % 10)) & 1); ++rep_)
#define IN(k) (lo <= (k) && (k) < hi && !((SKIPMASK >> ((k) == 0 ? 0 : 1 + ((k) - 1) % 10)) & 1))
#define SEAM(k) do { if (IN(k) && IN((k) + 1)) xcd_barrier(bar); } while (0)

    if (IN(0)) REP(0) {
        if (rep_) xcd_barrier(bar);
        p0_weights(in, ws, lds, gw, NGW, wave, lane);
        p0_rope(ROPE, bid * NTHREADS + tid, G * NTHREADS);
        t_norm(0, false, in, H, H, nullptr, HN, RSTD, nullptr, nullptr, in.g_mix_pre, gw, NGW, lane);
    }
    SEAM(0);
#pragma unroll 1
    for (int l = 0; l < DEPTH; ++l) {
        const int pb = 1 + 10 * l;
        const unsigned char* wl = ws + WS_W + (size_t)l * W_LAYER;
        if (IN(pb + 0)) REP(pb + 0) {
            if (rep_) xcd_barrier(bar);
            SchedPlain S{(const char*)HN, (const char*)(wl + WO_W1), DM, DM, N1T, G, bid}; EpiG1 E{PROJ, MISC, RSTD};
            run_gemm(lds, DM, DM, DM, S, E);
            skinny_gemm(lds, HN + (size_t)MREAL * DM, DM, (const bf16_t*)(wl + WO_W1), DM, DM, N1 / 32, 1, 0, E, G, bid);
        }
        SEAM(pb + 0);
        if (IN(pb + 1)) REP(pb + 1) { if (rep_) xcd_barrier(bar); t1_phase(l, in, PROJ, MISC, CQN, CKVN, KA, OCAT, CB, ROPE, (LAS float*)(lds + wave * 16384), gw, NGW, lane); }
        SEAM(pb + 1);
        if (IN(pb + 2)) REP(pb + 2) {
            if (rep_) xcd_barrier(bar);
            SchedG2 S{(const char*)CKVN, (const char*)(wl + WO_WUKV), (const char*)CQN, (const char*)(wl + WO_WUQ), G, bid}; EpiG2 E{QA, KA, VA, ROPE};
            run_gemm(lds, 512, 512, 512, S, E);
            skinny_gemm(lds, CKVN + (size_t)MREAL * 512, 512, (const bf16_t*)(wl + WO_WUKV), 512, 512, 2048 / 32, 1, 0, E, G, bid);
            skinny_gemm(lds, CQN + (size_t)MREAL * 512, 512, (const bf16_t*)(wl + WO_WUQ), 512, 512, 1536 / 32, 1, 1, E, G, bid);
        }
        SEAM(pb + 2);
        if (IN(pb + 3)) REP(pb + 3) {
            if (rep_) xcd_barrier(bar);
#if FAST_ATTN
            attn_fast((char*)lds_raw, PROJ, QA, KA, VA, CB, OCAT, vcu, G);
            attn_naive(lds, PROJ, QA, KA, VA, CB, OCAT, NMETA, 1, gw, NGW, wave, lane);
#else
            attn_naive(lds, PROJ, QA, KA, VA, CB, OCAT, LSEQ, NBATCH, gw, NGW, wave, lane);
#endif
        }
        SEAM(pb + 3);
        if (IN(pb + 4)) REP(pb + 4) {
            if (rep_) xcd_barrier(bar);
            SchedG3 S{(const char*)OCAT, (const char*)(wl + WO_WBR), G, bid}; EpiG3 E{PROJ, MERGED};
            run_gemm(lds, 1024, 3072, 3072, S, E);
            skinny_gemm(lds, OCAT + (size_t)MREAL * 3072, 3072, (const bf16_t*)(wl + WO_WBR), 3072, 1024, DM / 32, 3, 0, E, G, bid);
        }
        SEAM(pb + 4);
        if (IN(pb + 5)) REP(pb + 5) {
            if (rep_) xcd_barrier(bar);
            SchedPlain S{(const char*)MERGED, (const char*)(wl + WO_WOUT), DM, DM, 8, G, bid}; EpiF32 E{MIXF};
            run_gemm(lds, DM, DM, DM, S, E);
            skinny_gemm(lds, MERGED + (size_t)MREAL * DM, DM, (const bf16_t*)(wl + WO_WOUT), DM, DM, DM / 32, 1, 0, E, G, bid);
        }
        SEAM(pb + 5);
        if (IN(pb + 6)) REP(pb + 6) { const bool dry = (REPMASK >> 7 & 1) && rep_ == 0; if (rep_) xcd_barrier(bar);
            t_norm(1, false, in, H, dry ? (float*)ACT : H, MIXF, dry ? PROJ : HN, dry ? MISC : RSTD, nullptr, in.g_mix_post + l * DM, in.g_ffn_pre + l * DM, gw, NGW, lane); }
        SEAM(pb + 6);
        if (IN(pb + 7)) REP(pb + 7) {
            if (rep_) xcd_barrier(bar);
            SchedPlain S{(const char*)HN, (const char*)(wl + WO_WF1), DM, DM, 2 * DFF / 256, G, bid}; EpiG5 E{ACT, RSTD};
            run_gemm(lds, DM, DM, DM, S, E);
            skinny_gemm(lds, HN + (size_t)MREAL * DM, DM, (const bf16_t*)(wl + WO_WF1), DM, DM, 2 * DFF / 32, 1, 0, E, G, bid);
        }
        SEAM(pb + 7);
        if (IN(pb + 8)) REP(pb + 8) {
            if (rep_) xcd_barrier(bar);
            SchedPlain S{(const char*)ACT, (const char*)(wl + WO_WF2), DFF, DFF, 8, G, bid}; EpiF32 E{MIXF};
            run_gemm(lds, DFF, DFF, DFF, S, E);
            skinny_gemm(lds, ACT + (size_t)MREAL * DFF, DFF, (const bf16_t*)(wl + WO_WF2), DFF, DFF, DM / 32, 1, 0, E, G, bid);
        }
        SEAM(pb + 8);
        if (IN(pb + 9)) REP(pb + 9) { const bool dry = (REPMASK >> 10 & 1) && rep_ == 0; if (rep_) xcd_barrier(bar);
            t_norm(1, l == DEPTH - 1, in, H, dry ? (float*)ACT : H, MIXF, dry ? PROJ : HN, dry ? MISC : RSTD, dry ? (float*)ACT : args.out, in.g_ffn_post + l * DM, in.g_mix_pre + (l + 1 < DEPTH ? l + 1 : 0) * DM, gw, NGW, lane); }
        SEAM(pb + 9);
    }
#undef IN
#undef SEAM
}

extern "C" void kernel_launch(void* const* d_in, const int* in_sizes, int n_in, void* d_out, int out_size, void* d_ws, size_t ws_size, hipStream_t stream) {
    static int grid = 0;
    if (grid == 0) {
        if (n_in != 17 || out_size != MREAL * DM || ws_size < WS_END) { fprintf(stderr, "kernel_launch: unexpected shapes: n_in %d out %d ws %zu (need %zu)\n", n_in, out_size, ws_size, (size_t)WS_END); grid = -1; return; }
        int dev = 0, cus = 0, per_cu = 0;
        if (hipGetDevice(&dev) != hipSuccess || hipDeviceGetAttribute(&cus, hipDeviceAttributeMultiprocessorCount, dev) != hipSuccess) { grid = -1; return; }
        if (hipFuncSetAttribute((const void*)fwd, hipFuncAttributeMaxDynamicSharedMemorySize, LDS_BYTES) != hipSuccess) { fprintf(stderr, "kernel_launch: hipFuncSetAttribute failed\n"); grid = -1; return; }
        if (hipOccupancyMaxActiveBlocksPerMultiprocessor(&per_cu, (const void*)fwd, NTHREADS, LDS_BYTES) != hipSuccess || per_cu < 1) fprintf(stderr, "kernel_launch: occupancy query says %d\n", per_cu);
        (void)hipGetLastError();
        grid = cus;
    }
    if (grid < 0) return;
    (void)hipMemsetAsync((char*)d_ws + WS_CTL, 0, CTL_ZERO_BYTES, stream);
    Args a{};
    for (int i = 0; i < 17; ++i) a.in[i] = (const float*)d_in[i];
    a.out = (float*)d_out; a.ws = (unsigned char*)d_ws;
#if MK_ONE_LAUNCH
    a.ph_lo = 0; a.ph_hi = NPHASES;
    hipLaunchKernelGGL(fwd, dim3(grid), dim3(NTHREADS), LDS_BYTES, stream, a);
#else
    for (int p = 0; p < NPHASES; ++p) { a.ph_lo = p; a.ph_hi = p + 1; hipLaunchKernelGGL(fwd, dim3(grid), dim3(NTHREADS), LDS_BYTES, stream, a); }
#endif
}
```

```cpp
#include <hip/hip_runtime.h>
#include <cstdio>
#include <cstdint>

#ifndef MK_ONE_LAUNCH
#define MK_ONE_LAUNCH 1
#endif
#ifndef FAST_GEMM
#define FAST_GEMM 1
#endif
#ifndef FAST_ATTN
#define FAST_ATTN 1
#endif

#define GAS __attribute__((address_space(1)))
#define LAS __attribute__((address_space(3)))
typedef unsigned short bf16_t;
typedef short bf16x8 __attribute__((ext_vector_type(8)));
typedef float f32x4 __attribute__((ext_vector_type(4)));
typedef float f32x2 __attribute__((ext_vector_type(2)));
typedef unsigned u32x4 __attribute__((ext_vector_type(4)));
typedef unsigned u32x2 __attribute__((ext_vector_type(2)));
typedef __bf16 bf16x2_t __attribute__((ext_vector_type(2)));

constexpr int DM = 2048, NBATCH = 4, SEQ = 2048, DEPTH = 4, NMETA = 16, LSEQ = SEQ + NMETA;
constexpr int MREAL = NBATCH * SEQ;
constexpr int MTOK = MREAL + NMETA;
constexpr int MP = MREAL + 64, NPM = MREAL / 256;
constexpr int DIN = 13384, N1 = 13568, N1T = N1 / 256;
constexpr int DFF = 5632, NH = 8, HQK = 192;
constexpr float EPS = 1e-6f;
constexpr int PC_CQ = 0, PC_CKV = 512, PC_MISC = 1024, PC_CONVB = 1280, PC_CONVC = 2304, PC_CONVX = 3328, PC_FQ = 4352, PC_FK = 5376, PC_FV = 6400, PC_GATE = 7424;
constexpr int CBLD = 2112;

constexpr size_t al256(size_t x) { return (x + 255) & ~(size_t)255; }
constexpr size_t WS_CTL = 0, CTL_ZERO_BYTES = 1u << 20;
constexpr size_t SZ_W1 = (size_t)N1 * DM * 2, SZ_WUQ = (size_t)1536 * 512 * 2, SZ_WUKV = (size_t)2048 * 512 * 2, SZ_WBR = (size_t)DM * 3072 * 2,
                 SZ_WOUT = (size_t)DM * DM * 2, SZ_WF1 = (size_t)2 * DFF * DM * 2, SZ_WF2 = (size_t)DM * DFF * 2;
constexpr size_t WO_W1 = 0, WO_WUQ = WO_W1 + SZ_W1, WO_WUKV = WO_WUQ + SZ_WUQ, WO_WBR = WO_WUKV + SZ_WUKV, WO_WOUT = WO_WBR + SZ_WBR,
                 WO_WF1 = WO_WOUT + SZ_WOUT, WO_WF2 = WO_WF1 + SZ_WF1, W_LAYER = WO_WF2 + SZ_WF2;
constexpr size_t WS_W = CTL_ZERO_BYTES;
constexpr size_t WS_H = al256(WS_W + DEPTH * W_LAYER);
constexpr size_t WS_HN = al256(WS_H + (size_t)MP * DM * 4);
constexpr size_t WS_PROJ = al256(WS_HN + (size_t)MP * DM * 2);
constexpr size_t WS_MISC = al256(WS_PROJ + (size_t)MP * N1 * 2);
constexpr size_t WS_CQN = al256(WS_MISC + (size_t)MP * 128 * 4);
constexpr size_t WS_CKVN = al256(WS_CQN + (size_t)MP * 512 * 2);
constexpr size_t WS_QA = al256(WS_CKVN + (size_t)MP * 512 * 2);
constexpr size_t WS_KA = al256(WS_QA + (size_t)MP * 1536 * 2);
constexpr size_t WS_VA = al256(WS_KA + (size_t)MP * 1536 * 2);
constexpr size_t WS_CB = al256(WS_VA + (size_t)MP * 1024 * 2);
constexpr size_t WS_OCAT = al256(WS_CB + (size_t)32 * CBLD * 4);
constexpr size_t WS_MIXF = al256(WS_OCAT + (size_t)MP * 3072 * 2);
constexpr size_t WS_MERGED = al256(WS_MIXF + (size_t)MP * DM * 4);
constexpr size_t WS_ACT = al256(WS_MERGED + (size_t)MP * DM * 2);
constexpr size_t WS_ROPE = al256(WS_ACT + (size_t)MP * DFF * 2);
constexpr size_t WS_RSTD = al256(WS_ROPE + (size_t)LSEQ * 32 * 2 * 4);
constexpr size_t WS_END = al256(WS_RSTD + (size_t)MP * 4);

constexpr int NWAVES = 8, NTHREADS = NWAVES * 64;
constexpr int LDS_BYTES = 147456;
constexpr int RING_BYTES = 131072, MISC_OFF = LDS_BYTES - 256;
constexpr int NPHASES = 1 + 10 * DEPTH;

__device__ __forceinline__ unsigned cvtpk(float lo, float hi) { f32x2 v = {lo, hi}; bf16x2_t b = __builtin_convertvector(v, bf16x2_t); return __builtin_bit_cast(unsigned, b); }
__device__ __forceinline__ float bf2f(unsigned short u) { return __uint_as_float((unsigned)u << 16); }
__device__ __forceinline__ float bflo(unsigned w) { return __uint_as_float(w << 16); }
__device__ __forceinline__ float bfhi(unsigned w) { return __uint_as_float(w & 0xffff0000u); }
__device__ __forceinline__ float wave_sum(float v) {
#pragma unroll
    for (int o = 1; o < 64; o <<= 1) v += __shfl_xor(v, o);
    return v;
}
__device__ __forceinline__ float wave_max(float v) {
#pragma unroll
    for (int o = 1; o < 64; o <<= 1) v = fmaxf(v, __shfl_xor(v, o));
    return v;
}
__device__ __forceinline__ float sigmoidf_(float x) { return __builtin_amdgcn_rcpf(1.0f + __builtin_amdgcn_exp2f(-1.4426950408889634f * x)); }
__device__ __forceinline__ int row_of(int b, int t) { return t < NMETA ? MREAL + t : b * SEQ + t - NMETA; }
__device__ __forceinline__ int t_of(int r) { return r < MREAL ? NMETA + (r & (SEQ - 1)) : ((r - MREAL) & (NMETA - 1)); }
#define LDS_WAIT() asm volatile("s_waitcnt lgkmcnt(0)" ::: "memory")
#define VM_WAIT() asm volatile("s_waitcnt vmcnt(0)" ::: "memory")

#define XB_TMO      128
#define XB_XCNT(j)  (256  + 64 * (j))
#define XB_XSUB(j)  (1280 + 64 * (j))
#define XB_XGEN(j)  (2304 + 64 * (j))
#define XB_TOP      3328
#define XB_TOPGEN   3392
#define XCD_BAR_WORDS 3456
#define XB_SPIN_CAP (1u << 18)
__device__ __forceinline__ unsigned xb_ld(unsigned* p)              { return __hip_atomic_load(p, __ATOMIC_RELAXED, __HIP_MEMORY_SCOPE_AGENT); }
__device__ __forceinline__ unsigned xb_add(unsigned* p, unsigned v) { return __hip_atomic_fetch_add(p, v, __ATOMIC_RELAXED, __HIP_MEMORY_SCOPE_AGENT); }
__device__ __forceinline__ unsigned xb_xcc_id() { return (unsigned)__builtin_amdgcn_s_getreg((3 << 11) | 20) & 0xFu; }
#define XB_SPIN(cond, bar) do { unsigned _sp = 0; while (cond) { __builtin_amdgcn_s_sleep(1); \
    if ((++_sp & 255u) == 0u) { if (xb_ld(&(bar)[XB_TMO])) break; if (_sp > XB_SPIN_CAP) { atomicAdd(&(bar)[XB_TMO], 1u); break; } } } } while (0)
struct XcdBarrier { unsigned* bar; unsigned x; volatile LAS unsigned* st; };
__device__ __forceinline__ XcdBarrier xcd_barrier_post(unsigned* bar, volatile LAS unsigned* st) {
    XcdBarrier b; b.bar = bar; b.x = xb_xcc_id(); b.st = st;
    if (threadIdx.x == 0) (void)xb_add(&bar[XB_XCNT(b.x)], 1u);
    return b;
}
__device__ __forceinline__ void xcd_barrier_complete(unsigned* bar, unsigned x, unsigned& nloc, unsigned& nx) {
    const unsigned G = gridDim.x * gridDim.y * gridDim.z;
    unsigned sum, cnt, mine, sp = 0u;
    for (;;) {
        sum = 0u; cnt = 0u; mine = 0u;
#pragma unroll
        for (unsigned j = 0; j < 16; ++j) { const unsigned c = xb_ld(&bar[XB_XCNT(j)]); sum += c; cnt += (c > 0u) ? 1u : 0u; mine = (j == x) ? c : mine; }
        if (sum == G) break;
        __builtin_amdgcn_s_sleep(1);
        if ((++sp & 255u) == 0u) { if (xb_ld(&bar[XB_TMO])) break; if (sp > XB_SPIN_CAP) { atomicAdd(&bar[XB_TMO], 1u); break; } }
    }
    nloc = mine > 0u ? mine : 1u; nx = cnt > 0u ? cnt : 1u;
}
__device__ __forceinline__ void xcd_barrier(const XcdBarrier& b) {
    asm volatile("s_waitcnt vmcnt(0)" ::: "memory");
    __syncthreads();
    if (threadIdx.x == 0) {
        unsigned* bar = b.bar; asm volatile("" : "+s"(bar));
        __builtin_amdgcn_s_waitcnt(0);
        unsigned nloc = b.st[0], nx = b.st[1];
        if (nloc == 0u) { xcd_barrier_complete(bar, b.x, nloc, nx); b.st[0] = nloc; b.st[1] = nx; }
        const unsigned old = xb_add(&bar[XB_XSUB(b.x)], 1u);
        const unsigned gen = old / nloc;
        if (old + 1u == (gen + 1u) * nloc) {
            __builtin_amdgcn_fence(__ATOMIC_RELEASE, "agent");
            asm volatile("s_waitcnt vmcnt(0)" ::: "memory");
            const unsigned og = xb_add(&bar[XB_TOP], 1u);
            const unsigned tg = og / nx;
            if (og + 1u == (tg + 1u) * nx) xb_add(&bar[XB_TOPGEN], 1u);
            else XB_SPIN(xb_ld(&bar[XB_TOPGEN]) == tg, bar);
            __builtin_amdgcn_fence(__ATOMIC_ACQUIRE, "agent");
            xb_add(&bar[XB_XGEN(b.x)], 1u);
            asm volatile("s_waitcnt vmcnt(0)" ::: "memory");
        } else {
            XB_SPIN(xb_ld(&bar[XB_XGEN(b.x)]) == gen, bar);
            __builtin_amdgcn_fence(__ATOMIC_ACQUIRE, "agent");
            asm volatile("s_waitcnt vmcnt(0)" ::: "memory");
        }
    }
    __syncthreads();
}

struct Unit { int pm, pn, tag; const char* A; const char* B; };

__device__ __forceinline__ void tile_decode(int L, int nM, int nN, int& pm, int& pn) {
    const int nwg = nM * nN; int wgid = L;
    { const int q = nwg / 8, r = nwg % 8, xcd = wgid % 8, off = wgid / 8; wgid = (xcd < r ? xcd * (q + 1) : r * (q + 1) + (xcd - r) * q) + off; }
    const int nig = 8 * nN, gid = wgid / nig, fm = gid * 8, gsz = (nM - fm) < 8 ? (nM - fm) : 8;
    pm = fm + ((wgid % nig) % gsz); pn = (wgid % nig) / gsz;
}
struct SchedPlain {
    const char* A; const char* B; int lda, ldb, nN, G, c;
    __device__ __forceinline__ bool next(int i, Unit& u) const {
        const int L = i * G + c; if (L >= NPM * nN) return false;
        tile_decode(L, NPM, nN, u.pm, u.pn); u.tag = 0;
        u.A = A + (size_t)u.pm * 256 * lda * 2; u.B = B + (size_t)u.pn * 256 * ldb * 2; return true;
    }
};
struct SchedG2 {
    const char* Akv; const char* Bkv; const char* Aq; const char* Bq; int G, c;
    __device__ __forceinline__ bool next(int i, Unit& u) const {
        int L = i * G + c; if (L >= NPM * 14) return false;
        if (L < NPM * 8) { tile_decode(L, NPM, 8, u.pm, u.pn); u.tag = 0; u.A = Akv + (size_t)u.pm * 256 * 1024; u.B = Bkv + (size_t)u.pn * 256 * 1024; }
        else { L -= NPM * 8; tile_decode(L, NPM, 6, u.pm, u.pn); u.tag = 1; u.A = Aq + (size_t)u.pm * 256 * 1024; u.B = Bq + (size_t)u.pn * 256 * 1024; }
        return true;
    }
};
struct SchedG3 {
    const char* A; const char* B; int G, c;
    __device__ __forceinline__ bool next(int i, Unit& u) const {
        const int br = i % 3, L = (i / 3) * G + c; if (L >= NPM * 8) return false;
        tile_decode(L, NPM, 8, u.pm, u.pn); u.tag = br;
        u.A = A + ((size_t)u.pm * 256 * 3072 + br * 1024) * 2; u.B = B + ((size_t)u.pn * 256 * 3072 + br * 1024) * 2; return true;
    }
};

__device__ __forceinline__ void st_bf4(bf16_t* p, f32x4 v) { u32x2 w; w.x = cvtpk(v[0], v[1]); w.y = cvtpk(v[2], v[3]); *(u32x2*)p = w; }
__device__ __forceinline__ void st_bf8(bf16_t* p, f32x4 a, f32x4 b) { u32x4 w; w.x = cvtpk(a[0], a[1]); w.y = cvtpk(a[2], a[3]); w.z = cvtpk(b[0], b[1]); w.w = cvtpk(b[2], b[3]); *(u32x4*)p = w; }
template <class D> struct EpiBase {
    __device__ __forceinline__ void operator()(int tag, int row, int pn, int cj, f32x4& lo, f32x4& hi) const { const D& d = *static_cast<const D*>(this); d.calc(tag, row, pn, cj, lo, hi); d.store4(tag, row, pn, cj, lo, hi); }
    __device__ __forceinline__ void w8(int tag, int row, int pn, int cj, f32x4& l0, f32x4& l1, f32x4& h0, f32x4& h1) const { const D& d = *static_cast<const D*>(this);
        d.calc(tag, row, pn, cj, l0, h0); d.calc(tag, row, pn, cj + 4, l1, h1); d.store8(tag, row, pn, cj, l0, l1, h0, h1); }
};
struct EpiG1 : EpiBase<EpiG1> {
    static constexpr bool CHAIN = false, EPIPROBE = true;
    bf16_t* proj; float* misc; const float* rstd;
    __device__ __forceinline__ void calc(int, int row, int pn, int, f32x4& lo, f32x4& hi) const {
        const float rs = rstd[row]; lo = lo * rs; hi = hi * rs;
        if (pn >= PC_GATE / 256) {
#pragma unroll
            for (int e = 0; e < 4; ++e) { lo[e] = fmaxf(sigmoidf_(lo[e]), 7.888609052210118e-31f); hi[e] = fmaxf(sigmoidf_(hi[e]), 7.888609052210118e-31f); }
        }
    }
    __device__ __forceinline__ void store4(int, int row, int pn, int cj, const f32x4& lo, const f32x4& hi) const {
        bf16_t* p = proj + (size_t)row * N1 + pn * 256 + cj; st_bf4(p, lo); st_bf4(p + 128, hi);
        if (pn == PC_MISC / 256) *(f32x4*)(misc + (size_t)row * 128 + cj) = lo;
    }
    __device__ __forceinline__ void store8(int, int row, int pn, int cj, const f32x4& l0, const f32x4& l1, const f32x4& h0, const f32x4& h1) const {
        bf16_t* p = proj + (size_t)row * N1 + pn * 256 + cj; st_bf8(p, l0, l1); st_bf8(p + 128, h0, h1);
        if (pn == PC_MISC / 256) { float* q = misc + (size_t)row * 128 + cj; *(f32x4*)q = l0; *(f32x4*)(q + 4) = l1; }
    }
};
struct EpiG2 : EpiBase<EpiG2> {
    static constexpr bool CHAIN = false, EPIPROBE = false;
    bf16_t* qa; bf16_t* ka; bf16_t* va; const float* rope;
    __device__ __forceinline__ void rot(int row, int col, f32x4& v) const {
        const int h = col / HQK, j = col - h * HQK;
        if (j >= 128) {
            const int i0 = (j - 128) >> 1; const float* rp = rope + ((size_t)t_of(row) * 32 + i0) * 2;
            const f32x4 cs = *(const f32x4*)rp;
            v = (f32x4){v[0] * cs[0] - v[1] * cs[1], v[0] * cs[1] + v[1] * cs[0], v[2] * cs[2] - v[3] * cs[3], v[2] * cs[3] + v[3] * cs[2]};
        }
    }
    __device__ __forceinline__ void calc(int tag, int row, int pn, int cj, f32x4& lo, f32x4& hi) const { if (tag != 0) { rot(row, pn * 256 + cj, lo); rot(row, pn * 256 + 128 + cj, hi); } }
    __device__ __forceinline__ void store4(int tag, int row, int pn, int cj, const f32x4& lo, const f32x4& hi) const {
        if (tag == 0) { st_bf4(ka + (size_t)row * 1536 + pn * HQK + cj, lo); st_bf4(va + (size_t)row * 1024 + pn * 128 + cj, hi); }
        else { bf16_t* p = qa + (size_t)row * 1536 + pn * 256 + cj; st_bf4(p, lo); st_bf4(p + 128, hi); }
    }
    __device__ __forceinline__ void store8(int tag, int row, int pn, int cj, const f32x4& l0, const f32x4& l1, const f32x4& h0, const f32x4& h1) const {
        if (tag == 0) { st_bf8(ka + (size_t)row * 1536 + pn * HQK + cj, l0, l1); st_bf8(va + (size_t)row * 1024 + pn * 128 + cj, h0, h1); }
        else { bf16_t* p = qa + (size_t)row * 1536 + pn * 256 + cj; st_bf8(p, l0, l1); st_bf8(p + 128, h0, h1); }
    }
};
struct EpiG3 : EpiBase<EpiG3> {
    static constexpr bool CHAIN = true, EPIPROBE = false;
    const bf16_t* proj; bf16_t* merged;
    __device__ __forceinline__ void one(int tag, int row, int col, f32x4& v) const {
        const bf16_t* gp = proj + (size_t)row * N1 + PC_GATE + tag * DM + col;
        const u32x2 g = *(const u32x2*)gp;
        f32x4 f = {bflo(g.x), bfhi(g.x), bflo(g.y), bfhi(g.y)};
        if (tag < 2) { const u32x2 gn = *(const u32x2*)(gp + DM);
            f = (f32x4){f[0] * __builtin_amdgcn_rcpf(bflo(gn.x)), f[1] * __builtin_amdgcn_rcpf(bfhi(gn.x)), f[2] * __builtin_amdgcn_rcpf(bflo(gn.y)), f[3] * __builtin_amdgcn_rcpf(bfhi(gn.y))}; }
        v = v * f;
    }
    __device__ __forceinline__ void calc(int tag, int row, int pn, int cj, f32x4& lo, f32x4& hi) const { one(tag, row, pn * 256 + cj, lo); one(tag, row, pn * 256 + 128 + cj, hi); }
    __device__ __forceinline__ void store4(int tag, int row, int pn, int cj, const f32x4& lo, const f32x4& hi) const { if (tag == 2) { bf16_t* p = merged + (size_t)row * DM + pn * 256 + cj; st_bf4(p, lo); st_bf4(p + 128, hi); } }
    __device__ __forceinline__ void store8(int tag, int row, int pn, int cj, const f32x4& l0, const f32x4& l1, const f32x4& h0, const f32x4& h1) const {
        if (tag == 2) { bf16_t* p = merged + (size_t)row * DM + pn * 256 + cj; st_bf8(p, l0, l1); st_bf8(p + 128, h0, h1); } }
    __device__ __forceinline__ void g3(int row, int col, const f32x4 (&y)[3]) const {
        f32x4 v = {0.f, 0.f, 0.f, 0.f};
#pragma unroll
        for (int br = 0; br < 3; ++br) { const u32x2 g = *(const u32x2*)(proj + (size_t)row * N1 + PC_GATE + br * DM + col); v += y[br] * (f32x4){bflo(g.x), bfhi(g.x), bflo(g.y), bfhi(g.y)}; }
        st_bf4(merged + (size_t)row * DM + col, v);
    }
    __device__ __forceinline__ void gated3(int row, int pn, int cj, const f32x4 (&lo)[3], const f32x4 (&hi)[3]) const { g3(row, pn * 256 + cj, lo); g3(row, pn * 256 + 128 + cj, hi); }
};
struct EpiF32 : EpiBase<EpiF32> {
    static constexpr bool CHAIN = false, EPIPROBE = false;
    float* out;
    __device__ __forceinline__ void calc(int, int, int, int, f32x4&, f32x4&) const {}
    __device__ __forceinline__ void store4(int, int row, int pn, int cj, const f32x4& lo, const f32x4& hi) const { float* p = out + (size_t)row * DM + pn * 256 + cj; *(f32x4*)p = lo; *(f32x4*)(p + 128) = hi; }
    __device__ __forceinline__ void store8(int, int row, int pn, int cj, const f32x4& l0, const f32x4& l1, const f32x4& h0, const f32x4& h1) const {
        float* p = out + (size_t)row * DM + pn * 256 + cj; *(f32x4*)p = l0; *(f32x4*)(p + 4) = l1; *(f32x4*)(p + 128) = h0; *(f32x4*)(p + 132) = h1; }
};
struct EpiG5 : EpiBase<EpiG5> {
    static constexpr bool CHAIN = false, EPIPROBE = false;
    bf16_t* act; const float* rstd;
    __device__ __forceinline__ void calc(int, int row, int, int, f32x4& lo, f32x4& hi) const {
        const float rs = rstd[row]; lo = lo * rs; hi = hi * rs;
#pragma unroll
        for (int e = 0; e < 4; ++e) lo[e] = lo[e] * sigmoidf_(lo[e]) * hi[e];
    }
    __device__ __forceinline__ void store4(int, int row, int pn, int cj, const f32x4& lo, const f32x4&) const { st_bf4(act + (size_t)row * DFF + pn * 128 + cj, lo); }
    __device__ __forceinline__ void store8(int, int row, int pn, int cj, const f32x4& l0, const f32x4& l1, const f32x4&, const f32x4&) const { st_bf8(act + (size_t)row * DFF + pn * 128 + cj, l0, l1); }
};

template <class EF, class Sched>
__device__ __forceinline__ void gemm_simple(int K, int lda, int ldb, const Sched& S, const EF& E) {
    const int tid = threadIdx.x, wid = tid >> 6, lane = tid & 63, wr = wid >> 2, q = wid & 3, fr = lane & 15, fq = lane >> 4;
    Unit u;
#pragma unroll 1
    for (int i = 0; S.next(i, u); ++i) {
        const bf16_t* Ab = (const bf16_t*)u.A; const bf16_t* Bb = (const bf16_t*)u.B;
#pragma unroll 1
        for (int rb = 0; rb < 8; ++rb) {
            const int rloc = wr * 128 + rb * 16 + fr;
            f32x4 acc[4] = {};
            static_assert(!EF::CHAIN, "gemm_simple: no chained epilogues");
            const bf16_t* ap = Ab + (size_t)rloc * lda + fq * 8;
            const bf16_t* bp[4];
#pragma unroll
            for (int n = 0; n < 4; ++n) bp[n] = Bb + (size_t)((n >> 1) * 128 + q * 32 + (n & 1) * 16 + fr) * ldb + fq * 8;
#pragma unroll 2
            for (int k = 0; k < K; k += 32) {
                const bf16x8 a = *(const bf16x8*)(ap + k);
#pragma unroll
                for (int n = 0; n < 4; ++n) { const bf16x8 b = *(const bf16x8*)(bp[n] + k); acc[n] = __builtin_amdgcn_mfma_f32_16x16x32_bf16(b, a, acc[n], 0, 0, 0); }
            }
            const int row = u.pm * 256 + rloc;
#pragma unroll
            for (int n = 0; n < 2; ++n) E(u.tag, row, u.pn, q * 32 + n * 16 + 4 * fq, acc[n], acc[2 + n]);
        }
    }
}

namespace pg8 {
constexpr int BK = 64, HALF = 128, HTB = HALF * BK * 2, STAGE_BYTES = 8 * HTB;
__device__ __forceinline__ int lds_byte(int r, int c) { const int st = (r >> 4) * 2 + (c >> 5), rr = r & 15, cc = c & 31, ob = rr * 64 + cc * 2; return st * 1024 + (ob ^ (((ob >> 9) & 1) << 5)); }
__device__ __forceinline__ int perm32(int rho) { const int n = rho >> 4, i = rho & 15; return 8 * (i >> 2) + 4 * n + (i & 3); }
__device__ __forceinline__ void stage_rc(int b, int& R, int& C) { const int st = b / 1024, sb = b % 1024, swz = sb ^ (((sb >> 9) & 1) << 5); R = (st >> 1) * 16 + swz / 64; C = (st & 1) * 32 + (swz % 64) / 2; }

template <class EF, class Sched, bool ALIGN_EPI>
__device__ __forceinline__ void gemm_phase(LAS unsigned char* lds, const int K, const int lda, const int ldb, const Sched& S, const EF& E) {
    int tid = threadIdx.x; asm volatile("" : "+v"(tid));
    const int wid = __builtin_amdgcn_readfirstlane(tid >> 6), lane = tid & 63, wr = wid >> 2, wc = wid & 3, fr = lane & 15, fq = lane >> 4;
    const int nt = K / BK;
    unsigned voffA[2], voffB[2];
#pragma unroll
    for (int i = 0; i < 2; ++i) { int R, C; stage_rc(tid * 16 + i * 8192, R, C); const int Rb = (R & ~31) + perm32(R & 31);
        voffA[i] = (unsigned)(R * lda + C) * 2u; voffB[i] = (unsigned)(Rb * ldb + C) * 2u; }
    const size_t kstep = (size_t)(BK * 2);
    const size_t hstepA = (size_t)HALF * lda * 2, hstepB = (size_t)HALF * ldb * 2;
    const unsigned ldsw = (unsigned)wid * 1024u;
    const int aoff = lds_byte(wr * 64 + fr, fq * 8), boff = lds_byte(wc * 32 + fr, fq * 8);
#define PG8_SA(b, h) (((b) * 2 + (h)) * HTB)
#define PG8_SB(b, h) ((4 + (b) * 2 + (h)) * HTB)
#define PG8_STAGE(bufoff, gbase, voff) do { _Pragma("unroll") for (int _i = 0; _i < 2; ++_i) \
        __builtin_amdgcn_global_load_lds((const unsigned*)((const char*)(gbase) + (voff)[_i]), (LAS unsigned*)(lds + (bufoff) + ldsw + _i * 8192), 16, 0, 0); } while (0)
#define PG8_LDA(dst, b, h) do { _Pragma("unroll") for (int m = 0; m < 4; ++m) _Pragma("unroll") for (int k = 0; k < 2; ++k) dst[m][k] = *(const LAS bf16x8*)(lds + PG8_SA(b, h) + aoff + m * 2048 + k * 1024); } while (0)
#define PG8_LDB(dst, b, h) do { _Pragma("unroll") for (int n = 0; n < 2; ++n) _Pragma("unroll") for (int k = 0; k < 2; ++k) dst[n][k] = *(const LAS bf16x8*)(lds + PG8_SB(b, h) + boff + n * 2048 + k * 1024); } while (0)
#define PG8_MMA(ai, bj, At, Bt) do { __builtin_amdgcn_s_setprio(1); _Pragma("unroll") for (int m = 0; m < 4; ++m) _Pragma("unroll") for (int n = 0; n < 2; ++n) _Pragma("unroll") for (int k = 0; k < 2; ++k) \
        acc[ai][bj][m][n] = __builtin_amdgcn_mfma_f32_16x16x32_bf16(Bt[n][k], At[m][k], acc[ai][bj][m][n], 0, 0, 0); __builtin_amdgcn_s_setprio(0); } while (0)
#define PG8_WAIT_V(n) asm volatile("s_waitcnt vmcnt(" #n ")" ::: "memory")
#define PG8_WAIT_L(n) asm volatile("s_waitcnt lgkmcnt(" #n ")" ::: "memory")
#define PG8_BAR __builtin_amdgcn_s_barrier()
#define PG8_SCHED __builtin_amdgcn_sched_barrier(0)
    Unit cur, nxt; int ui = 0;
    if (!S.next(0, cur)) return;
    f32x4 acc[2][2][4][2];
#pragma unroll
    for (int a = 0; a < 2; ++a)
#pragma unroll
        for (int b = 0; b < 2; ++b)
#pragma unroll
            for (int m = 0; m < 4; ++m)
#pragma unroll
                for (int n = 0; n < 2; ++n) acc[a][b][m][n] = (f32x4){0.f, 0.f, 0.f, 0.f};
    bf16x8 At[4][2], B0[2][2], B1[2][2];
    const char* cA = cur.A; const char* cB = cur.B;
    PG8_STAGE(PG8_SB(0, 0), cB, voffB); PG8_STAGE(PG8_SB(0, 1), cB + hstepB, voffB); PG8_STAGE(PG8_SA(0, 0), cA, voffA); PG8_STAGE(PG8_SA(0, 1), cA + hstepA, voffA);
    if (wr == 1) PG8_BAR;
    PG8_WAIT_V(2); PG8_BAR;
    PG8_STAGE(PG8_SB(1, 0), cB + kstep, voffB); PG8_STAGE(PG8_SA(1, 0), cA + kstep, voffA); PG8_STAGE(PG8_SB(1, 1), cB + hstepB + kstep, voffB);
    PG8_WAIT_V(6); PG8_BAR;
    for (;;) {
        const bool has_next = S.next(ui + 1, nxt);
        const char* nA = has_next ? nxt.A : cA; const char* nB = has_next ? nxt.B : cB;
        for (int t = 0; t < nt; t += 2) {
            const bool last = (t == nt - 2);
            const char* a1 = cA + (size_t)(t + 1) * kstep;
            const char* a2 = last ? nA : cA + (size_t)(t + 2) * kstep; const char* b2 = last ? nB : cB + (size_t)(t + 2) * kstep;
            const char* a3 = a2 + kstep; const char* b3 = b2 + kstep;
            PG8_LDB(B0, 0, 0); PG8_LDB(B1, 0, 1); PG8_SCHED; PG8_LDA(At, 0, 0); PG8_STAGE(PG8_SA(1, 1), a1 + hstepA, voffA);
            PG8_WAIT_V(8); PG8_WAIT_L(0); PG8_BAR; PG8_MMA(0, 0, At, B0); PG8_MMA(0, 1, At, B1); PG8_BAR; PG8_SCHED;
            PG8_LDA(At, 0, 1); PG8_STAGE(PG8_SB(0, 0), b2, voffB); PG8_STAGE(PG8_SB(0, 1), b2 + hstepB, voffB); PG8_STAGE(PG8_SA(0, 0), a2, voffA);
            PG8_WAIT_V(8); PG8_WAIT_L(0); PG8_BAR; PG8_MMA(1, 0, At, B0); PG8_MMA(1, 1, At, B1); PG8_BAR; PG8_SCHED;
            PG8_LDB(B0, 1, 0); PG8_LDB(B1, 1, 1); PG8_SCHED; PG8_LDA(At, 1, 0); PG8_STAGE(PG8_SA(0, 1), a2 + hstepA, voffA);
            PG8_WAIT_V(8); PG8_WAIT_L(0); PG8_BAR; PG8_MMA(0, 0, At, B0); PG8_MMA(0, 1, At, B1); PG8_BAR; PG8_SCHED;
            PG8_LDA(At, 1, 1); PG8_STAGE(PG8_SB(1, 0), b3, voffB); PG8_STAGE(PG8_SB(1, 1), b3 + hstepB, voffB); PG8_STAGE(PG8_SA(1, 0), a3, voffA);
            PG8_WAIT_V(8); PG8_WAIT_L(0); PG8_BAR; PG8_MMA(1, 0, At, B0); PG8_MMA(1, 1, At, B1); PG8_BAR; PG8_SCHED;
        }
        if constexpr (ALIGN_EPI) { if (wr == 0) PG8_BAR; }
#ifndef EPIREP
#define EPIREP 0
#endif
        if constexpr (EF::EPIPROBE) { for (int er = 0; er < EPIREP; ++er) {
#pragma unroll
            for (int ai = 0; ai < 2; ++ai)
#pragma unroll
                for (int m = 0; m < 4; ++m) { const int row = cur.pm * 256 + ai * HALF + wr * 64 + m * 16 + fr;
                    f32x4 l0_ = acc[ai][0][m][0], l1_ = acc[ai][0][m][1], h0_ = acc[ai][1][m][0], h1_ = acc[ai][1][m][1]; E.w8(cur.tag, row, cur.pn, wc * 32 + 8 * fq, l0_, l1_, h0_, h1_); }
            asm volatile("" ::: "memory"); } }
        {
#pragma unroll
            for (int ai = 0; ai < 2; ++ai)
#pragma unroll
                for (int m = 0; m < 4; ++m) { const int row = cur.pm * 256 + ai * HALF + wr * 64 + m * 16 + fr;
                    E.w8(cur.tag, row, cur.pn, wc * 32 + 8 * fq, acc[ai][0][m][0], acc[ai][0][m][1], acc[ai][1][m][0], acc[ai][1][m][1]); }
        }
        if (!has_next) break;
        if (!EF::CHAIN || cur.tag == 2) {
#pragma unroll
        for (int a = 0; a < 2; ++a)
#pragma unroll
            for (int b = 0; b < 2; ++b)
#pragma unroll
                for (int m = 0; m < 4; ++m)
#pragma unroll
                    for (int n = 0; n < 2; ++n) acc[a][b][m][n] = (f32x4){0.f, 0.f, 0.f, 0.f};
        }
        cur = nxt; cA = nA; cB = nB; ++ui;
        if constexpr (ALIGN_EPI) { if (wr == 1) PG8_BAR; }
    }
    PG8_WAIT_V(0);
    if constexpr (!ALIGN_EPI) { if (wr == 0) PG8_BAR; }
    PG8_BAR;
#undef PG8_SA
#undef PG8_SB
#undef PG8_STAGE
#undef PG8_LDA
#undef PG8_LDB
#undef PG8_MMA
#undef PG8_WAIT_V
#undef PG8_WAIT_L
#undef PG8_BAR
#undef PG8_SCHED
}
}

template <class EF, class Sched>
__device__ __forceinline__ void run_gemm(LAS unsigned char* lds, int K, int lda, int ldb, const Sched& S, const EF& E) {
#if FAST_GEMM
    pg8::gemm_phase<EF, Sched, true>(lds, K, lda, ldb, S, E);
#else
    gemm_simple<EF, Sched>(K, lda, ldb, S, E);
#endif
}

template <int NBR, class EF>
__device__ __forceinline__ void skinny_gemm(LAS unsigned char* lds, const bf16_t* A, int lda, const bf16_t* Bt, int ldb, int K, int nitems, int tag0, const EF& E, int G, int bid, int nspread) {
    int tid = threadIdx.x; asm volatile("" : "+v"(tid));
    const int wid = __builtin_amdgcn_readfirstlane(tid >> 6), lane = tid & 63, fr = lane & 15, fq = lane >> 4;
    const int slot = G - 1 - bid; if (slot >= nspread) return;
    const int kw = K / 8; int par = 0;
#pragma unroll 1
    for (int p = slot; p < nitems; p += nspread) {
        const int pn = p >> 3, q = p & 7;
        LAS f32x4* red = (LAS f32x4*)(lds + par * 49152); par ^= 1;
#pragma unroll
        for (int br = 0; br < NBR; ++br) {
            const bf16_t* ap = A + (size_t)fr * lda + br * K + wid * kw + fq * 8;
            const bf16_t* blo = Bt + (size_t)(pn * 256 + q * 16 + fr) * ldb + br * K + wid * kw + fq * 8;
            const bf16_t* bhi = blo + (size_t)128 * ldb;
            f32x4 alo = {0.f, 0.f, 0.f, 0.f}, ahi = {0.f, 0.f, 0.f, 0.f};
#pragma unroll 1
            for (int k0 = 0; k0 < kw; k0 += 256) {
                bf16x8 a[8], b0[8], b1[8];
#pragma unroll
                for (int j = 0; j < 8; ++j) if (k0 + 32 * j < kw) { a[j] = *(const bf16x8*)(ap + k0 + 32 * j); b0[j] = *(const bf16x8*)(blo + k0 + 32 * j); b1[j] = *(const bf16x8*)(bhi + k0 + 32 * j); }
#pragma unroll
                for (int j = 0; j < 8; ++j) if (k0 + 32 * j < kw) { alo = __builtin_amdgcn_mfma_f32_16x16x32_bf16(b0[j], a[j], alo, 0, 0, 0); ahi = __builtin_amdgcn_mfma_f32_16x16x32_bf16(b1[j], a[j], ahi, 0, 0, 0); }
            }
            red[((wid * 64 + lane) * NBR + br) * 2] = alo; red[((wid * 64 + lane) * NBR + br) * 2 + 1] = ahi;
        }
        __syncthreads();
        if (wid == 0) {
            f32x4 tlo[NBR], thi[NBR];
#pragma unroll
            for (int br = 0; br < NBR; ++br) { tlo[br] = (f32x4){0.f, 0.f, 0.f, 0.f}; thi[br] = (f32x4){0.f, 0.f, 0.f, 0.f};
#pragma unroll
                for (int w = 0; w < 8; ++w) { tlo[br] += red[((w * 64 + lane) * NBR + br) * 2]; thi[br] += red[((w * 64 + lane) * NBR + br) * 2 + 1]; } }
            if constexpr (NBR == 1) E(tag0, MREAL + fr, pn, q * 16 + 4 * fq, tlo[0], thi[0]);
            else E.gated3(MREAL + fr, pn, q * 16 + 4 * fq, tlo, thi);
        }
    }
    __syncthreads();
}

__device__ __forceinline__ int perm_col(int kind, int n) {
    if (kind == 0) {
        if (n < 1024) return n;
        if (n < 1280) { const int j = n - 1024; return j < 64 ? 1024 + j : (j < 72 ? 7232 + (j - 64) : -1); }
        if (n < PC_FQ) return 1088 + (n - 1280);
        if (n < PC_GATE) return 4160 + (n - PC_FQ);
        return 7240 + (n - PC_GATE);
    }
    if (kind == 1) {
        const int h = n / HQK, j = n - h * HQK; if (j < 128) return n; const int p = j - 128; return h * HQK + 128 + (p >> 1) + 32 * (p & 1);
    }
    if (kind == 2) {
        const int tl = n >> 8, j = n & 255; return j < 128 ? tl * 128 + j : DFF + tl * 128 + (j - 128);
    }
    return n;
}
__device__ __forceinline__ void transpose_item(const float* W, int Nsrc, bf16_t* WT, int ldd, int koff, int kind, LAS float* scr, int kb, int nb, int lane) {
    const int k0 = 64 * kb, n0 = 32 * nb; const int sc = perm_col(kind, n0 + (lane & 31));
#pragma unroll 8
    for (int i = 0; i < 32; ++i) { const int kk = 2 * i + (lane >> 5); scr[kk * 33 + (lane & 31)] = sc >= 0 ? W[(size_t)(k0 + kk) * Nsrc + sc] : 0.f; }
    LDS_WAIT(); asm volatile("" ::: "memory");
    const int c = lane & 7;
#pragma unroll
    for (int j = 0; j < 4; ++j) { const int n = (lane >> 3) + 8 * j; const LAS float* s = scr + (8 * c) * 33 + n;
        u32x4 o; o.x = cvtpk(s[0 * 33], s[1 * 33]); o.y = cvtpk(s[2 * 33], s[3 * 33]); o.z = cvtpk(s[4 * 33], s[5 * 33]); o.w = cvtpk(s[6 * 33], s[7 * 33]);
        *(u32x4*)(WT + (size_t)(n0 + n) * ldd + koff + k0 + 8 * c) = o; }
    LDS_WAIT(); asm volatile("" ::: "memory");
}
__device__ __forceinline__ void transpose_item64(const float* W, int Nsrc, bf16_t* WT, int ldd, int koff, int kind, LAS float* scr, int kb, int nb, int lane) {
    const int k0 = 64 * kb, n0 = 64 * nb, n4 = (lane & 15) * 4; const int sc = perm_col(kind, n0 + n4);
#pragma unroll 8
    for (int i = 0; i < 16; ++i) { const int kk = 4 * i + (lane >> 4);
        const f32x4 v = sc >= 0 ? *(const f32x4*)(W + (size_t)(k0 + kk) * Nsrc + sc) : (f32x4){0.f, 0.f, 0.f, 0.f};
        LAS float* d = scr + kk * 65 + n4; d[0] = v[0]; d[1] = v[1]; d[2] = v[2]; d[3] = v[3]; }
    LDS_WAIT(); asm volatile("" ::: "memory");
    const int c = lane & 7;
#pragma unroll
    for (int j = 0; j < 8; ++j) { const int n = (lane >> 3) + 8 * j; const LAS float* s = scr + (8 * c) * 65 + n;
        u32x4 o; o.x = cvtpk(s[0 * 65], s[1 * 65]); o.y = cvtpk(s[2 * 65], s[3 * 65]); o.z = cvtpk(s[4 * 65], s[5 * 65]); o.w = cvtpk(s[6 * 65], s[7 * 65]);
        *(u32x4*)(WT + (size_t)(n0 + n) * ldd + koff + k0 + 8 * c) = o; }
    LDS_WAIT(); asm volatile("" ::: "memory");
}
struct Ins { const float *x, *meta, *w_in, *b_forget, *g_q, *g_kv, *w_uq, *w_ukv, *conv_w, *w_branch, *w_out, *w_f1, *w_f2, *g_mix_pre, *g_mix_post, *g_ffn_pre, *g_ffn_post; };

__device__ __forceinline__ void sincos_d(double x, float& c, float& s) {
    const double k = __builtin_rint(x * 0.63661977236758134308);
    const double r = (x - k * 1.57079632679489655800e+00) - k * 6.12323399573676603587e-17;
    const double r2 = r * r;
    double sp = -1.0 / 1307674368000.0; sp = sp * r2 + 1.0 / 6227020800.0; sp = sp * r2 - 1.0 / 39916800.0; sp = sp * r2 + 1.0 / 362880.0; sp = sp * r2 - 1.0 / 5040.0; sp = sp * r2 + 1.0 / 120.0; sp = sp * r2 - 1.0 / 6.0; sp = sp * r2 + 1.0; sp *= r;
    double cp = 1.0 / 20922789888000.0; cp = cp * r2 - 1.0 / 87178291200.0; cp = cp * r2 + 1.0 / 479001600.0; cp = cp * r2 - 1.0 / 3628800.0; cp = cp * r2 + 1.0 / 40320.0; cp = cp * r2 - 1.0 / 720.0; cp = cp * r2 + 1.0 / 24.0; cp = cp * r2 - 0.5; cp = cp * r2 + 1.0;
    const int qd = (int)((long long)k & 3);
    const double cc = (qd == 0) ? cp : (qd == 1) ? -sp : (qd == 2) ? -cp : sp;
    const double ss = (qd == 0) ? sp : (qd == 1) ? cp : (qd == 2) ? -sp : -cp;
    c = (float)cc; s = (float)ss;
}

constexpr int IT_W1 = 32 * (N1 / 64), IT_WUQ = 8 * 48, IT_WUKV = 8 * 32, IT_WBR = 16 * 32, IT_WOUT = 32 * 32, IT_WF1 = 32 * (2 * DFF / 64), IT_WF2 = (DFF / 64) * 32;
constexpr int IT_LAYER = IT_W1 + IT_WUQ + IT_WUKV + 3 * IT_WBR + IT_WOUT + IT_WF1 + IT_WF2;

struct TItem { const float* src; bf16_t* dst; int nsrc, ldd; };
__device__ __forceinline__ TItem titem(const float* W, int Nsrc, bf16_t* WT, int ldd, int koff, int kind, int kb, int nb, int lane) {
    const int k0 = 64 * kb, n0 = 64 * nb, n4 = (lane & 15) * 4; const int sc = perm_col(kind, n0 + n4);
    TItem t; t.src = sc >= 0 ? W + (size_t)(k0 + (lane >> 4)) * Nsrc + sc : nullptr; t.dst = WT + (size_t)(n0 + (lane >> 3)) * ldd + koff + k0 + 8 * (lane & 7); t.nsrc = Nsrc; t.ldd = ldd; return t;
}
__device__ __forceinline__ TItem p0_decode(const Ins& in, unsigned char* ws, int it, int lane) {
    constexpr int ITL = IT_LAYER - IT_WUQ;
    const int l = it / ITL; int r = it - l * ITL;
    unsigned char* wl = ws + WS_W + (size_t)l * W_LAYER;
    if (r < IT_W1) { const int nbk = N1 / 64; return titem(in.w_in + (size_t)l * DM * DIN, DIN, (bf16_t*)(wl + WO_W1), DM, 0, 0, r / nbk, r % nbk, lane); } r -= IT_W1;
    if (r < IT_WUKV) return titem(in.w_ukv + (size_t)l * 512 * 2048, 2048, (bf16_t*)(wl + WO_WUKV), 512, 0, 3, r / 32, r % 32, lane); r -= IT_WUKV;
    if (r < 3 * IT_WBR) { const int br = r / IT_WBR; r -= br * IT_WBR; return titem(in.w_branch + ((size_t)l * 3 + br) * 1024 * DM, DM, (bf16_t*)(wl + WO_WBR), 3072, br * 1024, 3, r / 32, r % 32, lane); } r -= 3 * IT_WBR;
    if (r < IT_WOUT) return titem(in.w_out + (size_t)l * DM * DM, DM, (bf16_t*)(wl + WO_WOUT), DM, 0, 3, r / 32, r % 32, lane); r -= IT_WOUT;
    if (r < IT_WF1) { const int nbk = 2 * DFF / 64; return titem(in.w_f1 + (size_t)l * DM * 2 * DFF, 2 * DFF, (bf16_t*)(wl + WO_WF1), DM, 0, 2, r / nbk, r % nbk, lane); } r -= IT_WF1;
    return titem(in.w_f2 + (size_t)l * DFF * DM, DM, (bf16_t*)(wl + WO_WF2), DFF, 0, 3, r / 32, r % 32, lane);
}
__device__ __forceinline__ void titem_load(const TItem& t, f32x4 (&v)[16]) {
#pragma unroll
    for (int i = 0; i < 16; ++i) v[i] = t.src ? *(const f32x4*)(t.src + (size_t)(4 * i) * t.nsrc) : (f32x4){0.f, 0.f, 0.f, 0.f};
}
__device__ __forceinline__ void p0_weights(const Ins& in, unsigned char* ws, LAS unsigned char* lds, int gw, int NGW, int wave, int lane) {
    LAS float* scr = (LAS float*)(lds + wave * 16640);
    constexpr int NIT = DEPTH * (IT_LAYER - IT_WUQ);
    if (gw < NIT) {
        TItem cur = p0_decode(in, ws, gw, lane); f32x4 vc[16]; titem_load(cur, vc);
#pragma unroll 1
        for (int it = gw; it < NIT; it += NGW) {
            const int itn = it + NGW < NIT ? it + NGW : it;
            const TItem nxt = p0_decode(in, ws, itn, lane); f32x4 vn[16]; titem_load(nxt, vn);
            const int n4 = (lane & 15) * 4;
#pragma unroll
            for (int i = 0; i < 16; ++i) { LAS float* d = scr + (4 * i + (lane >> 4)) * 65 + n4; d[0] = vc[i][0]; d[1] = vc[i][1]; d[2] = vc[i][2]; d[3] = vc[i][3]; }
            LDS_WAIT(); asm volatile("" ::: "memory");
            const int c = lane & 7;
#pragma unroll
            for (int j = 0; j < 8; ++j) { const LAS float* s = scr + (8 * c) * 65 + (lane >> 3) + 8 * j;
                u32x4 o; o.x = cvtpk(s[0 * 65], s[1 * 65]); o.y = cvtpk(s[2 * 65], s[3 * 65]); o.z = cvtpk(s[4 * 65], s[5 * 65]); o.w = cvtpk(s[6 * 65], s[7 * 65]);
                *(u32x4*)(cur.dst + (size_t)(8 * j) * cur.ldd) = o; }
            LDS_WAIT(); asm volatile("" ::: "memory");
            cur = nxt;
#pragma unroll
            for (int i = 0; i < 16; ++i) vc[i] = vn[i];
        }
    }
#pragma unroll 1
    for (int it = gw; it < DEPTH * IT_WUQ; it += NGW) { const int l = it / IT_WUQ, r = it - l * IT_WUQ;
        transpose_item(in.w_uq + (size_t)l * 512 * 1536, 1536, (bf16_t*)(ws + WS_W + (size_t)l * W_LAYER + WO_WUQ), 512, 0, 1, scr, r / 48, r % 48, lane); }
}
__device__ __forceinline__ void p0_rope(float* rope, int gtid, int ngt) {
    for (int idx = gtid; idx < LSEQ * 32; idx += ngt) {
        const int t = idx >> 5, i = idx & 31;
        double pwd = 1.0; for (int e = 0; e < i; ++e) pwd *= 1.3335214321633240;
        const float pw = (float)pwd;
        const float inv = 1.0f / pw;
        const float ang = (float)t * inv;
        float c, s; sincos_d((double)ang, c, s);
        rope[idx * 2] = c; rope[idx * 2 + 1] = s;
    }
}

struct TRow { f32x4 m[8]; f32x4 h[8]; };
__device__ __forceinline__ void t_load(TRow& R, int mode, int r, const Ins& in, const float* H, const float* MIX, int lane) {
    if (mode == 0) {
        const float* src = r < MREAL ? in.x + (size_t)r * DM : in.meta + (size_t)(r - MREAL) * DM;
#pragma unroll
        for (int j = 0; j < 8; ++j) R.h[j] = *(const f32x4*)(src + 256 * j + 4 * lane);
    } else {
#pragma unroll
        for (int j = 0; j < 8; ++j) { R.m[j] = *(const f32x4*)(MIX + (size_t)r * DM + 256 * j + 4 * lane); R.h[j] = *(const f32x4*)(H + (size_t)r * DM + 256 * j + 4 * lane); }
    }
}
__device__ __forceinline__ void t_norm(int mode, bool last, const Ins& in, const float* H, float* Hout, const float* MIX, bf16_t* HB, float* RSTD, float* out, const float* gpost, const float* gpre, int gw, int NGW, int lane) {
    asm volatile("" : "+v"(lane));
    if (gw >= MTOK) return;
    TRow cur; t_load(cur, mode, gw, in, H, MIX, lane);
#pragma unroll 1
    for (int r = gw; r < MTOK; r += NGW) {
        TRow nxt; const int rn = r + NGW < MTOK ? r + NGW : r;
        t_load(nxt, mode, rn, in, H, MIX, lane);
        f32x4 v[8];
        if (mode == 0) {
#pragma unroll
            for (int j = 0; j < 8; ++j) v[j] = cur.h[j];
        } else {
            float ss = 0.f;
#pragma unroll
            for (int j = 0; j < 8; ++j) ss += (cur.m[j][0] * cur.m[j][0] + cur.m[j][1] * cur.m[j][1]) + (cur.m[j][2] * cur.m[j][2] + cur.m[j][3] * cur.m[j][3]);
            const float rstd = 1.0f / sqrtf(wave_sum(ss) * (1.0f / DM) + EPS);
#pragma unroll
            for (int j = 0; j < 8; ++j) { const f32x4 g = *(const f32x4*)(gpost + 256 * j + 4 * lane); v[j] = cur.h[j] + (cur.m[j] * rstd) * g; }
        }
        if (last) {
            if (r < MREAL) {
#pragma unroll
                for (int j = 0; j < 8; ++j) *(f32x4*)(out + (size_t)r * DM + 256 * j + 4 * lane) = v[j];
            }
        } else {
            float ss = 0.f;
#pragma unroll
            for (int j = 0; j < 8; ++j) { if (mode != 0) *(f32x4*)(Hout + (size_t)r * DM + 256 * j + 4 * lane) = v[j];
                const f32x4 g = *(const f32x4*)(gpre + 256 * j + 4 * lane); st_bf4(HB + (size_t)r * DM + 256 * j + 4 * lane, v[j] * g);
                ss += (v[j][0] * v[j][0] + v[j][1] * v[j][1]) + (v[j][2] * v[j][2] + v[j][3] * v[j][3]); }
            if (mode == 0) {
#pragma unroll
                for (int j = 0; j < 8; ++j) *(f32x4*)(Hout + (size_t)r * DM + 256 * j + 4 * lane) = v[j];
            }
            const float rstd = 1.0f / sqrtf(wave_sum(ss) * (1.0f / DM) + EPS);
            if (lane == 0) RSTD[r] = rstd;
        }
        cur = nxt;
    }
}

__device__ __forceinline__ void t1_phase(int l, const Ins& in, const bf16_t* PROJ, const float* MISC, bf16_t* CQN, bf16_t* CKVN, bf16_t* KA, bf16_t* OCAT, float* CB, const float* rope, LAS float* scr, int gw, int NGW, int lane) {
    asm volatile("" : "+v"(lane));
    if (gw < 32) {
        const int b = gw >> 3, h = gw & 7; const float bias = in.b_forget[l * NH + h];
        {
            float x[33];
#pragma unroll
            for (int c = 0; c < 33; ++c) { const int t = c * 64 + lane; x[c] = t < LSEQ ? MISC[(size_t)row_of(b, t) * 128 + 64 + h] + bias : 0.f; }
#pragma unroll
            for (int c = 0; c < 33; ++c) scr[c * 64 + lane] = x[c];
        }
        LDS_WAIT(); asm volatile("" ::: "memory");
        float carry = 0.f;
#pragma unroll 1
        for (int c = 0; c < 33; ++c) { const int t = c * 64 + lane; const float xv = scr[c * 64 + lane];
            float lf = fminf(xv, 0.f) - log1pf(expf(-fabsf(xv))); if (t >= LSEQ) lf = 0.f;
#pragma unroll
            for (int o = 1; o < 64; o <<= 1) { const float y = __shfl_up(lf, o); if (lane >= o) lf += y; }
            lf += carry; carry = __shfl(lf, 63);
            if (t < LSEQ) CB[gw * CBLD + t] = lf; }
    }
    const float* gq = in.g_q + l * 512; const float* gkv = in.g_kv + l * 512; const float* cw = in.conv_w + (size_t)l * 3 * 1024;
#pragma unroll 1
    for (int r = gw; r < MTOK; r += NGW) {
        {
            const int half = lane >> 5, c0 = (lane & 31) * 16;
            const bf16_t* src = PROJ + (size_t)r * N1 + half * 512 + c0;
            const u32x4 a = *(const u32x4*)src, b = *(const u32x4*)(src + 8);
            float v[16] = {bflo(a.x), bfhi(a.x), bflo(a.y), bfhi(a.y), bflo(a.z), bfhi(a.z), bflo(a.w), bfhi(a.w), bflo(b.x), bfhi(b.x), bflo(b.y), bfhi(b.y), bflo(b.z), bfhi(b.z), bflo(b.w), bfhi(b.w)};
            float ss = 0.f;
#pragma unroll
            for (int e = 0; e < 16; ++e) ss += v[e] * v[e];
#pragma unroll
            for (int o = 1; o < 32; o <<= 1) ss += __shfl_xor(ss, o);
            const float rstd = 1.0f / sqrtf(ss * (1.0f / 512.0f) + EPS);
            const float* g = (half ? gkv : gq) + c0;
            u32x4 o0, o1;
            o0.x = cvtpk(v[0] * rstd * g[0], v[1] * rstd * g[1]); o0.y = cvtpk(v[2] * rstd * g[2], v[3] * rstd * g[3]); o0.z = cvtpk(v[4] * rstd * g[4], v[5] * rstd * g[5]); o0.w = cvtpk(v[6] * rstd * g[6], v[7] * rstd * g[7]);
            o1.x = cvtpk(v[8] * rstd * g[8], v[9] * rstd * g[9]); o1.y = cvtpk(v[10] * rstd * g[10], v[11] * rstd * g[11]); o1.z = cvtpk(v[12] * rstd * g[12], v[13] * rstd * g[13]); o1.w = cvtpk(v[14] * rstd * g[14], v[15] * rstd * g[15]);
            bf16_t* dst = (half ? CKVN : CQN) + (size_t)r * 512 + c0;
            *(u32x4*)dst = o0; *(u32x4*)(dst + 8) = o1;
        }
        const int t = t_of(r), b = r < MREAL ? (r >> 11) : 0;
        if (lane < 32) {
            const float x1 = MISC[(size_t)r * 128 + lane], x2 = MISC[(size_t)r * 128 + 32 + lane];
            const f32x2 cs = *(const f32x2*)(rope + ((size_t)t * 32 + lane) * 2);
            const unsigned w = cvtpk(x1 * cs[0] - x2 * cs[1], x1 * cs[1] + x2 * cs[0]);
#pragma unroll
            for (int h = 0; h < NH; ++h) *(unsigned*)(KA + (size_t)r * 1536 + h * HQK + 128 + 2 * lane) = w;
        }
        {
            const int c0 = lane * 16; float acc[16];
#pragma unroll
            for (int e = 0; e < 16; ++e) acc[e] = 0.f;
#pragma unroll
            for (int kk = 0; kk < 3; ++kk) {
                const int tt = t - 2 + kk; if (tt < 0) continue;
                const size_t rr = (size_t)row_of(b, tt);
                const u32x4 c0v = *(const u32x4*)(PROJ + rr * N1 + PC_CONVC + c0), c1v = *(const u32x4*)(PROJ + rr * N1 + PC_CONVC + c0 + 8);
                const u32x4 x0v = *(const u32x4*)(PROJ + rr * N1 + PC_CONVX + c0), x1v = *(const u32x4*)(PROJ + rr * N1 + PC_CONVX + c0 + 8);
                const float* w = cw + kk * 1024 + c0;
                const unsigned cc[8] = {c0v.x, c0v.y, c0v.z, c0v.w, c1v.x, c1v.y, c1v.z, c1v.w}; const unsigned xx[8] = {x0v.x, x0v.y, x0v.z, x0v.w, x1v.x, x1v.y, x1v.z, x1v.w};
#pragma unroll
                for (int e = 0; e < 8; ++e) { acc[2 * e] += w[2 * e] * (bflo(cc[e]) * bflo(xx[e])); acc[2 * e + 1] += w[2 * e + 1] * (bfhi(cc[e]) * bfhi(xx[e])); }
            }
            const u32x4 b0v = *(const u32x4*)(PROJ + (size_t)r * N1 + PC_CONVB + c0), b1v = *(const u32x4*)(PROJ + (size_t)r * N1 + PC_CONVB + c0 + 8);
            const unsigned bb[8] = {b0v.x, b0v.y, b0v.z, b0v.w, b1v.x, b1v.y, b1v.z, b1v.w};
            unsigned o[8];
#pragma unroll
            for (int e = 0; e < 8; ++e) o[e] = cvtpk(bflo(bb[e]) * acc[2 * e], bfhi(bb[e]) * acc[2 * e + 1]);
            bf16_t* dst = OCAT + (size_t)r * 3072 + 1024 + c0;
            *(u32x4*)dst = (u32x4){o[0], o[1], o[2], o[3]}; *(u32x4*)(dst + 8) = (u32x4){o[4], o[5], o[6], o[7]};
        }
    }
}

__device__ __forceinline__ void attn_naive(LAS unsigned char* lds, const bf16_t* PROJ, const bf16_t* QA, const bf16_t* KA, const bf16_t* VA, const float* CB, bf16_t* OCAT, int tmax, int nb, int gw, int NGW, int wave, int lane) {
    asm volatile("" : "+v"(lane));
    LAS float* sc = (LAS float*)lds + wave * 2304; LAS float* qs = sc + 2112;
#pragma unroll 1
    for (int it = gw; it < 2 * nb * NH * tmax; it += NGW) {
        const int t = it % tmax; const int r_ = it / tmax; const int h = r_ & 7, b = (r_ >> 3) % nb, ty = (r_ >> 3) / nb;
        const int row = row_of(b, t); const int dk = ty ? 128 : HQK;
        const bf16_t* qp = ty ? PROJ + (size_t)row * N1 + PC_FQ + h * 128 : QA + (size_t)row * 1536 + h * HQK;
        const bf16_t* kbase = ty ? PROJ + PC_FK + h * 128 : KA + h * HQK; const int ldk = ty ? N1 : 1536;
        const bf16_t* vbase = ty ? PROJ + PC_FV + h * 128 : VA + h * 128; const int ldv = ty ? N1 : 1024;
        const float scale = ty ? 0.08838834764831845f : 0.07216878364870323f;
        const float* cb = CB + (b * NH + h) * CBLD;
        for (int d = lane; d < dk; d += 64) qs[d] = bf2f(qp[d]);
        LDS_WAIT(); asm volatile("" ::: "memory");
        const float ct = ty ? cb[t] : 0.f;
        float mx = -1e30f;
#pragma unroll 1
        for (int s = lane; s <= t; s += 64) {
            const bf16_t* kp = kbase + (size_t)row_of(b, s) * ldk; float dot = 0.f;
#pragma unroll 4
            for (int d8 = 0; d8 < dk; d8 += 8) { const u32x4 kv = *(const u32x4*)(kp + d8);
                dot += qs[d8] * bflo(kv.x) + qs[d8 + 1] * bfhi(kv.x) + qs[d8 + 2] * bflo(kv.y) + qs[d8 + 3] * bfhi(kv.y) + qs[d8 + 4] * bflo(kv.z) + qs[d8 + 5] * bfhi(kv.z) + qs[d8 + 6] * bflo(kv.w) + qs[d8 + 7] * bfhi(kv.w); }
            float v = dot * scale; if (ty) v += ct - cb[s];
            sc[s] = v; mx = fmaxf(mx, v);
        }
        mx = wave_max(mx);
        float sum = 0.f;
        for (int s = lane; s <= t; s += 64) { const float p = __expf(sc[s] - mx); sc[s] = p; sum += p; }
        sum = wave_sum(sum);
        LDS_WAIT(); asm volatile("" ::: "memory");
        float a0 = 0.f, a1 = 0.f;
#pragma unroll 4
        for (int s = 0; s <= t; ++s) { const float p = sc[s]; const unsigned w = *(const unsigned*)(vbase + (size_t)row_of(b, s) * ldv + 2 * lane); a0 += p * bflo(w); a1 += p * bfhi(w); }
        const float inv = 1.0f / sum;
        *(unsigned*)(OCAT + (size_t)row * 3072 + (ty ? 2048 : 0) + h * 128 + 2 * lane) = cvtpk(a0 * inv, a1 * inv);
        LDS_WAIT(); asm volatile("" ::: "memory");
    }
}

namespace fa {
constexpr int NW = 8, QBLK = 32, KVBLK = 64, QB = NW * QBLK, DV = 128;
constexpr int SHM_V = KVBLK * DV * 2;
typedef short s16x4 __attribute__((ext_vector_type(4)));
typedef float f32x16 __attribute__((ext_vector_type(16)));
#define FA_SBAR() __builtin_amdgcn_sched_barrier(0)
__device__ __forceinline__ int v_st(int k, int c) { const int kk = (k & ~0xC) | ((k & 4) << 1) | ((k & 8) >> 1); return ((kk >> 3) * 4 + (c >> 5)) * 512 + ((kk & 7) * 32 + (c & 31)) * 2; }
__device__ __forceinline__ int v_rd_base(int lane) { return ((lane & 3) << 3) | (((lane >> 2) & 3) << 6) | (((lane >> 4) & 1) << 5) | (((lane >> 5) & 1) << 8); }
constexpr int v_rd_off(int d0, int ks, int half) { return d0 * 512 + ks * 4096 + half * 2048; }
__device__ __forceinline__ int crow(int r, int hi) { return (r & 3) + 8 * (r >> 2) + 4 * hi; }
__device__ __forceinline__ unsigned cvtpk_a(float lo, float hi) { unsigned r; asm volatile("v_cvt_pk_bf16_f32 %0, %1, %2" : "=v"(r) : "v"(lo), "v"(hi)); return r; }
__device__ __forceinline__ void mask_tile(f32x16& p0, f32x16& p1, int dq) {
    const float NEG = -__builtin_inff();
#pragma unroll
    for (int r = 0; r < 16; ++r) { const int c = (r & 3) + 8 * (r >> 2); if (dq - c < 0) p0[r] = NEG; if (dq - c - 32 < 0) p1[r] = NEG; }
}
__device__ __forceinline__ void mask_meta(f32x16& p0, f32x16& p1) {
    const float NEG = -__builtin_inff();
#pragma unroll
    for (int r = 8; r < 16; ++r) p0[r] = NEG;
#pragma unroll
    for (int r = 0; r < 16; ++r) p1[r] = NEG;
}
__device__ __forceinline__ void partialSM(f32x16& p0, f32x16& p1, float& m_reg, float& mn, float& alpha, const float SCALE) {
    float pmax = p0[0];
#pragma unroll
    for (int r = 1; r < 16; ++r) pmax = fmaxf(pmax, p0[r]);
#pragma unroll
    for (int r = 0; r < 16; ++r) pmax = fmaxf(pmax, p1[r]);
    { auto rr = __builtin_amdgcn_permlane32_swap(__float_as_uint(pmax), __float_as_uint(pmax), false, false); pmax = fmaxf(__uint_as_float(rr[0]), __uint_as_float(rr[1])); }
    const float C2 = 1.4426950408889634f * SCALE;
    if (__builtin_expect(__all((pmax - m_reg) * SCALE <= 8.f), 1)) { mn = m_reg; alpha = 1.f; }
    else { mn = fmaxf(m_reg, pmax); alpha = __builtin_amdgcn_exp2f((m_reg - mn) * C2); m_reg = mn; }
    const float mnL = -mn * C2;
#pragma unroll
    for (int r = 0; r < 16; ++r) p0[r] = fmaf(p0[r], C2, mnL);
#pragma unroll
    for (int r = 0; r < 16; ++r) p1[r] = fmaf(p1[r], C2, mnL);
#pragma unroll
    for (int r = 0; r < 16; ++r) p0[r] = __builtin_amdgcn_exp2f(p0[r]);
}
__device__ __forceinline__ void finishSM(f32x16& p0, f32x16& p1, float alpha, float& l_reg, bf16x8& pa0, bf16x8& pa1, bf16x8& pa2, bf16x8& pa3) {
#pragma unroll
    for (int r = 0; r < 16; ++r) p1[r] = __builtin_amdgcn_exp2f(p1[r]);
    float ps = 0;
#pragma unroll
    for (int r = 0; r < 16; ++r) ps += p0[r];
#pragma unroll
    for (int r = 0; r < 16; ++r) ps += p1[r];
    { auto rr = __builtin_amdgcn_permlane32_swap(__float_as_uint(ps), __float_as_uint(ps), false, false); ps = __uint_as_float(rr[0]) + __uint_as_float(rr[1]); }
    l_reg = l_reg * alpha + ps;
#define FA_PK4(P, B_, OUT) do { unsigned a0 = cvtpk_a(P[B_+0], P[B_+1]), a1 = cvtpk_a(P[B_+2], P[B_+3]); unsigned b0 = cvtpk_a(P[B_+4], P[B_+5]), b1 = cvtpk_a(P[B_+6], P[B_+7]); \
        auto r0 = __builtin_amdgcn_permlane32_swap(a0, b0, false, false); auto r1 = __builtin_amdgcn_permlane32_swap(a1, b1, false, false); \
        u32x4 w = {r0[0], r1[0], r0[1], r1[1]}; OUT = *reinterpret_cast<bf16x8*>(&w); } while (0)
    FA_PK4(p0, 0, pa0); FA_PK4(p0, 8, pa1); FA_PK4(p1, 0, pa2); FA_PK4(p1, 8, pa3);
#undef FA_PK4
}
template <int DK> __device__ __forceinline__ int kswz(int row, int colB) { return row * (2 * DK) + (colB ^ ((row & 7) << 4)); }
template <int DK, int KB, bool BIAS>
__device__ __forceinline__ void qkt(f32x16& p0, f32x16& p1, const char* K_lds, const float* bias_lds, int r32, int hi, const bf16x8* qr) {
    constexpr int SHM_K = KVBLK * DK * 2;
    if constexpr (BIAS) {
        const float* bp = bias_lds + KB * 64 + 4 * hi;
#pragma unroll
        for (int g = 0; g < 4; ++g) { const f32x4 a = *(const f32x4*)(bp + 8 * g), b = *(const f32x4*)(bp + 32 + 8 * g);
            p0[4 * g] = a[0]; p0[4 * g + 1] = a[1]; p0[4 * g + 2] = a[2]; p0[4 * g + 3] = a[3]; p1[4 * g] = b[0]; p1[4 * g + 1] = b[1]; p1[4 * g + 2] = b[2]; p1[4 * g + 3] = b[3]; }
    } else { p0 = f32x16{}; p1 = f32x16{}; }
    const char* kb[4];
#pragma unroll
    for (int dd = 0; dd < 4; ++dd) kb[dd] = K_lds + KB * SHM_K + kswz<DK>(r32, (dd * 16 + hi * 8) * 2);
#pragma unroll
    for (int d0 = 0; d0 < DK / 16; ++d0) { const char* a = kb[d0 & 3] + (d0 >> 2) * 128;
        bf16x8 b0 = *reinterpret_cast<const bf16x8*>(a);
        bf16x8 b1 = *reinterpret_cast<const bf16x8*>(a + 32 * 2 * DK);
        p0 = __builtin_amdgcn_mfma_f32_32x32x16_bf16(b0, qr[d0], p0, 0, 0, 0);
        p1 = __builtin_amdgcn_mfma_f32_32x32x16_bf16(b1, qr[d0], p1, 0, 0, 0); }
}
template <int VB>
__device__ __forceinline__ void pv_tile(f32x16* o, int vb0, bf16x8 pa0, bf16x8 pa1, bf16x8 pa2, bf16x8 pa3) {
#define FA_TRRD(dst, off) asm volatile("ds_read_b64_tr_b16 %0, %1 offset:%2" : "=&v"(dst) : "v"(vb0), "i"(off) : "memory")
#define FA_PV_D0(d0) do { s16x4 l0, l1, l2, l3, h0, h1, h2, h3; constexpr int b_ = VB * SHM_V + v_rd_off(d0, 0, 0); \
        FA_TRRD(l0, b_); FA_TRRD(h0, b_ + 2048); FA_TRRD(l1, b_ + 4096); FA_TRRD(h1, b_ + 6144); FA_TRRD(l2, b_ + 8192); FA_TRRD(h2, b_ + 10240); FA_TRRD(l3, b_ + 12288); FA_TRRD(h3, b_ + 14336); \
        asm volatile("s_waitcnt lgkmcnt(0)" ::: "memory"); FA_SBAR(); \
        o[d0] = __builtin_amdgcn_mfma_f32_32x32x16_bf16(pa0, (bf16x8){l0[0], l0[1], l0[2], l0[3], h0[0], h0[1], h0[2], h0[3]}, o[d0], 0, 0, 0); \
        o[d0] = __builtin_amdgcn_mfma_f32_32x32x16_bf16(pa1, (bf16x8){l1[0], l1[1], l1[2], l1[3], h1[0], h1[1], h1[2], h1[3]}, o[d0], 0, 0, 0); \
        o[d0] = __builtin_amdgcn_mfma_f32_32x32x16_bf16(pa2, (bf16x8){l2[0], l2[1], l2[2], l2[3], h2[0], h2[1], h2[2], h2[3]}, o[d0], 0, 0, 0); \
        o[d0] = __builtin_amdgcn_mfma_f32_32x32x16_bf16(pa3, (bf16x8){l3[0], l3[1], l3[2], l3[3], h3[0], h3[1], h3[2], h3[3]}, o[d0], 0, 0, 0); } while (0)
    FA_PV_D0(0); FA_PV_D0(1); FA_PV_D0(2); FA_PV_D0(3);
#undef FA_PV_D0
#undef FA_TRRD
}
struct Blk { const bf16_t* Q; const bf16_t* Kr; const bf16_t* Km; const bf16_t* Vr; const bf16_t* Vm; const float* cbr; const float* cbm; bf16_t* O; int P0; };
template <int DK> struct Seam { bf16x8 qr[DK / 16]; bf16x8 st_v0, st_v1; bf16x8 st_k[DK / 64]; float st_b; };
template <int DK> constexpr int lds_bytes() { return 2 * SHM_V + 2 * KVBLK * DK * 2 + NW * 64 * 4 + 2 * 64 * 4; }

#define FA_VMW() asm volatile("s_waitcnt vmcnt(0)" ::: "memory")
template <int DK, bool BIAS>
__device__ __forceinline__ void fa_load_tile(const Blk& B, int kb, int ldk, int ldv, int tid, Seam<DK>& S, const float BSC) {
    const bf16_t* Kp = kb == 0 ? B.Km : B.Kr; const bf16_t* Vp = kb == 0 ? B.Vm : B.Vr;
    const int sr = tid >> 4, sc = (tid & 15) * 8;
    S.st_v0 = *(const bf16x8*)(Vp + (size_t)(kb + sr) * ldv + sc); S.st_v1 = *(const bf16x8*)(Vp + (size_t)(kb + 32 + sr) * ldv + sc);
#pragma unroll
    for (int j = 0; j < DK / 64; ++j) { const int ci = tid + 512 * j, row = ci / (DK / 8), cc = ci % (DK / 8); S.st_k[j] = *(const bf16x8*)(Kp + (size_t)(kb + row) * ldk + cc * 8); }
    if constexpr (BIAS) { const float* cp = kb == 0 ? B.cbm : B.cbr; S.st_b = cp[kb + (tid & 63)] * BSC; }
}
template <int DK, bool BIAS>
__device__ __forceinline__ void fa_write_k(char* K_lds, float* bias_lds, int bf, int tid, const Seam<DK>& S) {
    constexpr int SHM_K = KVBLK * DK * 2;
#pragma unroll
    for (int j = 0; j < DK / 64; ++j) { const int ci = tid + 512 * j, row = ci / (DK / 8), cc = ci % (DK / 8); *(bf16x8*)(K_lds + bf * SHM_K + kswz<DK>(row, cc * 16)) = S.st_k[j]; }
    if constexpr (BIAS) { if (tid < 64) bias_lds[bf * 64 + tid] = S.st_b; }
}
template <int DK>
__device__ __forceinline__ void fa_write_v(char* V_lds, int bf, int tid, const Seam<DK>& S) {
    const int sr = tid >> 4, sc = (tid & 15) * 8;
    *(bf16x8*)(V_lds + bf * SHM_V + v_st(sr, sc)) = S.st_v0; *(bf16x8*)(V_lds + bf * SHM_V + v_st(32 + sr, sc)) = S.st_v1;
}
template <int DK, bool BIAS>
__device__ __forceinline__ void fa_prime(const int tid, const Blk& cur, int ldq, int ldk, int ldv, char* lds, Seam<DK>& S, const float BSC) {
    const int wid = __builtin_amdgcn_readfirstlane(tid >> 6), lane = tid & 63, r32 = lane & 31, hi = lane >> 5;
    constexpr int SHM_K = KVBLK * DK * 2;
    char* K_lds = lds + 2 * SHM_V; float* bias_lds = (float*)(lds + 2 * SHM_V + 2 * SHM_K + NW * 64 * 4);
#pragma unroll
    for (int d0 = 0; d0 < DK / 16; ++d0) S.qr[d0] = *(const bf16x8*)(cur.Q + (size_t)(wid * QBLK + r32) * ldq + d0 * 16 + hi * 8);
    fa_load_tile<DK, BIAS>(cur, 0, ldk, ldv, tid, S, BSC); FA_VMW(); fa_write_k<DK, BIAS>(K_lds, bias_lds, 0, tid, S);
    __syncthreads();
}
template <int DK, bool BIAS>
__device__ __forceinline__ void fa_block(const int tid, const Blk& cur, const Blk& nxt, int ldq, int ldk, int ldv, int ldo, char* lds, Seam<DK>& S, const float SCALE, const float BSC) {
    const int wid = __builtin_amdgcn_readfirstlane(tid >> 6), lane = tid & 63, r32 = lane & 31, hi = lane >> 5;
    constexpr int SHM_K = KVBLK * DK * 2;
    const int NT = (cur.P0 + QB - 1) / KVBLK + 1;
    const int qlo = cur.P0 + wid * QBLK, qm = qlo + r32 - 4 * hi;
    char* V_lds = lds; char* K_lds = lds + 2 * SHM_V;
    float* ws = (float*)(lds + 2 * SHM_V + 2 * SHM_K) + wid * 64; float* li_l = ws; float* al_l = ws + 32;
    float* bias_lds = (float*)(lds + 2 * SHM_V + 2 * SHM_K + NW * 64 * 4);
    float m_reg = -1e30f, l_reg = 0; f32x16 o[4] = {};
    const int vb0 = (int)(uintptr_t)V_lds + v_rd_base(lane);
#define FA_RESC(a) do { if (__any((a) < 1.f)) { if (hi == 0) al_l[r32] = (a); asm volatile("s_waitcnt lgkmcnt(0)" ::: "memory"); \
                     _Pragma("unroll") for (int d_ = 0; d_ < 4; ++d_) _Pragma("unroll") for (int r = 0; r < 16; ++r) o[d_][r] *= al_l[crow(r, hi)]; } } while (0)
#define FA_KBASE(t) ((t) * KVBLK)
#define FA_MASKT(P0_, P1_, t) do { const int kb_ = FA_KBASE(t); if (kb_ == 0) mask_meta(P0_, P1_); else if (kb_ + KVBLK - 1 > qlo) mask_tile(P0_, P1_, qm - kb_); } while (0)
    f32x16 pA0, pA1, pB0, pB1; float mnA, mnB, alA, alB; bf16x8 pa0, pa1, pa2, pa3;
    fa_write_v<DK>(V_lds, 0, tid, S); FA_SBAR();
    if (NT > 1) fa_load_tile<DK, BIAS>(cur, FA_KBASE(1), ldk, ldv, tid, S, BSC);
    FA_SBAR(); qkt<DK, 0, BIAS>(pA0, pA1, K_lds, bias_lds, r32, hi, S.qr);
    FA_MASKT(pA0, pA1, 0); partialSM(pA0, pA1, m_reg, mnA, alA, SCALE);
    if (NT > 1) { FA_VMW(); fa_write_v<DK>(V_lds, 1, tid, S); fa_write_k<DK, BIAS>(K_lds, bias_lds, 1, tid, S); }
    __syncthreads();
#define FA_HALF_STEP(PX0, PX1, mnX, alX, PY0, PY1, alY, t, KB, VB, SB) do { \
        FA_SBAR(); qkt<DK, KB, BIAS>(PX0, PX1, K_lds, bias_lds, r32, hi, S.qr); \
        finishSM(PY0, PY1, alY, l_reg, pa0, pa1, pa2, pa3); FA_SBAR(); \
        if ((t) + 1 < NT) { fa_load_tile<DK, BIAS>(cur, FA_KBASE((t) + 1), ldk, ldv, tid, S, BSC); FA_SBAR(); } \
        pv_tile<VB>(o, vb0, pa0, pa1, pa2, pa3); FA_MASKT(PX0, PX1, (t)); partialSM(PX0, PX1, m_reg, mnX, alX, SCALE); \
        __syncthreads(); \
        if ((t) + 1 < NT) { FA_VMW(); fa_write_v<DK>(V_lds, SB, tid, S); fa_write_k<DK, BIAS>(K_lds, bias_lds, SB, tid, S); } \
        FA_RESC(alX); __syncthreads(); } while (0)
    for (int t = 1; t + 1 < NT; t += 2) {
        FA_HALF_STEP(pB0, pB1, mnB, alB, pA0, pA1, alA, t, 1, 0, 0);
        FA_HALF_STEP(pA0, pA1, mnA, alA, pB0, pB1, alB, t + 1, 0, 1, 1);
    }
    const bool even = (NT & 1) == 0;
    if (even) { FA_SBAR(); qkt<DK, 1, BIAS>(pB0, pB1, K_lds, bias_lds, r32, hi, S.qr); FA_SBAR(); }
    fa_load_tile<DK, BIAS>(nxt, 0, ldk, ldv, tid, S, BSC); FA_SBAR();
#pragma unroll
    for (int d0 = 0; d0 < DK / 16; ++d0) S.qr[d0] = *(const bf16x8*)(nxt.Q + (size_t)(wid * QBLK + r32) * ldq + d0 * 16 + hi * 8);
    FA_SBAR();
    finishSM(pA0, pA1, alA, l_reg, pa0, pa1, pa2, pa3); FA_SBAR();
    pv_tile<0>(o, vb0, pa0, pa1, pa2, pa3);
    if (even) { FA_MASKT(pB0, pB1, NT - 1); partialSM(pB0, pB1, m_reg, mnB, alB, SCALE); __syncthreads(); FA_RESC(alB);
        finishSM(pB0, pB1, alB, l_reg, pa0, pa1, pa2, pa3); FA_SBAR(); pv_tile<1>(o, vb0, pa0, pa1, pa2, pa3); }
    FA_SBAR();
    asm volatile("s_waitcnt vmcnt(%0)" :: "i"(DK / 16) : "memory");
    fa_write_k<DK, BIAS>(K_lds, bias_lds, 0, tid, S); FA_SBAR();
    if (hi == 0) li_l[r32] = l_reg; asm volatile("s_waitcnt lgkmcnt(0)" ::: "memory");
    float rli[16];
#pragma unroll
    for (int r = 0; r < 16; ++r) rli[r] = __builtin_amdgcn_rcpf(li_l[crow(r, hi)]);
    bf16_t* Ow = cur.O + (size_t)(wid * QBLK) * ldo;
#pragma unroll
    for (int r = 0; r < 16; ++r) { const int orow = crow(r, hi);
#pragma unroll
        for (int d0 = 0; d0 < 4; ++d0) { const float v = o[d0][r] * rli[r]; const float vn = __shfl_xor(v, 1);
            if ((r32 & 1) == 0) *(unsigned*)(Ow + (size_t)orow * ldo + d0 * 32 + r32) = cvtpk_a(v, vn); } }
    __syncthreads();
#undef FA_RESC
#undef FA_KBASE
#undef FA_MASKT
#undef FA_HALF_STEP
}
template <int DK, bool BIAS>
__device__ __forceinline__ void fa_block_sb(const int tid, const Blk& cur, int ldk, int ldv, int ldo, char* lds, Seam<DK>& S, const float SCALE, const float BSC) {
    const int wid = __builtin_amdgcn_readfirstlane(tid >> 6), lane = tid & 63, r32 = lane & 31, hi = lane >> 5;
    constexpr int SHM_K = KVBLK * DK * 2;
    const int NT = (cur.P0 + QB - 1) / KVBLK + 1;
    const int qlo = cur.P0 + wid * QBLK, qm = qlo + r32 - 4 * hi;
    char* V_lds = lds; char* K_lds = lds + 2 * SHM_V;
    float* ws = (float*)(lds + 2 * SHM_V + 2 * SHM_K) + wid * 64; float* li_l = ws; float* al_l = ws + 32;
    float* bias_lds = (float*)(lds + 2 * SHM_V + 2 * SHM_K + NW * 64 * 4);
    float m_reg = -1e30f, l_reg = 0; f32x16 o[4] = {};
    const int vb0 = (int)(uintptr_t)V_lds + v_rd_base(lane);
    fa_write_v<DK>(V_lds, 0, tid, S);
    __syncthreads();
#define FA_STEP(t, KB) do { f32x16 p0, p1; float mn, al; bf16x8 pa0, pa1, pa2, pa3; \
        if ((t) + 1 < NT) { fa_load_tile<DK, BIAS>(cur, ((t) + 1) * KVBLK, ldk, ldv, tid, S, BSC); FA_SBAR(); } \
        qkt<DK, KB, BIAS>(p0, p1, K_lds, bias_lds, r32, hi, S.qr); \
        { const int kb_ = (t) * KVBLK; if (kb_ == 0) mask_meta(p0, p1); else if (kb_ + KVBLK - 1 > qlo) mask_tile(p0, p1, qm - kb_); } \
        partialSM(p0, p1, m_reg, mn, al, SCALE); \
        if (__any(al < 1.f)) { if (hi == 0) al_l[r32] = al; asm volatile("s_waitcnt lgkmcnt(0)" ::: "memory"); \
            _Pragma("unroll") for (int d_ = 0; d_ < 4; ++d_) _Pragma("unroll") for (int r = 0; r < 16; ++r) o[d_][r] *= al_l[crow(r, hi)]; } \
        finishSM(p0, p1, al, l_reg, pa0, pa1, pa2, pa3); FA_SBAR(); \
        pv_tile<KB>(o, vb0, pa0, pa1, pa2, pa3); \
        if ((t) + 1 < NT) { FA_VMW(); fa_write_v<DK>(V_lds, 1 - KB, tid, S); fa_write_k<DK, BIAS>(K_lds, bias_lds, 1 - KB, tid, S); } \
        __syncthreads(); } while (0)
    int t = 0;
    for (; t + 1 < NT; t += 2) { FA_STEP(t, 0); FA_STEP(t + 1, 1); }
    if (t < NT) FA_STEP(t, 0);
#undef FA_STEP
    if (hi == 0) li_l[r32] = l_reg; asm volatile("s_waitcnt lgkmcnt(0)" ::: "memory");
    float rli[16];
#pragma unroll
    for (int r = 0; r < 16; ++r) rli[r] = __builtin_amdgcn_rcpf(li_l[crow(r, hi)]);
    bf16_t* Ow = cur.O + (size_t)(wid * QBLK) * ldo;
#pragma unroll
    for (int r = 0; r < 16; ++r) { const int orow = crow(r, hi);
#pragma unroll
        for (int d0 = 0; d0 < 4; ++d0) { const float v = o[d0][r] * rli[r]; const float vn = __shfl_xor(v, 1);
            if ((r32 & 1) == 0) *(unsigned*)(Ow + (size_t)orow * ldo + d0 * 32 + r32) = cvtpk_a(v, vn); } }
    __syncthreads();
}
}

__device__ __forceinline__ void attn_fast(char* lds, const bf16_t* PROJ, const bf16_t* QA, const bf16_t* KA, const bf16_t* VA, const float* CB, bf16_t* OCAT, int vcu, int G) {
    for (int v = vcu; v < NBATCH * NH * 8; v += G) {
        const int bh = v >> 3, qb = v & 7, b = bh >> 3, h = bh & 7;
#ifndef FA_ONLY
#define FA_ONLY 3
#endif
        if (FA_ONLY & 1) {
            fa::Blk B; const size_t r0 = (size_t)b * SEQ + qb * 256, rm = (size_t)MREAL;
            B.Q = QA + r0 * 1536 + h * HQK; B.Kr = KA + ((size_t)b * SEQ) * 1536 + h * HQK - (size_t)64 * 1536; B.Km = KA + rm * 1536 + h * HQK;
            B.Vr = VA + ((size_t)b * SEQ) * 1024 + h * 128 - (size_t)64 * 1024; B.Vm = VA + rm * 1024 + h * 128; B.cbr = nullptr; B.cbm = nullptr;
            B.O = OCAT + r0 * 3072 + h * 128; B.P0 = 64 + qb * 256;
            int tl = threadIdx.x; asm volatile("" : "+v"(tl));
            fa::Seam<192> S; fa::fa_prime<192, false>(tl, B, 1536, 1536, 1024, lds, S, 0.f);
            fa::fa_block_sb<192, false>(tl, B, 1536, 1024, 3072, lds, S, 0.07216878364870323f, 0.f);
        }
        if (FA_ONLY & 2) {
            const int qf = 7 - qb; fa::Blk B; const size_t r0 = (size_t)b * SEQ + qf * 256, rm = (size_t)MREAL;
            B.Q = PROJ + r0 * N1 + PC_FQ + h * 128; B.Kr = PROJ + ((size_t)b * SEQ) * N1 + PC_FK + h * 128 - (size_t)64 * N1; B.Km = PROJ + rm * N1 + PC_FK + h * 128;
            B.Vr = PROJ + ((size_t)b * SEQ) * N1 + PC_FV + h * 128 - (size_t)64 * N1; B.Vm = PROJ + rm * N1 + PC_FV + h * 128;
            B.cbm = CB + bh * CBLD; B.cbr = CB + bh * CBLD - 48;
            B.O = OCAT + r0 * 3072 + 2048 + h * 128; B.P0 = 64 + qf * 256;
            int tl = threadIdx.x; asm volatile("" : "+v"(tl));
            fa::Seam<128> S; fa::fa_prime<128, true>(tl, B, N1, N1, N1, lds, S, -11.313708498984761f);
            fa::fa_block<128, true>(tl, B, B, N1, N1, N1, 3072, lds, S, 0.08838834764831845f, -11.313708498984761f);
        }
    }
}

struct Args { const float* in[17]; float* out; unsigned char* ws; int ph_lo, ph_hi; };
__global__ void __launch_bounds__(NTHREADS, 2) fwd(Args args) {
    extern __shared__ __attribute__((aligned(16))) unsigned char lds_raw[];
    LAS unsigned char* lds = (LAS unsigned char*)lds_raw;
    volatile LAS unsigned* MISCW = (volatile LAS unsigned*)(lds + MISC_OFF);
    const int tid = threadIdx.x, lane = tid & 63, wave = __builtin_amdgcn_readfirstlane(tid >> 6);
    const int G = gridDim.x, bid = blockIdx.x;
    const int gw = bid * NWAVES + wave, NGW = G * NWAVES;
    const int vcu = (G % 8 == 0) ? (bid % 8) * (G / 8) + bid / 8 : bid;
    unsigned char* ws = args.ws;
    Ins in; in.x = args.in[0]; in.meta = args.in[1]; in.w_in = args.in[2]; in.b_forget = args.in[3]; in.g_q = args.in[4]; in.g_kv = args.in[5]; in.w_uq = args.in[6]; in.w_ukv = args.in[7];
    in.conv_w = args.in[8]; in.w_branch = args.in[9]; in.w_out = args.in[10]; in.w_f1 = args.in[11]; in.w_f2 = args.in[12]; in.g_mix_pre = args.in[13]; in.g_mix_post = args.in[14]; in.g_ffn_pre = args.in[15]; in.g_ffn_post = args.in[16];
    float* H = (float*)(ws + WS_H); bf16_t* HN = (bf16_t*)(ws + WS_HN); bf16_t* PROJ = (bf16_t*)(ws + WS_PROJ); float* MISC = (float*)(ws + WS_MISC);
    bf16_t* CQN = (bf16_t*)(ws + WS_CQN); bf16_t* CKVN = (bf16_t*)(ws + WS_CKVN); bf16_t* QA = (bf16_t*)(ws + WS_QA); bf16_t* KA = (bf16_t*)(ws + WS_KA); bf16_t* VA = (bf16_t*)(ws + WS_VA);
    float* CB = (float*)(ws + WS_CB); bf16_t* OCAT = (bf16_t*)(ws + WS_OCAT); float* MIXF = (float*)(ws + WS_MIXF); bf16_t* MERGED = (bf16_t*)(ws + WS_MERGED); bf16_t* ACT = (bf16_t*)(ws + WS_ACT);
    float* ROPE = (float*)(ws + WS_ROPE); float* RSTD = (float*)(ws + WS_RSTD);

    for (int u = tid; u < (LDS_BYTES - RING_BYTES) / 4; u += NTHREADS) ((LAS unsigned*)(lds + RING_BYTES))[u] = 0u;
    __syncthreads();
    const int lo = args.ph_lo, hi = args.ph_hi;
    XcdBarrier bar; bar.bar = (unsigned*)(ws + WS_CTL) + 4096; bar.x = 0; bar.st = nullptr;
    if (hi - lo > 1) bar = xcd_barrier_post((unsigned*)(ws + WS_CTL) + 4096, MISCW + 8);
#ifndef SKIPMASK
#define SKIPMASK 0
#endif
#ifndef REPMASK
#define REPMASK 0
#endif
#define REP(k) for (int rep_ = 0; rep_ < 1 + ((REPMASK >> ((k) == 0 ? 0 : 1 + ((k) - 1) % 10)) & 1); ++rep_)
#define IN(k) (lo <= (k) && (k) < hi && !((SKIPMASK >> ((k) == 0 ? 0 : 1 + ((k) - 1) % 10)) & 1))
#define SEAM(k) do { if (IN(k) && IN((k) + 1)) xcd_barrier(bar); } while (0)

    if (IN(0)) REP(0) {
        if (rep_) xcd_barrier(bar);
        p0_weights(in, ws, lds, gw, NGW, wave, lane);
        p0_rope(ROPE, bid * NTHREADS + tid, G * NTHREADS);
        t_norm(0, false, in, H, H, nullptr, HN, RSTD, nullptr, nullptr, in.g_mix_pre, gw, NGW, lane);
    }
    SEAM(0);
#pragma unroll 1
    for (int l = 0; l < DEPTH; ++l) {
        const int pb = 1 + 10 * l;
        const unsigned char* wl = ws + WS_W + (size_t)l * W_LAYER;
        if (IN(pb + 0)) REP(pb + 0) {
            if (rep_) xcd_barrier(bar);
            SchedPlain S{(const char*)HN, (const char*)(wl + WO_W1), DM, DM, N1T, G, bid}; EpiG1 E{{}, PROJ, MISC, RSTD};
            run_gemm(lds, DM, DM, DM, S, E);
            skinny_gemm<1>(lds, HN + (size_t)MREAL * DM, DM, (const bf16_t*)(wl + WO_W1), DM, DM, N1 / 32, 0, E, G, bid, G - (NPM * N1T) % G);
        }
        SEAM(pb + 0);
        if (IN(pb + 1)) REP(pb + 1) { if (rep_) xcd_barrier(bar); t1_phase(l, in, PROJ, MISC, CQN, CKVN, KA, OCAT, CB, ROPE, (LAS float*)(lds + wave * 16384), gw, NGW, lane); }
        SEAM(pb + 1);
        if (IN(pb + 2)) REP(pb + 2) {
            if (rep_) xcd_barrier(bar);
            SchedG2 S{(const char*)CKVN, (const char*)(wl + WO_WUKV), (const char*)CQN, (const char*)(wl + WO_WUQ), G, bid}; EpiG2 E{{}, QA, KA, VA, ROPE};
            run_gemm(lds, 512, 512, 512, S, E);
            skinny_gemm<1>(lds, CKVN + (size_t)MREAL * 512, 512, (const bf16_t*)(wl + WO_WUKV), 512, 512, 2048 / 32, 0, E, G, bid, G - (NPM * 14) % G);
            skinny_gemm<1>(lds, CQN + (size_t)MREAL * 512, 512, (const bf16_t*)(wl + WO_WUQ), 512, 512, 1536 / 32, 1, E, G, bid, G - (NPM * 14) % G);
        }
        SEAM(pb + 2);
        if (IN(pb + 3)) REP(pb + 3) {
            if (rep_) xcd_barrier(bar);
#if FAST_ATTN
            attn_fast((char*)lds_raw, PROJ, QA, KA, VA, CB, OCAT, vcu, G);
            attn_naive(lds, PROJ, QA, KA, VA, CB, OCAT, NMETA, 1, gw, NGW, wave, lane);
#else
            attn_naive(lds, PROJ, QA, KA, VA, CB, OCAT, LSEQ, NBATCH, gw, NGW, wave, lane);
#endif
        }
        SEAM(pb + 3);
        if (IN(pb + 4)) REP(pb + 4) {
            if (rep_) xcd_barrier(bar);
            SchedG3 S{(const char*)OCAT, (const char*)(wl + WO_WBR), G, bid}; EpiG3 E{{}, PROJ, MERGED};
            run_gemm(lds, 1024, 3072, 3072, S, E);
            skinny_gemm<3>(lds, OCAT + (size_t)MREAL * 3072, 3072, (const bf16_t*)(wl + WO_WBR), 3072, 1024, DM / 32, 0, E, G, bid, G);
        }
        SEAM(pb + 4);
        if (IN(pb + 5)) REP(pb + 5) {
            if (rep_) xcd_barrier(bar);
            SchedPlain S{(const char*)MERGED, (const char*)(wl + WO_WOUT), DM, DM, 8, G, bid}; EpiF32 E{{}, MIXF};
            run_gemm(lds, DM, DM, DM, S, E);
            skinny_gemm<1>(lds, MERGED + (size_t)MREAL * DM, DM, (const bf16_t*)(wl + WO_WOUT), DM, DM, DM / 32, 0, E, G, bid, G);
        }
        SEAM(pb + 5);
        if (IN(pb + 6)) REP(pb + 6) { const bool dry = (REPMASK >> 7 & 1) && rep_ == 0; if (rep_) xcd_barrier(bar);
            t_norm(1, false, in, H, dry ? (float*)ACT : H, MIXF, dry ? PROJ : HN, dry ? MISC : RSTD, nullptr, in.g_mix_post + l * DM, in.g_ffn_pre + l * DM, gw, NGW, lane); }
        SEAM(pb + 6);
        if (IN(pb + 7)) REP(pb + 7) {
            if (rep_) xcd_barrier(bar);
            SchedPlain S{(const char*)HN, (const char*)(wl + WO_WF1), DM, DM, 2 * DFF / 256, G, bid}; EpiG5 E{{}, ACT, RSTD};
            run_gemm(lds, DM, DM, DM, S, E);
            skinny_gemm<1>(lds, HN + (size_t)MREAL * DM, DM, (const bf16_t*)(wl + WO_WF1), DM, DM, 2 * DFF / 32, 0, E, G, bid, G - (NPM * 2 * DFF / 256) % G);
        }
        SEAM(pb + 7);
        if (IN(pb + 8)) REP(pb + 8) {
            if (rep_) xcd_barrier(bar);
            SchedPlain S{(const char*)ACT, (const char*)(wl + WO_WF2), DFF, DFF, 8, G, bid}; EpiF32 E{{}, MIXF};
            run_gemm(lds, DFF, DFF, DFF, S, E);
            skinny_gemm<1>(lds, ACT + (size_t)MREAL * DFF, DFF, (const bf16_t*)(wl + WO_WF2), DFF, DFF, DM / 32, 0, E, G, bid, G);
        }
        SEAM(pb + 8);
        if (IN(pb + 9)) REP(pb + 9) { const bool dry = (REPMASK >> 10 & 1) && rep_ == 0; if (rep_) xcd_barrier(bar);
            t_norm(1, l == DEPTH - 1, in, H, dry ? (float*)ACT : H, MIXF, dry ? PROJ : HN, dry ? MISC : RSTD, dry ? (float*)ACT : args.out, in.g_ffn_post + l * DM, in.g_mix_pre + (l + 1 < DEPTH ? l + 1 : 0) * DM, gw, NGW, lane); }
        SEAM(pb + 9);
    }
#undef IN
#undef SEAM
}

extern "C" void kernel_launch(void* const* d_in, const int* in_sizes, int n_in, void* d_out, int out_size, void* d_ws, size_t ws_size, hipStream_t stream) {
    static int grid = 0;
    if (grid == 0) {
        if (n_in != 17 || out_size != MREAL * DM || ws_size < WS_END) { fprintf(stderr, "kernel_launch: unexpected shapes: n_in %d out %d ws %zu (need %zu)\n", n_in, out_size, ws_size, (size_t)WS_END); grid = -1; return; }
        int dev = 0, cus = 0, per_cu = 0;
        if (hipGetDevice(&dev) != hipSuccess || hipDeviceGetAttribute(&cus, hipDeviceAttributeMultiprocessorCount, dev) != hipSuccess) { grid = -1; return; }
        if (hipFuncSetAttribute((const void*)fwd, hipFuncAttributeMaxDynamicSharedMemorySize, LDS_BYTES) != hipSuccess) { fprintf(stderr, "kernel_launch: hipFuncSetAttribute failed\n"); grid = -1; return; }
        if (hipOccupancyMaxActiveBlocksPerMultiprocessor(&per_cu, (const void*)fwd, NTHREADS, LDS_BYTES) != hipSuccess || per_cu < 1) fprintf(stderr, "kernel_launch: occupancy query says %d\n", per_cu);
        (void)hipGetLastError();
        grid = cus;
    }
    if (grid < 0) return;
    (void)hipMemsetAsync((char*)d_ws + WS_CTL, 0, CTL_ZERO_BYTES, stream);
    Args a{};
    for (int i = 0; i < 17; ++i) a.in[i] = (const float*)d_in[i];
    a.out = (float*)d_out; a.ws = (unsigned char*)d_ws;
#if MK_ONE_LAUNCH
    a.ph_lo = 0; a.ph_hi = NPHASES;
    hipLaunchKernelGGL(fwd, dim3(grid), dim3(NTHREADS), LDS_BYTES, stream, a);
#else
    for (int p = 0; p < NPHASES; ++p) { a.ph_lo = p; a.ph_hi = p + 1; hipLaunchKernelGGL(fwd, dim3(grid), dim3(NTHREADS), LDS_BYTES, stream, a); }
#endif
}
```
